# Optimizing an MI355X kernel written in HIP

```python
import jax, jax.numpy as jnp
from jax import lax
import numpy as np

D_MODEL = 1024
BATCH = 16
SEQ = 2048
DEPTH = 2

N_MEM = 256
D_MIX = D_MODEL
SB_HEADS = 8
SB_HEAD_DIM = (D_MIX // 2) // SB_HEADS
SB_WIDTH = SB_HEADS * SB_HEAD_DIM
SB_BLOCK = 128
RET_HEADS = 4
RET_HEAD_DIM = (D_MIX // 2) // RET_HEADS
RET_WIDTH = RET_HEADS * RET_HEAD_DIM
RET_CHUNK = 128
ROPE_BASE = 10000.0
IN_COLS = 3 * SB_WIDTH + 4 * RET_WIDTH
XA_HEADS = 4
XA_HEAD_DIM = D_MODEL // XA_HEADS
PEER_HEADS = 8
PEER_NKEYS = 128
PEER_N_EXPERTS = PEER_NKEYS * PEER_NKEYS
PEER_DQ = 256
PEER_TOPK = 16
PEER_CHUNK = 128
EPS = 1e-6

kernel_name = "hybrid_sb_retention_peer_trunk"


def rmsnorm(x, g):
    xf = x.astype(jnp.float32)
    y = xf * lax.rsqrt(jnp.mean(xf * xf, axis=-1, keepdims=True) + EPS)
    return (y * g.astype(jnp.float32)).astype(x.dtype)


def head_rmsnorm(o, g):
    H, d = o.shape[1], o.shape[3]
    of = o.astype(jnp.float32)
    y = of * lax.rsqrt(jnp.mean(of * of, axis=-1, keepdims=True) + EPS)
    return (y * g.reshape(1, H, 1, d).astype(jnp.float32)).astype(o.dtype)


def head_groupnorm(o, g):
    H, d = o.shape[1], o.shape[3]
    of = o.astype(jnp.float32)
    mu = jnp.mean(of, axis=-1, keepdims=True)
    var = jnp.mean((of - mu) ** 2, axis=-1, keepdims=True)
    y = (of - mu) * lax.rsqrt(var + EPS)
    return (y * g.reshape(1, H, 1, d).astype(jnp.float32)).astype(o.dtype)


def split_heads(t, n_heads):
    B, S, _ = t.shape
    return t.reshape(B, S, n_heads, -1).transpose(0, 2, 1, 3)


def merge_heads(t):
    B, H, S, d = t.shape
    return t.transpose(0, 2, 1, 3).reshape(B, S, H * d)


def rotary(x):
    S, d = x.shape[2], x.shape[3]
    inv = ROPE_BASE ** (-jnp.arange(0, d, 2, dtype=jnp.float32) / d)
    ang = jnp.arange(S, dtype=jnp.float32)[:, None] * inv[None, :]
    cos, sin = jnp.cos(ang), jnp.sin(ang)
    xf = x.astype(jnp.float32)
    x1, x2 = xf[..., : d // 2], xf[..., d // 2:]
    return jnp.concatenate([x1 * cos - x2 * sin, x1 * sin + x2 * cos], axis=-1).astype(x.dtype)


def stick_breaking(q, k, v):
    S, d = q.shape[2], q.shape[3]
    scale = d ** -0.5
    outs = []
    for blk in range(S // SB_BLOCK):
        t0, t1 = blk * SB_BLOCK, (blk + 1) * SB_BLOCK
        z = jnp.einsum('bhtd,bhsd->bhts', q[:, :, t0:t1], k[:, :, :t1]).astype(jnp.float32) * scale
        causal = jnp.arange(t1)[None, :] < jnp.arange(t0, t1)[:, None]
        log_not_b = jnp.where(causal, jax.nn.log_sigmoid(-z), 0.0)
        stick = lax.cumsum(log_not_b, axis=3, reverse=True) - log_not_b
        a = jnp.where(causal, jnp.exp(jax.nn.log_sigmoid(z) + stick), 0.0)
        outs.append(jnp.einsum('bhts,bhsd->bhtd', a.astype(v.dtype), v[:, :, :t1]))
    return jnp.concatenate(outs, axis=2)


def retention(q, k, v):
    B, H, S, d = q.shape
    C = RET_CHUNK
    N = S // C
    log_g = jnp.log1p(-jnp.power(2.0, -5.0 - jnp.arange(H, dtype=jnp.float32)))
    qc = q.astype(jnp.float32).reshape(B, H, N, C, d)
    kc = (k.astype(jnp.float32) * d ** -0.5).reshape(B, H, N, C, d)
    vc = v.astype(jnp.float32).reshape(B, H, N, C, v.shape[3])
    idx = jnp.arange(C, dtype=jnp.float32)
    diff = idx[:, None] - idx[None, :]
    decay = jnp.where(diff >= 0, jnp.exp(diff[None] * log_g[:, None, None]), 0.0)
    inner_s = jnp.einsum('bhncd,bhnmd->bhncm', qc, kc) * decay[None, :, None]
    inner = jnp.einsum('bhncm,bhnme->bhnce', inner_s, vc)
    zeta = jnp.exp((C - 1 - idx)[None, :] * log_g[:, None])
    xi = jnp.exp((idx + 1)[None, :] * log_g[:, None])
    chunk_kv = jnp.einsum('bhncd,bhnce->nbhde', kc * zeta[None, :, None, :, None], vc)
    decay_c = jnp.exp(C * log_g)[None, :, None, None]

    def step(state, kv_n):
        return decay_c * state + kv_n, state

    _, prev = lax.scan(step, jnp.zeros_like(chunk_kv[0]), chunk_kv)
    cross = jnp.einsum('bhncd,nbhde->bhnce', qc * xi[None, :, None, :, None], prev)
    return (inner + cross).reshape(B, H, S, v.shape[3]).astype(q.dtype)


def head_group_mixer(h, w_in, sb_norm, ret_norm, w_out):
    proj = h @ w_in
    cuts = [SB_WIDTH, 2 * SB_WIDTH, 3 * SB_WIDTH, 3 * SB_WIDTH + RET_WIDTH,
            3 * SB_WIDTH + 2 * RET_WIDTH, 3 * SB_WIDTH + 3 * RET_WIDTH]
    sb_q, sb_k, sb_v, r_q, r_k, r_v, r_g = jnp.split(proj, cuts, axis=-1)
    sb_o = stick_breaking(split_heads(sb_q, SB_HEADS), split_heads(sb_k, SB_HEADS),
                          split_heads(sb_v, SB_HEADS))
    sb_o = merge_heads(head_rmsnorm(sb_o, sb_norm))
    ret_o = retention(rotary(split_heads(r_q, RET_HEADS)), rotary(split_heads(r_k, RET_HEADS)),
                      split_heads(r_v, RET_HEADS))
    ret_o = merge_heads(head_groupnorm(ret_o, ret_norm)) * jax.nn.silu(r_g)
    return jnp.concatenate([sb_o, ret_o], axis=-1) @ w_out


def memory_cross_attn(h, mem_h, wq, wkv, wo):
    B, S, D = h.shape
    M = mem_h.shape[1]
    q = (h @ wq).reshape(B, S, XA_HEADS, XA_HEAD_DIM)
    k, v = jnp.split(mem_h @ wkv, 2, axis=-1)
    k = k.reshape(B, M, XA_HEADS, XA_HEAD_DIM)
    v = v.reshape(B, M, XA_HEADS, XA_HEAD_DIM)
    s = jnp.einsum('bshd,bmhd->bhsm', q, k).astype(jnp.float32) * XA_HEAD_DIM ** -0.5
    p = jax.nn.softmax(s, axis=-1).astype(v.dtype)
    o = jnp.einsum('bhsm,bmhd->bshd', p, v).reshape(B, S, D)
    return o @ wo


def peer_ffn(h, w_pq, sub_keys, expert_u, expert_v):
    B, S, D = h.shape
    K, NK = PEER_TOPK, PEER_NKEYS
    q = (h @ w_pq).reshape(B, S, PEER_HEADS, 2, PEER_DQ // 2)
    scores = jnp.einsum('bshpd,hpkd->bshpk', q, sub_keys).astype(jnp.float32)
    top_s, top_i = lax.top_k(scores, K)
    cand_s = (top_s[..., 0, :, None] + top_s[..., 1, None, :]).reshape(B, S, PEER_HEADS, K * K)
    cand_i = (top_i[..., 0, :, None] * NK + top_i[..., 1, None, :]).reshape(B, S, PEER_HEADS, K * K)
    best_s, best_pos = lax.top_k(cand_s, K)
    expert_idx = jnp.take_along_axis(cand_i, best_pos, axis=-1)
    gate = jax.nn.softmax(best_s, axis=-1).astype(h.dtype)
    T = B * S
    n_chunks = T // PEER_CHUNK
    h_c = h.reshape(n_chunks, PEER_CHUNK, D)
    i_c = expert_idx.reshape(n_chunks, PEER_CHUNK, PEER_HEADS, K)
    g_c = gate.reshape(n_chunks, PEER_CHUNK, PEER_HEADS, K)

    def retrieve(args):
        hc, ic, gc = args
        u = jnp.take(expert_u, ic, axis=0)
        a = jnp.einsum('cd,chkd->chk', hc, u)
        w = gc * jax.nn.gelu(a, approximate=False)
        return jnp.einsum('chk,chkd->cd', w, jnp.take(expert_v, ic, axis=0))

    return lax.map(retrieve, (h_c, i_c, g_c)).reshape(B, S, D)


def setup_inputs(seed: int = 0) -> dict:
    key = jax.random.key(seed)
    ks = jax.random.split(key, 20)
    f32 = jnp.float32

    def nrm(k, shape, scale):
        return jax.random.normal(k, shape, f32) * scale

    def gain(k, shape):
        return 1.0 + 0.01 * jax.random.normal(k, shape, f32)

    L, D = DEPTH, D_MODEL
    return {
        "x": nrm(ks[0], (BATCH, SEQ, D), 1.0),
        "mem": nrm(ks[1], (BATCH, N_MEM, D), 1.0),
        "mix_norm": gain(ks[2], (L, D)),
        "w_in": nrm(ks[3], (L, D, IN_COLS), D ** -0.5),
        "sb_norm": gain(ks[4], (L, SB_WIDTH)),
        "ret_norm": gain(ks[5], (L, RET_WIDTH)),
        "w_out": nrm(ks[6], (L, D_MIX, D), 0.5 * D_MIX ** -0.5),
        "xa_norm": gain(ks[7], (L, D)),
        "mem_norm": gain(ks[8], (L, D)),
        "xa_wq": nrm(ks[9], (L, D, D), D ** -0.5),
        "xa_wkv": nrm(ks[10], (L, D, 2 * D), D ** -0.5),
        "xa_wo": nrm(ks[11], (L, D, D), 0.5 * D ** -0.5),
        "peer_norm": gain(ks[12], (L, D)),
        "peer_wq": nrm(ks[13], (L, D, PEER_HEADS * PEER_DQ), D ** -0.5),
        "peer_keys": nrm(ks[14], (L, PEER_HEADS, 2, PEER_NKEYS, PEER_DQ // 2), (PEER_DQ // 2) ** -0.5),
        "peer_u": nrm(ks[15], (L, PEER_N_EXPERTS, D), D ** -0.5),
        "peer_v": nrm(ks[16], (L, PEER_N_EXPERTS, D), 0.25),
        "final_norm": gain(ks[17], (D,)),
    }


def reference(x, mem, mix_norm, w_in, sb_norm, ret_norm, w_out, xa_norm, mem_norm,
              xa_wq, xa_wkv, xa_wo, peer_norm, peer_wq, peer_keys, peer_u, peer_v, final_norm):
    for l in range(DEPTH):
        x = x + head_group_mixer(rmsnorm(x, mix_norm[l]), w_in[l], sb_norm[l], ret_norm[l], w_out[l])
        x = x + memory_cross_attn(rmsnorm(x, xa_norm[l]), rmsnorm(mem, mem_norm[l]),
                                  xa_wq[l], xa_wkv[l], xa_wo[l])
        x = x + peer_ffn(rmsnorm(x, peer_norm[l]), peer_wq[l], peer_keys[l], peer_u[l], peer_v[l])
    return rmsnorm(x, final_norm)
```

```cpp
#include <hip/hip_runtime.h>
#include <stdint.h>

typedef unsigned short bf16_t;
__device__ __forceinline__ float bf2f(bf16_t v) { return __uint_as_float(((unsigned)v) << 16); }
__device__ __forceinline__ bf16_t f2bf(float f) { unsigned u = __float_as_uint(f); u = (u + 0x7fffu + ((u >> 16) & 1u)) >> 16; return (bf16_t)u; }

constexpr int NB = 16, SEQ = 2048, DM = 1024, T = NB * SEQ, NL = 2, NMEM = 256, INC = 3584;
constexpr float EPS = 1e-6f;

__device__ __forceinline__ float wave_sum(float v) {
#pragma unroll
    for (int o = 1; o < 64; o <<= 1) v += __shfl_xor(v, o);
    return v;
}
__device__ __forceinline__ float wave_max(float v) {
#pragma unroll
    for (int o = 1; o < 64; o <<= 1) v = fmaxf(v, __shfl_xor(v, o));
    return v;
}

__global__ void __launch_bounds__(256) k_rmsnorm(const float* x, const float* g, bf16_t* ob, float* of, int rows) {
    const int row = blockIdx.x * 4 + (threadIdx.x >> 6), lane = threadIdx.x & 63;
    if (row >= rows) return;
    const float4* xr = (const float4*)(x + (size_t)row * DM);
    float4 v[4]; float s = 0.f;
#pragma unroll
    for (int i = 0; i < 4; ++i) { v[i] = xr[lane + 64 * i]; s += v[i].x * v[i].x + v[i].y * v[i].y + v[i].z * v[i].z + v[i].w * v[i].w; }
    s = wave_sum(s);
    const float r = rsqrtf(s * (1.0f / DM) + EPS);
#pragma unroll
    for (int i = 0; i < 4; ++i) {
        const float4 gg = ((const float4*)g)[lane + 64 * i];
        float4 y; y.x = v[i].x * r * gg.x; y.y = v[i].y * r * gg.y; y.z = v[i].z * r * gg.z; y.w = v[i].w * r * gg.w;
        if (of) ((float4*)(of + (size_t)row * DM))[lane + 64 * i] = y;
        if (ob) { ushort4 o; o.x = f2bf(y.x); o.y = f2bf(y.y); o.z = f2bf(y.z); o.w = f2bf(y.w); ((ushort4*)(ob + (size_t)row * DM))[lane + 64 * i] = o; }
    }
}

template <int EPI>
__global__ void __launch_bounds__(256) k_gemm(const bf16_t* __restrict__ A, const float* __restrict__ B, int M, int N, int K, void* Cv, const float* R) {
    __shared__ float As[16][68];
    __shared__ float Bs[16][68];
    const int tid = threadIdx.x, tx = tid & 15, ty = tid >> 4;
    const int m0 = blockIdx.y * 64, n0 = blockIdx.x * 64;
    float acc[4][4];
#pragma unroll
    for (int i = 0; i < 4; ++i)
#pragma unroll
        for (int j = 0; j < 4; ++j) acc[i][j] = 0.f;
    for (int k0 = 0; k0 < K; k0 += 16) {
        {   const int r = tid >> 2, c = (tid & 3) * 4;
            const ushort4 a = *(const ushort4*)(A + (size_t)(m0 + r) * K + k0 + c);
            As[c + 0][r] = bf2f(a.x); As[c + 1][r] = bf2f(a.y); As[c + 2][r] = bf2f(a.z); As[c + 3][r] = bf2f(a.w);
            const int kr = tid >> 4, nc = (tid & 15) * 4;
            const float4 b = *(const float4*)(B + (size_t)(k0 + kr) * N + n0 + nc);
            Bs[kr][nc + 0] = b.x; Bs[kr][nc + 1] = b.y; Bs[kr][nc + 2] = b.z; Bs[kr][nc + 3] = b.w; }
        __syncthreads();
#pragma unroll
        for (int kk = 0; kk < 16; ++kk) {
            float a[4], b[4];
#pragma unroll
            for (int i = 0; i < 4; ++i) { a[i] = As[kk][ty * 4 + i]; b[i] = Bs[kk][tx * 4 + i]; }
#pragma unroll
            for (int i = 0; i < 4; ++i)
#pragma unroll
                for (int j = 0; j < 4; ++j) acc[i][j] += a[i] * b[j];
        }
        __syncthreads();
    }
#pragma unroll
    for (int i = 0; i < 4; ++i) {
        const size_t off = (size_t)(m0 + ty * 4 + i) * N + n0 + tx * 4;
        if (EPI == 0) { ushort4 o; o.x = f2bf(acc[i][0]); o.y = f2bf(acc[i][1]); o.z = f2bf(acc[i][2]); o.w = f2bf(acc[i][3]); *(ushort4*)((bf16_t*)Cv + off) = o; }
        else if (EPI == 1) { const float4 r = *(const float4*)(R + off); float4 o; o.x = r.x + acc[i][0]; o.y = r.y + acc[i][1]; o.z = r.z + acc[i][2]; o.w = r.w + acc[i][3]; *(float4*)((float*)Cv + off) = o; }
        else { float4 o; o.x = acc[i][0]; o.y = acc[i][1]; o.z = acc[i][2]; o.w = acc[i][3]; *(float4*)((float*)Cv + off) = o; }
    }
}

__global__ void __launch_bounds__(256) k_sb_naive(const bf16_t* __restrict__ proj, const float* __restrict__ sbn, bf16_t* __restrict__ mix) {
    const int wv = blockIdx.x * 4 + (threadIdx.x >> 6), lane = threadIdx.x & 63;
    const int t = wv & (SEQ - 1), h = (wv >> 11) & 7, b = wv >> 14;
    const size_t rowb = (size_t)b * SEQ;
    const float q = bf2f(proj[(rowb + t) * INC + h * 64 + lane]) * 0.125f;
    float run = 0.f, acc = 0.f;
    for (int s = t - 1; s >= 0; --s) {
        const bf16_t* pr = proj + (rowb + s) * INC + h * 64 + lane;
        const float z = wave_sum(q * bf2f(pr[512]));
        const float vd = bf2f(pr[1024]);
        const float lsz = fminf(z, 0.f) - log1pf(__expf(-fabsf(z)));
        const float a = __expf(lsz + run);
        acc += a * vd;
        run += lsz - z;
        if (run < -120.f) break;
    }
    const float ss = wave_sum(acc * acc);
    const float y = acc * rsqrtf(ss * (1.f / 64.f) + EPS) * sbn[h * 64 + lane];
    mix[(rowb + t) * DM + h * 64 + lane] = f2bf(y);
}

__global__ void __launch_bounds__(256) k_ret_naive(const bf16_t* __restrict__ proj, const float* __restrict__ rn, bf16_t* __restrict__ mix) {
    __shared__ float qs[128], ks[128], vs[128], red[2][128], stat[4];
    const int bh = blockIdx.x, b = bh >> 2, h = bh & 3, tid = threadIdx.x, half = tid >> 7, e = tid & 127;
    const float gamma = 1.0f - exp2f(-5.0f - (float)h);
    float st[64];
#pragma unroll
    for (int i = 0; i < 64; ++i) st[i] = 0.f;
    const float inv_i = exp2f(-((float)(2 * (tid & 63)) / 128.0f) * 13.287712379549449f);
    for (int t = 0; t < SEQ; ++t) {
        const bf16_t* pr = proj + ((size_t)b * SEQ + t) * INC;
        if (tid < 128) {
            const int i = tid & 63; const int base = (tid < 64 ? 1536 : 2048) + h * 128;
            const float x1 = bf2f(pr[base + i]), x2 = bf2f(pr[base + i + 64]);
            float sn, cs; sincosf((float)t * inv_i, &sn, &cs);
            const float o1 = x1 * cs - x2 * sn, o2 = x1 * sn + x2 * cs;
            if (tid < 64) { qs[i] = o1; qs[i + 64] = o2; } else { const float sc = 0.08838834764831845f; ks[i] = o1 * sc; ks[i + 64] = o2 * sc; }
        } else {
            vs[tid - 128] = bf2f(pr[2560 + h * 128 + (tid - 128)]);
        }
        __syncthreads();
        const float ve = vs[e]; float part = 0.f;
#pragma unroll
        for (int dd = 0; dd < 64; ++dd) { const int d = half * 64 + dd; st[dd] = gamma * st[dd] + ks[d] * ve; part += qs[d] * st[dd]; }
        red[half][e] = part;
        __syncthreads();
        float o = 0.f;
        if (tid < 128) { o = red[0][e] + red[1][e]; const float s1 = wave_sum(o); if ((tid & 63) == 0) stat[tid >> 6] = s1; }
        __syncthreads();
        float mu = 0.f, dlt = 0.f;
        if (tid < 128) { mu = (stat[0] + stat[1]) * (1.f / 128.f); dlt = o - mu; const float s2 = wave_sum(dlt * dlt); if ((tid & 63) == 0) stat[2 + (tid >> 6)] = s2; }
        __syncthreads();
        if (tid < 128) {
            const float var = (stat[2] + stat[3]) * (1.f / 128.f);
            const float g = bf2f(pr[3072 + h * 128 + e]);
            const float y = dlt * rsqrtf(var + EPS) * rn[h * 128 + e] * (g / (1.f + __expf(-g)));
            mix[((size_t)b * SEQ + t) * DM + 512 + h * 128 + e] = f2bf(y);
        }
        __syncthreads();
    }
}

__global__ void __launch_bounds__(256) k_xattn_naive(const bf16_t* __restrict__ Q, const bf16_t* __restrict__ KV, bf16_t* __restrict__ O) {
    __shared__ float qsh[4][256], psh[4][256];
    const int w = threadIdx.x >> 6, lane = threadIdx.x & 63;
    const int wv = blockIdx.x * 4 + w, h = wv & 3, t = wv >> 2, b = t >> 11;
    const bf16_t* qr = Q + (size_t)t * DM + h * 256;
#pragma unroll
    for (int i = 0; i < 4; ++i) qsh[w][lane + 64 * i] = bf2f(qr[lane + 64 * i]);
    __syncthreads();
    float s[4];
#pragma unroll
    for (int i = 0; i < 4; ++i) {
        const int m = lane + 64 * i; const bf16_t* kr = KV + ((size_t)b * NMEM + m) * 2048 + h * 256;
        float a = 0.f;
        for (int d = 0; d < 256; d += 4) { const ushort4 k4 = *(const ushort4*)(kr + d); a += qsh[w][d] * bf2f(k4.x) + qsh[w][d + 1] * bf2f(k4.y) + qsh[w][d + 2] * bf2f(k4.z) + qsh[w][d + 3] * bf2f(k4.w); }
        s[i] = a * 0.0625f;
    }
    const float mx = wave_max(fmaxf(fmaxf(s[0], s[1]), fmaxf(s[2], s[3])));
    float p[4], sum = 0.f;
#pragma unroll
    for (int i = 0; i < 4; ++i) { p[i] = __expf(s[i] - mx); sum += p[i]; }
    sum = wave_sum(sum);
    const float inv = 1.f / sum;
#pragma unroll
    for (int i = 0; i < 4; ++i) psh[w][lane + 64 * i] = p[i] * inv;
    __syncthreads();
    float o[4] = {0.f, 0.f, 0.f, 0.f};
    for (int m = 0; m < NMEM; ++m) {
        const ushort4 v4 = *(const ushort4*)(KV + ((size_t)b * NMEM + m) * 2048 + 1024 + h * 256 + lane * 4);
        const float pm = psh[w][m];
        o[0] += pm * bf2f(v4.x); o[1] += pm * bf2f(v4.y); o[2] += pm * bf2f(v4.z); o[3] += pm * bf2f(v4.w);
    }
    ushort4 ov; ov.x = f2bf(o[0]); ov.y = f2bf(o[1]); ov.z = f2bf(o[2]); ov.w = f2bf(o[3]);
    *(ushort4*)(O + (size_t)t * DM + h * 256 + lane * 4) = ov;
}

__device__ __forceinline__ void wave_argmax(float& v, int& i) {
#pragma unroll
    for (int o = 1; o < 64; o <<= 1) {
        const float ov = __shfl_xor(v, o); const int oi = __shfl_xor(i, o);
        if (ov > v || (ov == v && oi < i)) { v = ov; i = oi; }
    }
}
__global__ void __launch_bounds__(256) k_peer_topk_naive(const float* __restrict__ PQ, const float* __restrict__ keys, int* __restrict__ idx, float* __restrict__ gate) {
    __shared__ float qsh[4][256];
    const int w = threadIdx.x >> 6, lane = threadIdx.x & 63;
    const int wv = blockIdx.x * 4 + w, h = wv & 7, t = wv >> 3;
    const float* qr = PQ + (size_t)t * 2048 + h * 256;
#pragma unroll
    for (int i = 0; i < 4; ++i) qsh[w][lane + 64 * i] = qr[lane + 64 * i];
    __syncthreads();
    float tops[2] = {0.f, 0.f}; int topi[2] = {0, 0};
#pragma unroll
    for (int p = 0; p < 2; ++p) {
        float sc[2];
#pragma unroll
        for (int j = 0; j < 2; ++j) {
            const int k = lane + 64 * j; const float* kr = keys + ((size_t)(h * 2 + p) * 128 + k) * 128;
            float a = 0.f;
            for (int d = 0; d < 128; d += 4) { const float4 k4 = *(const float4*)(kr + d); a += qsh[w][p * 128 + d] * k4.x + qsh[w][p * 128 + d + 1] * k4.y + qsh[w][p * 128 + d + 2] * k4.z + qsh[w][p * 128 + d + 3] * k4.w; }
            sc[j] = a;
        }
        for (int r = 0; r < 16; ++r) {
            float v; int i;
            if (sc[0] >= sc[1]) { v = sc[0]; i = lane; } else { v = sc[1]; i = lane + 64; }
            wave_argmax(v, i);
            if (lane == r) { tops[p] = v; topi[p] = i; }
            if (i == lane) sc[0] = -INFINITY; else if (i == lane + 64) sc[1] = -INFINITY;
        }
    }
    float cs[4]; int ce[4];
#pragma unroll
    for (int q = 0; q < 4; ++q) {
        const int c = lane + 64 * q, i = c >> 4, j = c & 15;
        cs[q] = __shfl(tops[0], i) + __shfl(tops[1], j);
        ce[q] = __shfl(topi[0], i) * 128 + __shfl(topi[1], j);
    }
    float bs = 0.f; int be = 0;
    for (int r = 0; r < 16; ++r) {
        float v = cs[0]; int c = lane;
#pragma unroll
        for (int q = 1; q < 4; ++q) if (cs[q] > v) { v = cs[q]; c = lane + 64 * q; }
        wave_argmax(v, c);
        int e = 0;
#pragma unroll
        for (int q = 0; q < 4; ++q) { const int eq = __shfl(ce[q], c & 63); if ((c >> 6) == q) e = eq; }
        if (lane == r) { bs = v; be = e; }
        if ((c & 63) == lane) {
#pragma unroll
            for (int q = 0; q < 4; ++q) if ((c >> 6) == q) cs[q] = -INFINITY;
        }
    }
    const float mx = __shfl(bs, 0);
    const float ex = lane < 16 ? __expf(bs - mx) : 0.f;
    const float sum = wave_sum(ex);
    if (lane < 16) { idx[(size_t)t * 128 + h * 16 + lane] = be; gate[(size_t)t * 128 + h * 16 + lane] = ex / sum; }
}

__global__ void __launch_bounds__(256) k_peer_gather_naive(const bf16_t* __restrict__ H, const float* __restrict__ U, const float* __restrict__ V, const int* __restrict__ idx, const float* __restrict__ gate, float* XR) {
    const int t = blockIdx.x * 4 + (threadIdx.x >> 6), lane = threadIdx.x & 63;
    float4 hv[4], acc[4];
#pragma unroll
    for (int i = 0; i < 4; ++i) { const ushort4 a = ((const ushort4*)(H + (size_t)t * DM))[lane + 64 * i]; hv[i].x = bf2f(a.x); hv[i].y = bf2f(a.y); hv[i].z = bf2f(a.z); hv[i].w = bf2f(a.w); acc[i] = make_float4(0.f, 0.f, 0.f, 0.f); }
    const int i0 = idx[(size_t)t * 128 + lane], i1 = idx[(size_t)t * 128 + 64 + lane];
    const float g0 = gate[(size_t)t * 128 + lane], g1 = gate[(size_t)t * 128 + 64 + lane];
    for (int p = 0; p < 128; ++p) {
        const int e = __shfl(p < 64 ? i0 : i1, p & 63); const float g = __shfl(p < 64 ? g0 : g1, p & 63);
        const float4* ur = (const float4*)(U + (size_t)e * DM); const float4* vr = (const float4*)(V + (size_t)e * DM);
        float a = 0.f;
#pragma unroll
        for (int i = 0; i < 4; ++i) { const float4 u = ur[lane + 64 * i]; a += hv[i].x * u.x + hv[i].y * u.y + hv[i].z * u.z + hv[i].w * u.w; }
        a = wave_sum(a);
        const float wgt = g * 0.5f * a * (1.f + erff(a * 0.7071067811865476f));
#pragma unroll
        for (int i = 0; i < 4; ++i) { const float4 v = vr[lane + 64 * i]; acc[i].x += wgt * v.x; acc[i].y += wgt * v.y; acc[i].z += wgt * v.z; acc[i].w += wgt * v.w; }
    }
    float4* xr = (float4*)(XR + (size_t)t * DM);
#pragma unroll
    for (int i = 0; i < 4; ++i) { float4 x = xr[lane + 64 * i]; x.x += acc[i].x; x.y += acc[i].y; x.z += acc[i].z; x.w += acc[i].w; xr[lane + 64 * i] = x; }
}

extern "C" void kernel_launch(void* const* d_in, const int* in_sizes, int n_in, void* d_out, int out_size, void* d_ws, size_t ws_size, hipStream_t stream) {
    const float* x = (const float*)d_in[0]; const float* mem = (const float*)d_in[1];
    const float* mix_norm = (const float*)d_in[2]; const float* w_in = (const float*)d_in[3];
    const float* sb_norm = (const float*)d_in[4]; const float* ret_norm = (const float*)d_in[5];
    const float* w_out = (const float*)d_in[6]; const float* xa_norm = (const float*)d_in[7];
    const float* mem_norm = (const float*)d_in[8]; const float* xa_wq = (const float*)d_in[9];
    const float* xa_wkv = (const float*)d_in[10]; const float* xa_wo = (const float*)d_in[11];
    const float* peer_norm = (const float*)d_in[12]; const float* peer_wq = (const float*)d_in[13];
    const float* peer_keys = (const float*)d_in[14]; const float* peer_u = (const float*)d_in[15];
    const float* peer_v = (const float*)d_in[16]; const float* final_norm = (const float*)d_in[17];
    float* XR = (float*)d_out;
    char* ws = (char*)d_ws; const size_t MiB = 1u << 20;
    bf16_t* H = (bf16_t*)(ws + 0);
    bf16_t* PROJ = (bf16_t*)(ws + 64 * MiB);
    bf16_t* MIX = (bf16_t*)(ws + 288 * MiB);
    float* PQ = (float*)(ws + 64 * MiB);
    bf16_t* Q = (bf16_t*)(ws + 64 * MiB);
    bf16_t* O = (bf16_t*)(ws + 128 * MiB);
    int* IDX = (int*)(ws + 352 * MiB);
    float* GATE = (float*)(ws + 368 * MiB);
    bf16_t* MEMH = (bf16_t*)(ws + 384 * MiB);
    bf16_t* KV = (bf16_t*)(ws + 392 * MiB);
    for (int l = 0; l < NL; ++l) {
        const float* src = l == 0 ? x : XR;
        k_rmsnorm<<<T / 4, 256, 0, stream>>>(src, mix_norm + l * DM, H, nullptr, T);
        k_gemm<0><<<dim3(INC / 64, T / 64), 256, 0, stream>>>(H, w_in + (size_t)l * DM * INC, T, INC, DM, PROJ, nullptr);
        k_sb_naive<<<NB * 8 * SEQ / 4, 256, 0, stream>>>(PROJ, sb_norm + l * 512, MIX);
        k_ret_naive<<<NB * 4, 256, 0, stream>>>(PROJ, ret_norm + l * 512, MIX);
        k_gemm<1><<<dim3(DM / 64, T / 64), 256, 0, stream>>>(MIX, w_out + (size_t)l * DM * DM, T, DM, DM, XR, src);
        k_rmsnorm<<<T / 4, 256, 0, stream>>>(XR, xa_norm + l * DM, H, nullptr, T);
        k_gemm<0><<<dim3(DM / 64, T / 64), 256, 0, stream>>>(H, xa_wq + (size_t)l * DM * DM, T, DM, DM, Q, nullptr);
        k_rmsnorm<<<NB * NMEM / 4, 256, 0, stream>>>(mem, mem_norm + l * DM, MEMH, nullptr, NB * NMEM);
        k_gemm<0><<<dim3(2048 / 64, NB * NMEM / 64), 256, 0, stream>>>(MEMH, xa_wkv + (size_t)l * DM * 2048, NB * NMEM, 2048, DM, KV, nullptr);
        k_xattn_naive<<<T * 4 / 4, 256, 0, stream>>>(Q, KV, O);
        k_gemm<1><<<dim3(DM / 64, T / 64), 256, 0, stream>>>(O, xa_wo + (size_t)l * DM * DM, T, DM, DM, XR, XR);
        k_rmsnorm<<<T / 4, 256, 0, stream>>>(XR, peer_norm + l * DM, H, nullptr, T);
        k_gemm<2><<<dim3(2048 / 64, T / 64), 256, 0, stream>>>(H, peer_wq + (size_t)l * DM * 2048, T, 2048, DM, PQ, nullptr);
        k_peer_topk_naive<<<T * 8 / 4, 256, 0, stream>>>(PQ, peer_keys + (size_t)l * 8 * 2 * 128 * 128, IDX, GATE);
        k_peer_gather_naive<<<T / 4, 256, 0, stream>>>(H, peer_u + (size_t)l * 16384 * DM, peer_v + (size_t)l * 16384 * DM, IDX, GATE, XR);
    }
    k_rmsnorm<<<T / 4, 256, 0, stream>>>(XR, final_norm, nullptr, XR, T);
}
```

```cpp
#include <hip/hip_runtime.h>
#include <hip/hip_cooperative_groups.h>
#include <stdint.h>
#include <cstdio>
namespace cg = cooperative_groups;

typedef unsigned short bf16_t;
__device__ __forceinline__ float bf2f(bf16_t v) { return __uint_as_float(((unsigned)v) << 16); }
__device__ __forceinline__ bf16_t f2bf(float f) { unsigned u = __float_as_uint(f); u = (u + 0x7fffu + ((u >> 16) & 1u)) >> 16; return (bf16_t)u; }

constexpr int NB = 16, SEQ = 2048, DM = 1024, T = NB * SEQ, NL = 2, NMEM = 256, INC = 3584;
constexpr float EPS = 1e-6f;

__device__ __forceinline__ float wave_sum(float v) {
#pragma unroll
    for (int o = 1; o < 64; o <<= 1) v += __shfl_xor(v, o);
    return v;
}
__device__ __forceinline__ float wave_max(float v) {
#pragma unroll
    for (int o = 1; o < 64; o <<= 1) v = fmaxf(v, __shfl_xor(v, o));
    return v;
}

__device__ __forceinline__ void d_rmsnorm(const int vb, const int vtid, char* lds, const float* x, const float* g, bf16_t* ob, float* of, int rows) {
    const int row = vb * 4 + (vtid >> 6), lane = vtid & 63;
    if (row >= rows) return;
    const float4* xr = (const float4*)(x + (size_t)row * DM);
    float4 v[4]; float s = 0.f;
#pragma unroll
    for (int i = 0; i < 4; ++i) { v[i] = xr[lane + 64 * i]; s += v[i].x * v[i].x + v[i].y * v[i].y + v[i].z * v[i].z + v[i].w * v[i].w; }
    s = wave_sum(s);
    const float r = rsqrtf(s * (1.0f / DM) + EPS);
#pragma unroll
    for (int i = 0; i < 4; ++i) {
        const float4 gg = ((const float4*)g)[lane + 64 * i];
        float4 y; y.x = v[i].x * r * gg.x; y.y = v[i].y * r * gg.y; y.z = v[i].z * r * gg.z; y.w = v[i].w * r * gg.w;
        if (of) ((float4*)(of + (size_t)row * DM))[lane + 64 * i] = y;
        if (ob) { ushort4 o; o.x = f2bf(y.x); o.y = f2bf(y.y); o.z = f2bf(y.z); o.w = f2bf(y.w); ((ushort4*)(ob + (size_t)row * DM))[lane + 64 * i] = o; }
    }
}

template <int EPI>
__device__ __forceinline__ void d_gemm(const int vb, const int vtid, char* lds, const bf16_t* __restrict__ A, const float* __restrict__ B, int M, int N, int K, void* Cv, const float* R) {
    float (*As)[68] = (float (*)[68])lds; float (*Bs)[68] = (float (*)[68])(lds + 16 * 68 * 4);
    const int tid = vtid, tx = tid & 15, ty = tid >> 4; const int nbx = N / 64;
    const int m0 = (vb / nbx) * 64, n0 = (vb % nbx) * 64;
    float acc[4][4];
#pragma unroll
    for (int i = 0; i < 4; ++i)
#pragma unroll
        for (int j = 0; j < 4; ++j) acc[i][j] = 0.f;
    for (int k0 = 0; k0 < K; k0 += 16) {
        {   const int r = tid >> 2, c = (tid & 3) * 4;
            const ushort4 a = *(const ushort4*)(A + (size_t)(m0 + r) * K + k0 + c);
            As[c + 0][r] = bf2f(a.x); As[c + 1][r] = bf2f(a.y); As[c + 2][r] = bf2f(a.z); As[c + 3][r] = bf2f(a.w);
            const int kr = tid >> 4, nc = (tid & 15) * 4;
            const float4 b = *(const float4*)(B + (size_t)(k0 + kr) * N + n0 + nc);
            Bs[kr][nc + 0] = b.x; Bs[kr][nc + 1] = b.y; Bs[kr][nc + 2] = b.z; Bs[kr][nc + 3] = b.w; }
        __syncthreads();
#pragma unroll
        for (int kk = 0; kk < 16; ++kk) {
            float a[4], b[4];
#pragma unroll
            for (int i = 0; i < 4; ++i) { a[i] = As[kk][ty * 4 + i]; b[i] = Bs[kk][tx * 4 + i]; }
#pragma unroll
            for (int i = 0; i < 4; ++i)
#pragma unroll
                for (int j = 0; j < 4; ++j) acc[i][j] += a[i] * b[j];
        }
        __syncthreads();
    }
#pragma unroll
    for (int i = 0; i < 4; ++i) {
        const size_t off = (size_t)(m0 + ty * 4 + i) * N + n0 + tx * 4;
        if (EPI == 0) { ushort4 o; o.x = f2bf(acc[i][0]); o.y = f2bf(acc[i][1]); o.z = f2bf(acc[i][2]); o.w = f2bf(acc[i][3]); *(ushort4*)((bf16_t*)Cv + off) = o; }
        else if (EPI == 1) { const float4 r = *(const float4*)(R + off); float4 o; o.x = r.x + acc[i][0]; o.y = r.y + acc[i][1]; o.z = r.z + acc[i][2]; o.w = r.w + acc[i][3]; *(float4*)((float*)Cv + off) = o; }
        else { float4 o; o.x = acc[i][0]; o.y = acc[i][1]; o.z = acc[i][2]; o.w = acc[i][3]; *(float4*)((float*)Cv + off) = o; }
    }
}

__device__ __forceinline__ void d_sb_naive(const int vb, const int vtid, char* lds, const bf16_t* __restrict__ proj, const float* __restrict__ sbn, bf16_t* __restrict__ mix) {
    const int wv = vb * 4 + (vtid >> 6), lane = vtid & 63;
    const int t = wv & (SEQ - 1), h = (wv >> 11) & 7, b = wv >> 14;
    const size_t rowb = (size_t)b * SEQ;
    const float q = bf2f(proj[(rowb + t) * INC + h * 64 + lane]) * 0.125f;
    float run = 0.f, acc = 0.f;
    for (int s = t - 1; s >= 0; --s) {
        const bf16_t* pr = proj + (rowb + s) * INC + h * 64 + lane;
        const float z = wave_sum(q * bf2f(pr[512]));
        const float vd = bf2f(pr[1024]);
        const float lsz = fminf(z, 0.f) - log1pf(__expf(-fabsf(z)));
        const float a = __expf(lsz + run);
        acc += a * vd;
        run += lsz - z;
        if (run < -120.f) break;
    }
    const float ss = wave_sum(acc * acc);
    const float y = acc * rsqrtf(ss * (1.f / 64.f) + EPS) * sbn[h * 64 + lane];
    mix[(rowb + t) * DM + h * 64 + lane] = f2bf(y);
}

__device__ __forceinline__ void d_ret_naive(const int vb, const int vtid, char* lds, const bf16_t* __restrict__ proj, const float* __restrict__ rn, bf16_t* __restrict__ mix) {
    float* qs = (float*)lds; float* ks = qs + 128; float* vs = ks + 128; float (*red)[128] = (float (*)[128])(vs + 128); float* stat = vs + 128 + 256;
    const int bh = vb, b = bh >> 2, h = bh & 3, tid = vtid, half = tid >> 7, e = tid & 127;
    const float gamma = 1.0f - exp2f(-5.0f - (float)h);
    float st[64];
#pragma unroll
    for (int i = 0; i < 64; ++i) st[i] = 0.f;
    const float inv_i = exp2f(-((float)(2 * (tid & 63)) / 128.0f) * 13.287712379549449f);
    for (int t = 0; t < SEQ; ++t) {
        const bf16_t* pr = proj + ((size_t)b * SEQ + t) * INC;
        if (tid < 128) {
            const int i = tid & 63; const int base = (tid < 64 ? 1536 : 2048) + h * 128;
            const float x1 = bf2f(pr[base + i]), x2 = bf2f(pr[base + i + 64]);
            float sn, cs; sincosf((float)t * inv_i, &sn, &cs);
            const float o1 = x1 * cs - x2 * sn, o2 = x1 * sn + x2 * cs;
            if (tid < 64) { qs[i] = o1; qs[i + 64] = o2; } else { const float sc = 0.08838834764831845f; ks[i] = o1 * sc; ks[i + 64] = o2 * sc; }
        } else {
            vs[tid - 128] = bf2f(pr[2560 + h * 128 + (tid - 128)]);
        }
        __syncthreads();
        const float ve = vs[e]; float part = 0.f;
#pragma unroll
        for (int dd = 0; dd < 64; ++dd) { const int d = half * 64 + dd; st[dd] = gamma * st[dd] + ks[d] * ve; part += qs[d] * st[dd]; }
        red[half][e] = part;
        __syncthreads();
        float o = 0.f;
        if (tid < 128) { o = red[0][e] + red[1][e]; const float s1 = wave_sum(o); if ((tid & 63) == 0) stat[tid >> 6] = s1; }
        __syncthreads();
        float mu = 0.f, dlt = 0.f;
        if (tid < 128) { mu = (stat[0] + stat[1]) * (1.f / 128.f); dlt = o - mu; const float s2 = wave_sum(dlt * dlt); if ((tid & 63) == 0) stat[2 + (tid >> 6)] = s2; }
        __syncthreads();
        if (tid < 128) {
            const float var = (stat[2] + stat[3]) * (1.f / 128.f);
            const float g = bf2f(pr[3072 + h * 128 + e]);
            const float y = dlt * rsqrtf(var + EPS) * rn[h * 128 + e] * (g / (1.f + __expf(-g)));
            mix[((size_t)b * SEQ + t) * DM + 512 + h * 128 + e] = f2bf(y);
        }
        __syncthreads();
    }
}

__device__ __forceinline__ void d_xattn_naive(const int vb, const int vtid, char* lds, const bf16_t* __restrict__ Q, const bf16_t* __restrict__ KV, bf16_t* __restrict__ O) {
    float (*qsh)[256] = (float (*)[256])lds; float (*psh)[256] = (float (*)[256])(lds + 4096);
    const int w = vtid >> 6, lane = vtid & 63;
    const int wv = vb * 4 + w, h = wv & 3, t = wv >> 2, b = t >> 11;
    const bf16_t* qr = Q + (size_t)t * DM + h * 256;
#pragma unroll
    for (int i = 0; i < 4; ++i) qsh[w][lane + 64 * i] = bf2f(qr[lane + 64 * i]);
    __syncthreads();
    float s[4];
#pragma unroll
    for (int i = 0; i < 4; ++i) {
        const int m = lane + 64 * i; const bf16_t* kr = KV + ((size_t)b * NMEM + m) * 2048 + h * 256;
        float a = 0.f;
#pragma unroll 4
        for (int d = 0; d < 256; d += 4) { const ushort4 k4 = *(const ushort4*)(kr + d); a += qsh[w][d] * bf2f(k4.x) + qsh[w][d + 1] * bf2f(k4.y) + qsh[w][d + 2] * bf2f(k4.z) + qsh[w][d + 3] * bf2f(k4.w); }
        s[i] = a * 0.0625f;
    }
    const float mx = wave_max(fmaxf(fmaxf(s[0], s[1]), fmaxf(s[2], s[3])));
    float p[4], sum = 0.f;
#pragma unroll
    for (int i = 0; i < 4; ++i) { p[i] = __expf(s[i] - mx); sum += p[i]; }
    sum = wave_sum(sum);
    const float inv = 1.f / sum;
#pragma unroll
    for (int i = 0; i < 4; ++i) psh[w][lane + 64 * i] = p[i] * inv;
    __syncthreads();
    float o[4] = {0.f, 0.f, 0.f, 0.f};
#pragma unroll 4
    for (int m = 0; m < NMEM; ++m) {
        const ushort4 v4 = *(const ushort4*)(KV + ((size_t)b * NMEM + m) * 2048 + 1024 + h * 256 + lane * 4);
        const float pm = psh[w][m];
        o[0] += pm * bf2f(v4.x); o[1] += pm * bf2f(v4.y); o[2] += pm * bf2f(v4.z); o[3] += pm * bf2f(v4.w);
    }
    ushort4 ov; ov.x = f2bf(o[0]); ov.y = f2bf(o[1]); ov.z = f2bf(o[2]); ov.w = f2bf(o[3]);
    *(ushort4*)(O + (size_t)t * DM + h * 256 + lane * 4) = ov;
}

__device__ __forceinline__ void wave_argmax(float& v, int& i) {
#pragma unroll
    for (int o = 1; o < 64; o <<= 1) {
        const float ov = __shfl_xor(v, o); const int oi = __shfl_xor(i, o);
        if (ov > v || (ov == v && oi < i)) { v = ov; i = oi; }
    }
}
__device__ __forceinline__ void d_peer_topk_naive(const int vb, const int vtid, char* lds, const float* __restrict__ PQ, const float* __restrict__ keys, int* __restrict__ idx, float* __restrict__ gate) {
    float (*qsh)[256] = (float (*)[256])lds;
    const int w = vtid >> 6, lane = vtid & 63;
    const int wv = vb * 4 + w, h = wv & 7, t = wv >> 3;
    const float* qr = PQ + (size_t)t * 2048 + h * 256;
#pragma unroll
    for (int i = 0; i < 4; ++i) qsh[w][lane + 64 * i] = qr[lane + 64 * i];
    __syncthreads();
    float tops[2] = {0.f, 0.f}; int topi[2] = {0, 0};
#pragma unroll
    for (int p = 0; p < 2; ++p) {
        float sc[2];
#pragma unroll
        for (int j = 0; j < 2; ++j) {
            const int k = lane + 64 * j; const float* kr = keys + ((size_t)(h * 2 + p) * 128 + k) * 128;
            float a = 0.f;
#pragma unroll 4
            for (int d = 0; d < 128; d += 4) { const float4 k4 = *(const float4*)(kr + d); a += qsh[w][p * 128 + d] * k4.x + qsh[w][p * 128 + d + 1] * k4.y + qsh[w][p * 128 + d + 2] * k4.z + qsh[w][p * 128 + d + 3] * k4.w; }
            sc[j] = a;
        }
#pragma unroll 1
        for (int r = 0; r < 16; ++r) {
            float v; int i;
            if (sc[0] >= sc[1]) { v = sc[0]; i = lane; } else { v = sc[1]; i = lane + 64; }
            wave_argmax(v, i);
            if (lane == r) { tops[p] = v; topi[p] = i; }
            if (i == lane) sc[0] = -INFINITY; else if (i == lane + 64) sc[1] = -INFINITY;
        }
    }
    float cs[4]; int ce[4];
#pragma unroll
    for (int q = 0; q < 4; ++q) {
        const int c = lane + 64 * q, i = c >> 4, j = c & 15;
        cs[q] = __shfl(tops[0], i) + __shfl(tops[1], j);
        ce[q] = __shfl(topi[0], i) * 128 + __shfl(topi[1], j);
    }
    float bs = 0.f; int be = 0;
#pragma unroll 1
    for (int r = 0; r < 16; ++r) {
        float v = cs[0]; int c = lane;
#pragma unroll
        for (int q = 1; q < 4; ++q) if (cs[q] > v) { v = cs[q]; c = lane + 64 * q; }
        wave_argmax(v, c);
        int e = 0;
#pragma unroll
        for (int q = 0; q < 4; ++q) { const int eq = __shfl(ce[q], c & 63); if ((c >> 6) == q) e = eq; }
        if (lane == r) { bs = v; be = e; }
        if ((c & 63) == lane) {
#pragma unroll
            for (int q = 0; q < 4; ++q) if ((c >> 6) == q) cs[q] = -INFINITY;
        }
    }
    const float mx = __shfl(bs, 0);
    const float ex = lane < 16 ? __expf(bs - mx) : 0.f;
    const float sum = wave_sum(ex);
    if (lane < 16) { idx[(size_t)t * 128 + h * 16 + lane] = be; gate[(size_t)t * 128 + h * 16 + lane] = ex / sum; }
}

__device__ __forceinline__ void d_peer_gather_naive(const int vb, const int vtid, char* lds, const bf16_t* __restrict__ H, const float* __restrict__ U, const float* __restrict__ V, const int* __restrict__ idx, const float* __restrict__ gate, float* XR) {
    const int t = vb * 4 + (vtid >> 6), lane = vtid & 63;
    float4 hv[4], acc[4];
#pragma unroll
    for (int i = 0; i < 4; ++i) { const ushort4 a = ((const ushort4*)(H + (size_t)t * DM))[lane + 64 * i]; hv[i].x = bf2f(a.x); hv[i].y = bf2f(a.y); hv[i].z = bf2f(a.z); hv[i].w = bf2f(a.w); acc[i] = make_float4(0.f, 0.f, 0.f, 0.f); }
    const int i0 = idx[(size_t)t * 128 + lane], i1 = idx[(size_t)t * 128 + 64 + lane];
    const float g0 = gate[(size_t)t * 128 + lane], g1 = gate[(size_t)t * 128 + 64 + lane];
#pragma unroll 2
    for (int p = 0; p < 128; ++p) {
        const int e = __shfl(p < 64 ? i0 : i1, p & 63); const float g = __shfl(p < 64 ? g0 : g1, p & 63);
        const float4* ur = (const float4*)(U + (size_t)e * DM); const float4* vr = (const float4*)(V + (size_t)e * DM);
        float a = 0.f;
#pragma unroll
        for (int i = 0; i < 4; ++i) { const float4 u = ur[lane + 64 * i]; a += hv[i].x * u.x + hv[i].y * u.y + hv[i].z * u.z + hv[i].w * u.w; }
        a = wave_sum(a);
        const float wgt = g * 0.5f * a * (1.f + erff(a * 0.7071067811865476f));
#pragma unroll
        for (int i = 0; i < 4; ++i) { const float4 v = vr[lane + 64 * i]; acc[i].x += wgt * v.x; acc[i].y += wgt * v.y; acc[i].z += wgt * v.z; acc[i].w += wgt * v.w; }
    }
    float4* xr = (float4*)(XR + (size_t)t * DM);
#pragma unroll
    for (int i = 0; i < 4; ++i) { float4 x = xr[lane + 64 * i]; x.x += acc[i].x; x.y += acc[i].y; x.z += acc[i].z; x.w += acc[i].w; xr[lane + 64 * i] = x; }
}

struct Params { const float* in[18]; float* out; char* ws; };
constexpr int LDS_BYTES = 147456;
#define VB_LOOP(nvb) for (int vb = blockIdx.x * 2 + (int)(threadIdx.x >> 8); vb < (nvb); vb += gridDim.x * 2)

__global__ void __launch_bounds__(512, 2) mega(Params p) {
    extern __shared__ __attribute__((aligned(16))) char lds_all[];
    cg::grid_group grid = cg::this_grid();
    const int vtid = threadIdx.x & 255; char* lds = lds_all + (threadIdx.x >> 8) * 32768;
    const float* x = p.in[0]; const float* mem = p.in[1];
    const float* mix_norm = p.in[2]; const float* w_in = p.in[3];
    const float* sb_norm = p.in[4]; const float* ret_norm = p.in[5];
    const float* w_out = p.in[6]; const float* xa_norm = p.in[7];
    const float* mem_norm = p.in[8]; const float* xa_wq = p.in[9];
    const float* xa_wkv = p.in[10]; const float* xa_wo = p.in[11];
    const float* peer_norm = p.in[12]; const float* peer_wq = p.in[13];
    const float* peer_keys = p.in[14]; const float* peer_u = p.in[15];
    const float* peer_v = p.in[16]; const float* final_norm = p.in[17];
    float* XR = p.out;
    char* ws = p.ws; const size_t MiB = 1u << 20;
    bf16_t* H = (bf16_t*)(ws + 0);
    bf16_t* PROJ = (bf16_t*)(ws + 64 * MiB);
    bf16_t* MIX = (bf16_t*)(ws + 288 * MiB);
    float* PQ = (float*)(ws + 64 * MiB);
    bf16_t* Q = (bf16_t*)(ws + 64 * MiB);
    bf16_t* O = (bf16_t*)(ws + 128 * MiB);
    int* IDX = (int*)(ws + 352 * MiB);
    float* GATE = (float*)(ws + 368 * MiB);
    bf16_t* MEMH = (bf16_t*)(ws + 384 * MiB);
    bf16_t* KV = (bf16_t*)(ws + 392 * MiB);
    for (int l = 0; l < NL; ++l) {
        const float* src = l == 0 ? x : XR;
        VB_LOOP(T / 4) d_rmsnorm(vb, vtid, lds, src, mix_norm + l * DM, H, nullptr, T);
        VB_LOOP(NB * NMEM / 4) d_rmsnorm(vb, vtid, lds, mem, mem_norm + l * DM, MEMH, nullptr, NB * NMEM);
        grid.sync();
        VB_LOOP((INC / 64) * (T / 64)) d_gemm<0>(vb, vtid, lds, H, w_in + (size_t)l * DM * INC, T, INC, DM, PROJ, nullptr);
        VB_LOOP((2048 / 64) * (NB * NMEM / 64)) d_gemm<0>(vb, vtid, lds, MEMH, xa_wkv + (size_t)l * DM * 2048, NB * NMEM, 2048, DM, KV, nullptr);
        grid.sync();
        VB_LOOP(NB * 4) d_ret_naive(vb, vtid, lds, PROJ, ret_norm + l * 512, MIX);
        VB_LOOP(NB * 8 * SEQ / 4) d_sb_naive(vb, vtid, lds, PROJ, sb_norm + l * 512, MIX);
        grid.sync();
        VB_LOOP((DM / 64) * (T / 64)) d_gemm<1>(vb, vtid, lds, MIX, w_out + (size_t)l * DM * DM, T, DM, DM, XR, src);
        grid.sync();
        VB_LOOP(T / 4) d_rmsnorm(vb, vtid, lds, XR, xa_norm + l * DM, H, nullptr, T);
        grid.sync();
        VB_LOOP((DM / 64) * (T / 64)) d_gemm<0>(vb, vtid, lds, H, xa_wq + (size_t)l * DM * DM, T, DM, DM, Q, nullptr);
        grid.sync();
        VB_LOOP(T) d_xattn_naive(vb, vtid, lds, Q, KV, O);
        grid.sync();
        VB_LOOP((DM / 64) * (T / 64)) d_gemm<1>(vb, vtid, lds, O, xa_wo + (size_t)l * DM * DM, T, DM, DM, XR, XR);
        grid.sync();
        VB_LOOP(T / 4) d_rmsnorm(vb, vtid, lds, XR, peer_norm + l * DM, H, nullptr, T);
        grid.sync();
        VB_LOOP((2048 / 64) * (T / 64)) d_gemm<2>(vb, vtid, lds, H, peer_wq + (size_t)l * DM * 2048, T, 2048, DM, PQ, nullptr);
        grid.sync();
        VB_LOOP(T * 2) d_peer_topk_naive(vb, vtid, lds, PQ, peer_keys + (size_t)l * 8 * 2 * 128 * 128, IDX, GATE);
        grid.sync();
        VB_LOOP(T / 4) d_peer_gather_naive(vb, vtid, lds, H, peer_u + (size_t)l * 16384 * DM, peer_v + (size_t)l * 16384 * DM, IDX, GATE, XR);
        grid.sync();
    }
    VB_LOOP(T / 4) d_rmsnorm(vb, vtid, lds, XR, final_norm, nullptr, XR, T);
}

extern "C" void kernel_launch(void* const* d_in, const int* in_sizes, int n_in, void* d_out, int out_size, void* d_ws, size_t ws_size, hipStream_t stream) {
    static int grid_blocks = 0;
    if (grid_blocks == 0) {
        int dev = 0, cus = 0, per_cu = 0;
        (void)hipGetDevice(&dev);
        (void)hipDeviceGetAttribute(&cus, hipDeviceAttributeMultiprocessorCount, dev);
        (void)hipFuncSetAttribute((const void*)mega, hipFuncAttributeMaxDynamicSharedMemorySize, LDS_BYTES);
        (void)hipOccupancyMaxActiveBlocksPerMultiprocessor(&per_cu, (const void*)mega, 512, LDS_BYTES);
        if (per_cu < 1) { fprintf(stderr, "occupancy query says %d blocks/CU\n", per_cu); per_cu = 1; }
        grid_blocks = cus * per_cu;
        if (ws_size < (size_t)420 * (1u << 20) || n_in != 18) { fprintf(stderr, "bad ws_size %zu / n_in %d\n", ws_size, n_in); grid_blocks = -1; }
    }
    if (grid_blocks < 0) return;
    Params p{};
    for (int i = 0; i < 18; ++i) p.in[i] = (const float*)d_in[i];
    p.out = (float*)d_out; p.ws = (char*)d_ws;
    void* args[] = {&p};
    hipError_t e = hipLaunchCooperativeKernel((const void*)mega, dim3(grid_blocks), dim3(512), args, LDS_BYTES, stream);
    if (e != hipSuccess) fprintf(stderr, "cooperative launch failed: %s (grid %d)\n", hipGetErrorString(e), grid_blocks);
}
```

```cpp
#include <hip/hip_runtime.h>
#include <hip/hip_cooperative_groups.h>
#include <stdint.h>
#include <cstdio>
namespace cg = cooperative_groups;

typedef unsigned short bf16_t;
__device__ __forceinline__ float bf2f(bf16_t v) { return __uint_as_float(((unsigned)v) << 16); }
__device__ __forceinline__ bf16_t f2bf(float f) { unsigned u = __float_as_uint(f); u = (u + 0x7fffu + ((u >> 16) & 1u)) >> 16; return (bf16_t)u; }
__device__ __forceinline__ unsigned pk2bf(float lo, float hi) { return (unsigned)f2bf(lo) | ((unsigned)f2bf(hi) << 16); }
__device__ __forceinline__ unsigned short f2h(float f) { _Float16 h = (_Float16)f; return __builtin_bit_cast(unsigned short, h); }
__device__ __forceinline__ float h2f(unsigned short u) { return (float)__builtin_bit_cast(_Float16, u); }

constexpr int NB = 16, SEQ = 2048, DM = 1024, T = NB * SEQ, NL = 2, NMEM = 256, INC = 3584, MROWS = NB * NMEM;
constexpr float EPS = 1e-6f;

__device__ __forceinline__ float wave_sum(float v) {
#pragma unroll
    for (int o = 1; o < 64; o <<= 1) v += __shfl_xor(v, o);
    return v;
}
__device__ __forceinline__ float wave_max(float v) {
#pragma unroll
    for (int o = 1; o < 64; o <<= 1) v = fmaxf(v, __shfl_xor(v, o));
    return v;
}
namespace pg8 {
#define PG8_LAS __attribute__((address_space(3)))
typedef unsigned short bf16_t;
typedef short bf16x8 __attribute__((ext_vector_type(8)));
typedef float f32x4 __attribute__((ext_vector_type(4)));
typedef unsigned u32x4 __attribute__((ext_vector_type(4)));
constexpr int BM = 256, BK = 64, HALF = 128, HTB = HALF * BK * 2  , STAGE_BYTES = 8 * HTB, NXCD = 8, WGM = 8;

__host__ __device__ __forceinline__ int lds_byte(int r, int c) { const int st = (r >> 4) * 2 + (c >> 5), rr = r & 15, cc = c & 31, ob = rr * 64 + cc * 2; return st * 1024 + (ob ^ (((ob >> 9) & 1) << 5)); }
__host__ __device__ __forceinline__ void stage_rc(int b, int& R, int& C) { const int st = b / 1024, sb = b % 1024, swz = sb ^ (((sb >> 9) & 1) << 5); R = (st >> 1) * 16 + swz / 64; C = (st & 1) * 32 + (swz % 64) / 2; }
__host__ __device__ __forceinline__ int perm32(int rho) { const int n = rho >> 4, i = rho & 15; return 8 * (i >> 2) + 4 * n + (i & 3); }

struct Unit { int pm, pn; };
struct Gemm { const bf16_t* A; const bf16_t* Bt; int M, N, K; };

struct StaticOrder {
    int nM, nN, nwg, G, c;
    __host__ __device__ void init(int M, int N, int G_, int c_, int tid_in, const float* ssq = nullptr, PG8_LAS float* rb = nullptr) { tidm = tid_in; SSQ = ssq; rbuf = rb; nM = M / BM; nN = N / BM; nwg = nM * nN; G = G_; c = c_; }
    __host__ __device__ bool next(int i, Unit& u) const {
        const long L = (long)i * G + c; if (L >= nwg) return false;
        int wgid = (int)L; { const int q = nwg / NXCD, r = nwg % NXCD, xcd = wgid % NXCD, off = wgid / NXCD; wgid = (xcd < r ? xcd * (q + 1) : r * (q + 1) + (xcd - r) * q) + off; }
        const int nig = WGM * nN, gid = wgid / nig, fm = gid * WGM, gsz = (nM - fm) < WGM ? (nM - fm) : WGM;
        u.pm = fm + ((wgid % nig) % gsz); u.pn = (wgid % nig) / gsz; return true;
    }
    int tidm; const float* SSQ; PG8_LAS float* rbuf;
    __device__ __forceinline__ void a_ready(const Unit& u, int ui) const {
        if (SSQ) { const int t = tidm; if (t < 256) { const f32x4* p = (const f32x4*)(SSQ + (size_t)(u.pm * BM + t) * 16); const f32x4 a = p[0], b = p[1], c = p[2], d = p[3];
            const float q = ((a[0] + a[1]) + (a[2] + a[3])) + ((b[0] + b[1]) + (b[2] + b[3])) + ((c[0] + c[1]) + (c[2] + c[3])) + ((d[0] + d[1]) + (d[2] + d[3]));
            rbuf[(ui & 1) * 256 + t] = rsqrtf(q * (1.0f / 1024.0f) + 1e-6f); } }
    }
    __device__ __forceinline__ void done(const Unit&) const {}
};

__device__ __forceinline__ unsigned cvt_pk_bf16(float lo, float hi) { unsigned r; asm volatile("v_cvt_pk_bf16_f32 %0, %1, %2" : "=v"(r) : "v"(lo), "v"(hi)); return r; }
typedef float f32x2 __attribute__((ext_vector_type(2)));
template <class Epi, class Sched, bool ALIGN_EPI = false, bool SP2 = false>
__device__ __forceinline__ void gemm_phase(PG8_LAS unsigned char* lds, const Gemm g, const Sched& S, const Epi& E, const int tid_in) {
    const int tid = tid_in, wid = __builtin_amdgcn_readfirstlane(tid >> 6), lane = tid & 63, wr = wid >> 2, wc = wid & 3, fr = lane & 15, fq = lane >> 4;
    const int K = g.K, nt = K / BK;
    unsigned voffA[2], voffB[2];
#pragma unroll
    for (int i = 0; i < 2; ++i) { int R, C; stage_rc(tid * 16 + i * 8192, R, C); const int Rb = Epi::PERM ? ((R & ~31) + perm32(R & 31)) : R;
        voffA[i] = (unsigned)(R * K + C) * 2u; voffB[i] = (unsigned)(Rb * K + C) * 2u; }
    const size_t kstep = (size_t)(BK * 2);
    const size_t hstep = (size_t)HALF * K * 2;
    const size_t tstep = 2 * hstep;
    const unsigned ldsw = (unsigned)wid * 1024u;
    const int aoff = lds_byte(wr * 64 + fr, fq * 8), boff = lds_byte(wc * 32 + fr, fq * 8);
#define PG8_SA(b, h) (((b) * 2 + (h)) * HTB)
#define PG8_SB(b, h) ((4 + (b) * 2 + (h)) * HTB)
#define PG8_STAGE(bufoff, gbase, voff) do { _Pragma("unroll") for (int _i = 0; _i < 2; ++_i) \
        __builtin_amdgcn_global_load_lds((const unsigned*)((const char*)(gbase) + (voff)[_i]), (PG8_LAS unsigned*)(lds + (bufoff) + ldsw + _i * 8192), 16, 0, 0); } while (0)
#define PG8_LDA(dst, b, h) do { _Pragma("unroll") for (int m = 0; m < 4; ++m) _Pragma("unroll") for (int k = 0; k < 2; ++k) dst[m][k] = *(const PG8_LAS bf16x8*)(lds + PG8_SA(b, h) + aoff + m * 2048 + k * 1024); } while (0)
#define PG8_LDB(dst, b, h) do { _Pragma("unroll") for (int n = 0; n < 2; ++n) _Pragma("unroll") for (int k = 0; k < 2; ++k) dst[n][k] = *(const PG8_LAS bf16x8*)(lds + PG8_SB(b, h) + boff + n * 2048 + k * 1024); } while (0)
#define PG8_MMA(ai, bj, At, Bt) do { __builtin_amdgcn_s_setprio(1); _Pragma("unroll") for (int m = 0; m < 4; ++m) _Pragma("unroll") for (int n = 0; n < 2; ++n) _Pragma("unroll") for (int k = 0; k < 2; ++k) \
        acc[ai][bj][m][n] = __builtin_amdgcn_mfma_f32_16x16x32_bf16(Bt[n][k], At[m][k], acc[ai][bj][m][n], 0, 0, 0); __builtin_amdgcn_s_setprio(0); } while (0)
#define PG8_WAIT_V(n) asm volatile("s_waitcnt vmcnt(" #n ")" ::: "memory")
#define PG8_WAIT_L(n) asm volatile("s_waitcnt lgkmcnt(" #n ")" ::: "memory")
#define PG8_BAR __builtin_amdgcn_s_barrier()
#define PG8_SCHED __builtin_amdgcn_sched_barrier(0)
    Unit cur, nxt; int ui = 0;
    if (!S.next(0, cur)) return;
    f32x4 acc[2][2][4][2];
#pragma unroll
    for (int a = 0; a < 2; ++a)
#pragma unroll
        for (int b = 0; b < 2; ++b)
#pragma unroll
            for (int m = 0; m < 4; ++m)
#pragma unroll
                for (int n = 0; n < 2; ++n) acc[a][b][m][n] = (f32x4){0.f, 0.f, 0.f, 0.f};
    bf16x8 At[4][2], B0[2][2], B1[2][2];
    const char* cA = (const char*)g.A + (size_t)cur.pm * tstep; const char* cB = (const char*)g.Bt + (size_t)cur.pn * tstep;
    S.a_ready(cur, 0);
    if constexpr (SP2) {
        PG8_STAGE(PG8_SB(0, 0), cB, voffB); PG8_STAGE(PG8_SB(0, 1), cB + hstep, voffB); PG8_STAGE(PG8_SA(0, 0), cA, voffA); PG8_STAGE(PG8_SA(0, 1), cA + hstep, voffA);
        if (wr == 1) PG8_BAR;
        PG8_WAIT_V(2); PG8_BAR;
        PG8_STAGE(PG8_SB(1, 0), cB + kstep, voffB); PG8_STAGE(PG8_SA(1, 0), cA + kstep, voffA); PG8_STAGE(PG8_SB(1, 1), cB + hstep + kstep, voffB);
        PG8_WAIT_V(6); PG8_BAR;
    } else {
        PG8_STAGE(PG8_SB(0, 0), cB, voffB); PG8_STAGE(PG8_SA(0, 0), cA, voffA); PG8_STAGE(PG8_SB(0, 1), cB + hstep, voffB); PG8_STAGE(PG8_SA(0, 1), cA + hstep, voffA);
        if (wr == 1) PG8_BAR;
        PG8_WAIT_V(4); PG8_BAR;
        PG8_STAGE(PG8_SB(1, 0), cB + kstep, voffB); PG8_STAGE(PG8_SA(1, 0), cA + kstep, voffA); PG8_STAGE(PG8_SB(1, 1), cB + hstep + kstep, voffB);
        PG8_WAIT_V(6); PG8_BAR;
    }
    for (;;) {
        const bool has_next = S.next(ui + 1, nxt);
        const char* nA = has_next ? (const char*)g.A + (size_t)nxt.pm * tstep : cA; const char* nB = has_next ? (const char*)g.Bt + (size_t)nxt.pn * tstep : cB;
        for (int t = 0; t < nt; t += 2) {
            const bool last = (t == nt - 2);
            const char* a1 = cA + (size_t)(t + 1) * kstep;
            const char* a2 = last ? nA : cA + (size_t)(t + 2) * kstep; const char* b2 = last ? nB : cB + (size_t)(t + 2) * kstep;
            const char* a3 = a2 + kstep; const char* b3 = b2 + kstep;
            if (last && has_next) S.a_ready(nxt, ui + 1);
            if constexpr (SP2) {
            PG8_LDB(B0, 0, 0); PG8_LDB(B1, 0, 1); PG8_SCHED; PG8_LDA(At, 0, 0); PG8_STAGE(PG8_SA(1, 1), a1 + hstep, voffA);
            PG8_WAIT_V(8); PG8_WAIT_L(0); PG8_BAR; PG8_MMA(0, 0, At, B0); PG8_MMA(0, 1, At, B1); PG8_BAR; PG8_SCHED;
            PG8_LDA(At, 0, 1); PG8_STAGE(PG8_SB(0, 0), b2, voffB); PG8_STAGE(PG8_SB(0, 1), b2 + hstep, voffB); PG8_STAGE(PG8_SA(0, 0), a2, voffA);
            PG8_WAIT_V(8); PG8_WAIT_L(0); PG8_BAR; PG8_MMA(1, 0, At, B0); PG8_MMA(1, 1, At, B1); PG8_BAR; PG8_SCHED;
            PG8_LDB(B0, 1, 0); PG8_LDB(B1, 1, 1); PG8_SCHED; PG8_LDA(At, 1, 0); PG8_STAGE(PG8_SA(0, 1), a2 + hstep, voffA);
            PG8_WAIT_V(8); PG8_WAIT_L(0); PG8_BAR; PG8_MMA(0, 0, At, B0); PG8_MMA(0, 1, At, B1); PG8_BAR; PG8_SCHED;
            PG8_LDA(At, 1, 1); PG8_STAGE(PG8_SB(1, 0), b3, voffB); PG8_STAGE(PG8_SB(1, 1), b3 + hstep, voffB); PG8_STAGE(PG8_SA(1, 0), a3, voffA);
            PG8_WAIT_V(8); PG8_WAIT_L(0); PG8_BAR; PG8_MMA(1, 0, At, B0); PG8_MMA(1, 1, At, B1); PG8_BAR; PG8_SCHED;
            } else {
            PG8_LDB(B0, 0, 0); PG8_SCHED; PG8_LDA(At, 0, 0); PG8_STAGE(PG8_SA(1, 1), a1 + hstep, voffA);
            PG8_WAIT_L(8); PG8_BAR; PG8_WAIT_L(0); PG8_MMA(0, 0, At, B0); PG8_BAR; PG8_SCHED;
            PG8_LDB(B1, 0, 1); PG8_STAGE(PG8_SB(0, 0), b2, voffB);
            PG8_BAR; PG8_WAIT_L(0); PG8_MMA(0, 1, At, B1); PG8_BAR;
            PG8_LDA(At, 0, 1); PG8_STAGE(PG8_SA(0, 0), a2, voffA);
            PG8_BAR; PG8_WAIT_L(0); PG8_MMA(1, 0, At, B0); PG8_BAR; PG8_SCHED;
            PG8_STAGE(PG8_SB(0, 1), b2 + hstep, voffB);
            PG8_WAIT_V(6); PG8_BAR; PG8_MMA(1, 1, At, B1); PG8_BAR;
            PG8_LDB(B0, 1, 0); PG8_SCHED; PG8_LDA(At, 1, 0); PG8_STAGE(PG8_SA(0, 1), a2 + hstep, voffA);
            PG8_WAIT_L(8); PG8_BAR; PG8_WAIT_L(0); PG8_MMA(0, 0, At, B0); PG8_BAR; PG8_SCHED;
            PG8_LDB(B1, 1, 1); PG8_STAGE(PG8_SB(1, 0), b3, voffB);
            PG8_BAR; PG8_WAIT_L(0); PG8_MMA(0, 1, At, B1); PG8_BAR;
            PG8_LDA(At, 1, 1); PG8_STAGE(PG8_SA(1, 0), a3, voffA);
            PG8_BAR; PG8_WAIT_L(0); PG8_MMA(1, 0, At, B0); PG8_BAR; PG8_SCHED;
            PG8_STAGE(PG8_SB(1, 1), b3 + hstep, voffB);
            PG8_WAIT_V(6); PG8_BAR; PG8_MMA(1, 1, At, B1); PG8_BAR;
            }
        }
        if constexpr (ALIGN_EPI) { if (wr == 0) PG8_BAR; }
        if constexpr (!Epi::AFTER_DRAIN) { E(acc, cur, wr, wc, fr, fq, ui); S.done(cur); }
        if (!has_next) break;
#pragma unroll
        for (int a = 0; a < 2; ++a)
#pragma unroll
            for (int b = 0; b < 2; ++b)
#pragma unroll
                for (int m = 0; m < 4; ++m)
#pragma unroll
                    for (int n = 0; n < 2; ++n) acc[a][b][m][n] = (f32x4){0.f, 0.f, 0.f, 0.f};
        cur = nxt; cA = nA; cB = nB; ++ui;
        if constexpr (ALIGN_EPI) { if (wr == 1) PG8_BAR; }
    }
    PG8_WAIT_V(0);
    if constexpr (!ALIGN_EPI) { if (wr == 0) PG8_BAR; }
    PG8_BAR;
    if constexpr (Epi::AFTER_DRAIN) { E.fused(acc, cur, wr, wc, fr, fq, lds, wid, lane); S.done(cur); }
#undef PG8_SA
#undef PG8_SB
#undef PG8_STAGE
#undef PG8_LDA
#undef PG8_LDB
#undef PG8_MMA
#undef PG8_WAIT_V
#undef PG8_WAIT_L
#undef PG8_BAR
#undef PG8_SCHED
}
}
namespace pg8 {
struct EpiProj {
    static constexpr bool PERM = true, AFTER_DRAIN = false;
    bf16_t* MIXQ; bf16_t* PROJ2; const PG8_LAS float* rbuf;
    __device__ __forceinline__ void operator()(const f32x4 (&acc)[2][2][4][2], const Unit& u, int wr, int wc, int fr, int fq, int ui) const {
        const int lr0 = wr * 64 + fr, row0 = u.pm * BM + lr0; const int pn = u.pn;
        const PG8_LAS float* rb = rbuf + (ui & 1) * 256 + lr0;
        bf16_t* base; int ld, colt, mode;
        if (pn < 2) { base = MIXQ; ld = 1024; colt = pn * 256; mode = 1; }
        else if (pn < 6) { base = PROJ2; ld = 2560; colt = (pn - 2) * 256; mode = 0; }
        else if (pn < 8) { base = MIXQ; ld = 1024; colt = 512 + (pn - 6) * 256; mode = 2; }
        else if (pn < 10) { base = PROJ2; ld = 2560; colt = 1024 + (pn - 8) * 256; mode = 3; }
        else { base = PROJ2; ld = 2560; colt = 1536 + (pn - 10) * 256; mode = 0; }
        const float sc = mode == 1 ? 0.125f : (mode == 3 ? 0.08838834764831845f : 1.0f);
        const int col0 = colt + wc * 32 + 8 * fq; const int i0 = wc * 16 + 4 * fq;
        if (mode < 2) {
#pragma unroll
            for (int ai = 0; ai < 2; ++ai)
#pragma unroll
                for (int m = 0; m < 4; ++m) {
                    const int row = row0 + ai * HALF + m * 16; const float r = rb[ai * HALF + m * 16] * sc;
#pragma unroll
                    for (int bj = 0; bj < 2; ++bj) {
                        const f32x4 v0 = acc[ai][bj][m][0] * r, v1 = acc[ai][bj][m][1] * r;
                        u32x4 w; w.x = pk2bf(v0[0], v0[1]); w.y = pk2bf(v0[2], v0[3]); w.z = pk2bf(v1[0], v1[1]); w.w = pk2bf(v1[2], v1[3]);
                        *(u32x4*)(base + (size_t)row * ld + col0 + bj * HALF) = w;
                    }
                }
        } else {
            float f[4];
#pragma unroll
            for (int jj = 0; jj < 4; ++jj) f[jj] = exp2f(-(float)(2 * (i0 + jj)) * (13.287712379549449f / 128.0f)) * 0.15915494309189535f;
#pragma unroll
            for (int ai = 0; ai < 2; ++ai)
#pragma unroll
                for (int m = 0; m < 4; ++m) {
                    const int row = row0 + ai * HALF + m * 16; const float r = rb[ai * HALF + m * 16] * sc; const float pos = (float)(row & (SEQ - 1));
                    float cs[4], sn[4];
#pragma unroll
                    for (int jj = 0; jj < 4; ++jj) { const float xr = __builtin_amdgcn_fractf(pos * f[jj]); cs[jj] = __builtin_amdgcn_cosf(xr); sn[jj] = __builtin_amdgcn_sinf(xr); }
#pragma unroll
                    for (int bj = 0; bj < 2; ++bj) {
                        const f32x4 a = acc[ai][bj][m][0] * r, b = acc[ai][bj][m][1] * r; f32x4 v0, v1;
                        v0[0] = a[0] * cs[0] - a[1] * sn[0]; v0[1] = a[0] * sn[0] + a[1] * cs[0];
                        v0[2] = a[2] * cs[1] - a[3] * sn[1]; v0[3] = a[2] * sn[1] + a[3] * cs[1];
                        v1[0] = b[0] * cs[2] - b[1] * sn[2]; v1[1] = b[0] * sn[2] + b[1] * cs[2];
                        v1[2] = b[2] * cs[3] - b[3] * sn[3]; v1[3] = b[2] * sn[3] + b[3] * cs[3];
                        u32x4 w; w.x = pk2bf(v0[0], v0[1]); w.y = pk2bf(v0[2], v0[3]); w.z = pk2bf(v1[0], v1[1]); w.w = pk2bf(v1[2], v1[3]);
                        *(u32x4*)(base + (size_t)row * ld + col0 + bj * HALF) = w;
                    }
                }
        }
    }
};
struct EpiResid {
    static constexpr bool PERM = false, AFTER_DRAIN = false;
    const float* src; float* XR; bf16_t* XB; float* SSQ;
    __device__ __forceinline__ void operator()(const f32x4 (&acc)[2][2][4][2], const Unit& u, int wr, int wc, int fr, int fq, int ui) const {
        const int row0 = u.pm * BM + wr * 64 + fr; const int col0 = u.pn * BM + wc * 32 + 4 * fq;
#pragma unroll
        for (int ai = 0; ai < 2; ++ai)
#pragma unroll
            for (int m = 0; m < 4; ++m) {
                const int row = row0 + ai * HALF + m * 16; float ss = 0.f;
#pragma unroll
                for (int bj = 0; bj < 2; ++bj)
#pragma unroll
                    for (int n = 0; n < 2; ++n) {
                        const size_t off = (size_t)row * 1024 + col0 + bj * HALF + n * 16;
                        const f32x4 o = *(const f32x4*)(src + off) + acc[ai][bj][m][n];
                        *(f32x4*)(XR + off) = o;
                        uint2 w; w.x = pk2bf(o[0], o[1]); w.y = pk2bf(o[2], o[3]); *(uint2*)(XB + off) = w;
                        ss += (o[0] * o[0] + o[1] * o[1]) + (o[2] * o[2] + o[3] * o[3]);
                    }
                ss += __shfl_xor(ss, 16); ss += __shfl_xor(ss, 32);
                if (fq == 0) SSQ[(size_t)row * 16 + u.pn * 4 + wc] = ss;
                if (m & 1) asm volatile("" ::: "memory");
            }
    }
};
template <bool F16> struct EpiScale {
    static constexpr bool PERM = true, AFTER_DRAIN = false;
    bf16_t* O; int ldc; const PG8_LAS float* rbuf; float scale;
    __device__ __forceinline__ void operator()(const f32x4 (&acc)[2][2][4][2], const Unit& u, int wr, int wc, int fr, int fq, int ui) const {
        const int lr0 = wr * 64 + fr, row0 = u.pm * BM + lr0; const int col0 = u.pn * BM + wc * 32 + 8 * fq;
        const PG8_LAS float* rb = rbuf + (ui & 1) * 256 + lr0;
#pragma unroll
        for (int ai = 0; ai < 2; ++ai)
#pragma unroll
            for (int m = 0; m < 4; ++m) {
                const int row = row0 + ai * HALF + m * 16; const float r = rb[ai * HALF + m * 16] * scale;
#pragma unroll
                for (int bj = 0; bj < 2; ++bj) {
                    const f32x4 v0 = acc[ai][bj][m][0] * r, v1 = acc[ai][bj][m][1] * r; u32x4 w;
                    if (F16) { w.x = (unsigned)f2h(v0[0]) | ((unsigned)f2h(v0[1]) << 16); w.y = (unsigned)f2h(v0[2]) | ((unsigned)f2h(v0[3]) << 16); w.z = (unsigned)f2h(v1[0]) | ((unsigned)f2h(v1[1]) << 16); w.w = (unsigned)f2h(v1[2]) | ((unsigned)f2h(v1[3]) << 16); }
                    else { w.x = pk2bf(v0[0], v0[1]); w.y = pk2bf(v0[2], v0[3]); w.z = pk2bf(v1[0], v1[1]); w.w = pk2bf(v1[2], v1[3]); }
                    *(u32x4*)(O + (size_t)row * ldc + col0 + bj * HALF) = w;
                }
            }
    }
};
}
__device__ __forceinline__ int win_colmap(int n) { if (n < 1536 || n >= 2560) return n; const int hb = n & ~127, j = n & 127; return hb + (j >> 1) + 64 * (j & 1); }
__device__ __forceinline__ void tr_item(const float* __restrict__ W, int K, int N, const float* __restrict__ g, bool perm, bf16_t* __restrict__ WT, float* scr, int item, int lane) {
    const int nblk = N / 32, kb = item / nblk, nb = item % nblk, k0 = 64 * kb, n0 = 32 * nb;
    const int nn = n0 + (lane & 31); const int ns = perm ? win_colmap(nn) : nn;
#pragma unroll 8
    for (int i = 0; i < 32; ++i) { const int kk = 2 * i + (lane >> 5); const float gg = g ? g[k0 + kk] : 1.0f; scr[kk * 33 + (lane & 31)] = W[(size_t)(k0 + kk) * N + ns] * gg; }
    asm volatile("s_waitcnt lgkmcnt(0)" ::: "memory");
    const int c = lane & 7;
#pragma unroll
    for (int j = 0; j < 4; ++j) { const int n = (lane >> 3) + 8 * j; const float* s = scr + (8 * c) * 33 + n;
        uint4 o; o.x = pk2bf(s[0 * 33], s[1 * 33]); o.y = pk2bf(s[2 * 33], s[3 * 33]); o.z = pk2bf(s[4 * 33], s[5 * 33]); o.w = pk2bf(s[6 * 33], s[7 * 33]);
        *(uint4*)(WT + (size_t)(n0 + n) * K + k0 + 8 * c) = o; }
    asm volatile("s_waitcnt lgkmcnt(0)" ::: "memory");
}
__device__ __forceinline__ void peer_fold_item(const float* __restrict__ wpq, const float* __restrict__ keys, const float* __restrict__ g, bf16_t* __restrict__ WPT, float* scr, int item, const int tid) {
    const int hp = item >> 4, k0 = (item & 15) * 64;
    float* ws_ = scr;
    float* ks_ = scr + 64 * 132;
    for (int i = tid; i < 64 * 32; i += 512) { const int kk = i >> 5, d4 = (i & 31) * 4; const float4 v = *(const float4*)(wpq + (size_t)(k0 + kk) * 2048 + hp * 128 + d4); const float gg = g[k0 + kk];
        float* o = ws_ + kk * 132 + d4; o[0] = v.x * gg; o[1] = v.y * gg; o[2] = v.z * gg; o[3] = v.w * gg; }
    for (int i = tid; i < 128 * 32; i += 512) { const int ky = i >> 5, d4 = (i & 31) * 4; const float4 v = *(const float4*)(keys + ((size_t)hp * 128 + ky) * 128 + d4);
        float* o = ks_ + ky * 132 + d4; o[0] = v.x; o[1] = v.y; o[2] = v.z; o[3] = v.w; }
    __syncthreads();
    const int key = tid & 127, kg = tid >> 7;
    float acc[16];
#pragma unroll
    for (int j = 0; j < 16; ++j) acc[j] = 0.f;
    for (int d = 0; d < 128; d += 4) {
        const float4 kv = *(const float4*)(ks_ + key * 132 + d);
#pragma unroll
        for (int j = 0; j < 16; ++j) { const float4 wv = *(const float4*)(ws_ + (kg * 16 + j) * 132 + d); acc[j] += kv.x * wv.x + kv.y * wv.y + kv.z * wv.z + kv.w * wv.w; }
    }
    uint4 o0, o1;
    o0.x = pk2bf(acc[0], acc[1]); o0.y = pk2bf(acc[2], acc[3]); o0.z = pk2bf(acc[4], acc[5]); o0.w = pk2bf(acc[6], acc[7]);
    o1.x = pk2bf(acc[8], acc[9]); o1.y = pk2bf(acc[10], acc[11]); o1.z = pk2bf(acc[12], acc[13]); o1.w = pk2bf(acc[14], acc[15]);
    uint4* dst = (uint4*)(WPT + (size_t)(hp * 128 + key) * 1024 + k0 + kg * 16);
    dst[0] = o0; dst[1] = o1;
    __syncthreads();
}
__device__ __forceinline__ void row_to_bf16_ssq(const float* __restrict__ xrow, bf16_t* __restrict__ orow, float* __restrict__ ssq, int lane) {
    const float4* xr = (const float4*)xrow; float s = 0.f;
#pragma unroll
    for (int i = 0; i < 4; ++i) { const float4 v = xr[lane + 64 * i]; s += (v.x * v.x + v.y * v.y) + (v.z * v.z + v.w * v.w);
        uint2 w; w.x = pk2bf(v.x, v.y); w.y = pk2bf(v.z, v.w); ((uint2*)orow)[lane + 64 * i] = w; }
    s = wave_sum(s);
    if (lane < 16) ssq[lane] = lane == 0 ? s : 0.f;
}
__device__ __forceinline__ void d_rmsnorm_final(const int vb, const int vtid, float* XR, const float* g) {
    const int row = vb * 4 + (vtid >> 6), lane = vtid & 63;
    float4* xr = (float4*)(XR + (size_t)row * DM);
    float4 v[4]; float s = 0.f;
#pragma unroll
    for (int i = 0; i < 4; ++i) { v[i] = xr[lane + 64 * i]; s += v[i].x * v[i].x + v[i].y * v[i].y + v[i].z * v[i].z + v[i].w * v[i].w; }
    s = wave_sum(s);
    const float r = rsqrtf(s * (1.0f / DM) + EPS);
#pragma unroll
    for (int i = 0; i < 4; ++i) { const float4 gg = ((const float4*)g)[lane + 64 * i];
        float4 y; y.x = v[i].x * r * gg.x; y.y = v[i].y * r * gg.y; y.z = v[i].z * r * gg.z; y.w = v[i].w * r * gg.w; xr[lane + 64 * i] = y; }
}
__device__ __forceinline__ void d_sb_naive(const int vb, const int vtid, bf16_t* MIXQ, const bf16_t* __restrict__ PROJ2, const float* __restrict__ sbn) {
    const int wv = vb * 4 + (vtid >> 6), lane = vtid & 63;
    const int t = wv & (SEQ - 1), h = (wv >> 11) & 7, b = wv >> 14;
    const size_t rowb = (size_t)b * SEQ;
    const float q = bf2f(MIXQ[(rowb + t) * DM + h * 64 + lane]);
    float run = 0.f, acc = 0.f;
    for (int s = t - 1; s >= 0; --s) {
        const bf16_t* pr = PROJ2 + (rowb + s) * 2560 + h * 64 + lane;
        const float z = wave_sum(q * bf2f(pr[0]));
        const float vd = bf2f(pr[512]);
        const float lsz = fminf(z, 0.f) - log1pf(__expf(-fabsf(z)));
        const float a = __expf(lsz + run);
        acc += a * vd;
        run += lsz - z;
        if (run < -120.f) break;
    }
    const float ss = wave_sum(acc * acc);
    const float y = acc * rsqrtf(ss * (1.f / 64.f) + EPS) * sbn[h * 64 + lane];
    MIXQ[(rowb + t) * DM + h * 64 + lane] = f2bf(y);
}
__device__ __forceinline__ void d_ret_naive(const int vb, const int vtid, char* lds, bf16_t* MIXQ, const bf16_t* __restrict__ PROJ2, const float* __restrict__ rn) {
    float* qs = (float*)lds; float* ks = qs + 128; float* vs = ks + 128; float (*red)[128] = (float (*)[128])(vs + 128); float* stat = vs + 128 + 256;
    const int bh = vb, b = bh >> 2, h = bh & 3, tid = vtid, half = tid >> 7, e = tid & 127;
    const float gamma = 1.0f - exp2f(-5.0f - (float)h);
    float st[64];
#pragma unroll
    for (int i = 0; i < 64; ++i) st[i] = 0.f;
    for (int t = 0; t < SEQ; ++t) {
        const size_t row = (size_t)b * SEQ + t;
        const bf16_t* pr = PROJ2 + row * 2560;
        if (tid < 128) { qs[tid] = bf2f(MIXQ[row * DM + 512 + h * 128 + tid]); ks[tid] = bf2f(pr[1024 + h * 128 + tid]); }
        else vs[tid - 128] = bf2f(pr[1536 + h * 128 + (tid - 128)]);
        __syncthreads();
        const float ve = vs[e]; float part = 0.f;
#pragma unroll
        for (int dd = 0; dd < 64; ++dd) { const int d = half * 64 + dd; st[dd] = gamma * st[dd] + ks[d] * ve; part += qs[d] * st[dd]; }
        red[half][e] = part;
        __syncthreads();
        float o = 0.f;
        if (tid < 128) { o = red[0][e] + red[1][e]; const float s1 = wave_sum(o); if ((tid & 63) == 0) stat[tid >> 6] = s1; }
        __syncthreads();
        float mu = 0.f, dlt = 0.f;
        if (tid < 128) { mu = (stat[0] + stat[1]) * (1.f / 128.f); dlt = o - mu; const float s2 = wave_sum(dlt * dlt); if ((tid & 63) == 0) stat[2 + (tid >> 6)] = s2; }
        __syncthreads();
        if (tid < 128) {
            const float var = (stat[2] + stat[3]) * (1.f / 128.f);
            const float g = bf2f(pr[2048 + h * 128 + e]);
            const float y = dlt * rsqrtf(var + EPS) * rn[h * 128 + e] * (g / (1.f + __expf(-g)));
            MIXQ[row * DM + 512 + h * 128 + e] = f2bf(y);
        }
        __syncthreads();
    }
}
__device__ __forceinline__ void d_xattn_naive(const int vb, const int vtid, char* lds, const bf16_t* __restrict__ Q, const bf16_t* __restrict__ KV, bf16_t* __restrict__ O) {
    float (*qsh)[256] = (float (*)[256])lds; float (*psh)[256] = (float (*)[256])(lds + 4096);
    const int w = vtid >> 6, lane = vtid & 63;
    const int wv = vb * 4 + w, h = wv & 3, t = wv >> 2, b = t >> 11;
    const bf16_t* qr = Q + (size_t)t * DM + h * 256;
#pragma unroll
    for (int i = 0; i < 4; ++i) qsh[w][lane + 64 * i] = bf2f(qr[lane + 64 * i]);
    __syncthreads();
    float s[4];
#pragma unroll
    for (int i = 0; i < 4; ++i) {
        const int m = lane + 64 * i; const bf16_t* kr = KV + ((size_t)b * NMEM + m) * 2048 + h * 256;
        float a = 0.f;
#pragma unroll 4
        for (int d = 0; d < 256; d += 4) { const ushort4 k4 = *(const ushort4*)(kr + d); a += qsh[w][d] * bf2f(k4.x) + qsh[w][d + 1] * bf2f(k4.y) + qsh[w][d + 2] * bf2f(k4.z) + qsh[w][d + 3] * bf2f(k4.w); }
        s[i] = a * 0.0625f;
    }
    const float mx = wave_max(fmaxf(fmaxf(s[0], s[1]), fmaxf(s[2], s[3])));
    float p[4], sum = 0.f;
#pragma unroll
    for (int i = 0; i < 4; ++i) { p[i] = __expf(s[i] - mx); sum += p[i]; }
    sum = wave_sum(sum);
    const float inv = 1.f / sum;
#pragma unroll
    for (int i = 0; i < 4; ++i) psh[w][lane + 64 * i] = p[i] * inv;
    __syncthreads();
    float o[4] = {0.f, 0.f, 0.f, 0.f};
#pragma unroll 4
    for (int m = 0; m < NMEM; ++m) {
        const ushort4 v4 = *(const ushort4*)(KV + ((size_t)b * NMEM + m) * 2048 + 1024 + h * 256 + lane * 4);
        const float pm = psh[w][m];
        o[0] += pm * bf2f(v4.x); o[1] += pm * bf2f(v4.y); o[2] += pm * bf2f(v4.z); o[3] += pm * bf2f(v4.w);
    }
    ushort4 ov; ov.x = f2bf(o[0]); ov.y = f2bf(o[1]); ov.z = f2bf(o[2]); ov.w = f2bf(o[3]);
    *(ushort4*)(O + (size_t)t * DM + h * 256 + lane * 4) = ov;
    __syncthreads();
}
__device__ __forceinline__ void wave_argmax(float& v, int& i) {
#pragma unroll
    for (int o = 1; o < 64; o <<= 1) {
        const float ov = __shfl_xor(v, o); const int oi = __shfl_xor(i, o);
        if (ov > v || (ov == v && oi < i)) { v = ov; i = oi; }
    }
}
__device__ __forceinline__ void d_peer_topk_naive(const int vb, const int vtid, const bf16_t* __restrict__ SC, int* __restrict__ idx, float* __restrict__ gate) {
    const int w = vtid >> 6, lane = vtid & 63;
    const int wv = vb * 4 + w, h = wv & 7, t = wv >> 3;
    const bf16_t* sr = SC + (size_t)t * 2048 + h * 256;
    float tops[2] = {0.f, 0.f}; int topi[2] = {0, 0};
#pragma unroll
    for (int p = 0; p < 2; ++p) {
        float sc[2]; sc[0] = h2f(sr[p * 128 + lane]); sc[1] = h2f(sr[p * 128 + 64 + lane]);
#pragma unroll 1
        for (int r = 0; r < 16; ++r) {
            float v; int i;
            if (sc[0] >= sc[1]) { v = sc[0]; i = lane; } else { v = sc[1]; i = lane + 64; }
            wave_argmax(v, i);
            if (lane == r) { tops[p] = v; topi[p] = i; }
            if (i == lane) sc[0] = -INFINITY; else if (i == lane + 64) sc[1] = -INFINITY;
        }
    }
    float cs[4]; int ce[4];
#pragma unroll
    for (int q = 0; q < 4; ++q) {
        const int c = lane + 64 * q, i = c >> 4, j = c & 15;
        cs[q] = __shfl(tops[0], i) + __shfl(tops[1], j);
        ce[q] = __shfl(topi[0], i) * 128 + __shfl(topi[1], j);
    }
    float bs = 0.f; int be = 0;
#pragma unroll 1
    for (int r = 0; r < 16; ++r) {
        float v = cs[0]; int c = lane;
#pragma unroll
        for (int q = 1; q < 4; ++q) if (cs[q] > v) { v = cs[q]; c = lane + 64 * q; }
        wave_argmax(v, c);
        int e = 0;
#pragma unroll
        for (int q = 0; q < 4; ++q) { const int eq = __shfl(ce[q], c & 63); if ((c >> 6) == q) e = eq; }
        if (lane == r) { bs = v; be = e; }
        if ((c & 63) == lane) {
#pragma unroll
            for (int q = 0; q < 4; ++q) if ((c >> 6) == q) cs[q] = -INFINITY;
        }
    }
    const float mx = __shfl(bs, 0);
    const float ex = lane < 16 ? __expf(bs - mx) : 0.f;
    const float sum = wave_sum(ex);
    if (lane < 16) { idx[(size_t)t * 128 + h * 16 + lane] = be; gate[(size_t)t * 128 + h * 16 + lane] = ex / sum; }
}
__device__ __forceinline__ void d_peer_gather_naive(const int vb, const int vtid, bf16_t* XB, const float* __restrict__ g, float* SSQ, const float* __restrict__ U, const float* __restrict__ V, const int* __restrict__ idx, const float* __restrict__ gate, float* XR) {
    const int t = vb * 4 + (vtid >> 6), lane = vtid & 63;
    float rstd; { const float sv = lane < 16 ? SSQ[(size_t)t * 16 + lane] : 0.f; rstd = rsqrtf(wave_sum(sv) * (1.0f / DM) + EPS); }
    float4 hv[4], acc[4];
#pragma unroll
    for (int i = 0; i < 4; ++i) { const ushort4 a = ((const ushort4*)(XB + (size_t)t * DM))[lane + 64 * i]; const float4 gg = ((const float4*)g)[lane + 64 * i];
        hv[i].x = bf2f(a.x) * gg.x * rstd; hv[i].y = bf2f(a.y) * gg.y * rstd; hv[i].z = bf2f(a.z) * gg.z * rstd; hv[i].w = bf2f(a.w) * gg.w * rstd; acc[i] = make_float4(0.f, 0.f, 0.f, 0.f); }
    const int i0 = idx[(size_t)t * 128 + lane], i1 = idx[(size_t)t * 128 + 64 + lane];
    const float g0 = gate[(size_t)t * 128 + lane], g1 = gate[(size_t)t * 128 + 64 + lane];
#pragma unroll 2
    for (int p = 0; p < 128; ++p) {
        const int e = __shfl(p < 64 ? i0 : i1, p & 63); const float gt = __shfl(p < 64 ? g0 : g1, p & 63);
        const float4* ur = (const float4*)(U + (size_t)e * DM); const float4* vr = (const float4*)(V + (size_t)e * DM);
        float a = 0.f;
#pragma unroll
        for (int i = 0; i < 4; ++i) { const float4 u = ur[lane + 64 * i]; a += hv[i].x * u.x + hv[i].y * u.y + hv[i].z * u.z + hv[i].w * u.w; }
        a = wave_sum(a);
        const float wgt = gt * 0.5f * a * (1.f + erff(a * 0.7071067811865476f));
#pragma unroll
        for (int i = 0; i < 4; ++i) { const float4 v = vr[lane + 64 * i]; acc[i].x += wgt * v.x; acc[i].y += wgt * v.y; acc[i].z += wgt * v.z; acc[i].w += wgt * v.w; }
    }
    float4* xr = (float4*)(XR + (size_t)t * DM); float ss = 0.f;
#pragma unroll
    for (int i = 0; i < 4; ++i) { float4 x = xr[lane + 64 * i]; x.x += acc[i].x; x.y += acc[i].y; x.z += acc[i].z; x.w += acc[i].w; xr[lane + 64 * i] = x;
        uint2 w; w.x = pk2bf(x.x, x.y); w.y = pk2bf(x.z, x.w); ((uint2*)(XB + (size_t)t * DM))[lane + 64 * i] = w; ss += (x.x * x.x + x.y * x.y) + (x.z * x.z + x.w * x.w); }
    ss = wave_sum(ss);
    if (lane < 16) SSQ[(size_t)t * 16 + lane] = lane == 0 ? ss : 0.f;
}
typedef float f32x2 __attribute__((ext_vector_type(2)));
template <int CTRL> __device__ __forceinline__ float dpp_f(float v) { return __builtin_bit_cast(float, __builtin_amdgcn_update_dpp(0, __builtin_bit_cast(int, v), CTRL, 0xF, 0xF, false)); }
template <int CTRL> __device__ __forceinline__ unsigned dpp_u(unsigned v) { return (unsigned)__builtin_amdgcn_update_dpp(0, (int)v, CTRL, 0xF, 0xF, false); }
constexpr int NEXP = 16384;
__device__ __forceinline__ void table_row_to_fp8(const float* __restrict__ row, const float* __restrict__ g, unsigned char* __restrict__ T8, float* __restrict__ isc, int e, int lane) {
    float v[16]; float mx = 0.f;
#pragma unroll
    for (int i = 0; i < 4; ++i) { const float4 a = ((const float4*)row)[lane * 4 + i]; float4 gg = make_float4(1.f, 1.f, 1.f, 1.f); if (g) gg = ((const float4*)g)[lane * 4 + i];
        v[4 * i] = a.x * gg.x; v[4 * i + 1] = a.y * gg.y; v[4 * i + 2] = a.z * gg.z; v[4 * i + 3] = a.w * gg.w;
        mx = fmaxf(mx, fmaxf(fmaxf(fabsf(v[4 * i]), fabsf(v[4 * i + 1])), fmaxf(fabsf(v[4 * i + 2]), fabsf(v[4 * i + 3])))); }
    mx = wave_max(mx);
    const float sc = mx > 0.f ? 224.0f / mx : 1.0f;
    uint4 o; unsigned w[4];
#pragma unroll
    for (int i = 0; i < 4; ++i) { int p = __builtin_amdgcn_cvt_pk_fp8_f32(v[4 * i] * sc, v[4 * i + 1] * sc, 0, false); p = __builtin_amdgcn_cvt_pk_fp8_f32(v[4 * i + 2] * sc, v[4 * i + 3] * sc, p, true); w[i] = (unsigned)p; }
    o.x = w[0]; o.y = w[1]; o.z = w[2]; o.w = w[3];
    *(uint4*)(T8 + ((size_t)(lane >> 3) * NEXP + e) * 128 + (lane & 7) * 16) = o;
    if (lane == 0) isc[e] = mx > 0.f ? mx * (1.0f / 224.0f) : 1.0f;
}

#define PK_CE(a, b) { const unsigned t_ = (a) > (b) ? (a) : (b); b = (a) > (b) ? (b) : (a); a = t_; }
__device__ __forceinline__ void sort16_desc(unsigned (&v)[16]) {
#pragma unroll
    for (int k = 2; k <= 16; k <<= 1)
#pragma unroll
        for (int j = k >> 1; j > 0; j >>= 1)
#pragma unroll
            for (int i = 0; i < 16; ++i) { const int l = i ^ j; if (l > i) { if ((i & k) == 0) PK_CE(v[i], v[l]) else PK_CE(v[l], v[i]) } }
}
__device__ __forceinline__ void merge16_desc(unsigned (&R)[16], const unsigned (&N)[16]) {
#pragma unroll
    for (int i = 0; i < 16; ++i) R[i] = R[i] > N[15 - i] ? R[i] : N[15 - i];
#pragma unroll
    for (int j = 8; j > 0; j >>= 1)
#pragma unroll
        for (int i = 0; i < 16; ++i) { const int l = i ^ j; if (l > i) PK_CE(R[i], R[l]) }
}
__device__ __forceinline__ void peer_topk_fast(const bf16_t* __restrict__ SC, int* __restrict__ IDX, float* __restrict__ GATE, int t, int hp) {
    const uint4* src = (const uint4*)(SC + (size_t)t * 2048 + hp * 128);
    unsigned R[16];
#pragma unroll
    for (int g = 0; g < 8; ++g) {
        const uint4 a = src[2 * g], b = src[2 * g + 1]; const unsigned dw[8] = {a.x, a.y, a.z, a.w, b.x, b.y, b.z, b.w};
        unsigned N[16];
#pragma unroll
        for (int k = 0; k < 8; ++k) { const unsigned w = dw[k]; const unsigned m = ((w >> 15) & 0x00010001u) * 0x7FFFu; const unsigned u = w ^ (m | 0x80008000u);
            N[2 * k] = (u << 16) | (unsigned)(127 - (g * 16 + 2 * k)); N[2 * k + 1] = (u & 0xFFFF0000u) | (unsigned)(127 - (g * 16 + 2 * k + 1)); }
        sort16_desc(N);
        if (g == 0) {
#pragma unroll
            for (int i = 0; i < 16; ++i) R[i] = N[i];
        } else merge16_desc(R, N);
    }
    const int p = hp & 1;
    unsigned F[16];
#pragma unroll
    for (int r = 0; r < 16; ++r) {
        const unsigned u = R[r] >> 16; const unsigned hb = (u & 0x8000u) ? (u & 0x7FFFu) : (~u & 0xFFFFu);
        const float s = h2f((unsigned short)hb); const int id = 127 - (int)(R[r] & 127u);
        int f = (int)rintf(s * 4096.0f); f = f < -65535 ? -65535 : (f > 65535 ? 65535 : f);
        F[r] = p ? (unsigned)(f * 16384 + id) : (((unsigned)(f + 131072) << 14) + ((unsigned)id << 7));
    }
    unsigned F0[16], F1[16];
#pragma unroll
    for (int r = 0; r < 16; ++r) { const unsigned o = dpp_u<0xB1>(F[r]); F0[r] = p ? o : F[r]; F1[r] = p ? F[r] : o; }
    unsigned A[16], B[16];
#pragma unroll
    for (int j = 0; j < 16; ++j) A[j] = F0[0] + F1[j];
#pragma unroll
    for (int j = 0; j < 8; ++j) B[j] = F0[1] + F1[j];
#pragma unroll
    for (int j = 0; j < 5; ++j) B[8 + j] = F0[2] + F1[j];
#pragma unroll
    for (int j = 0; j < 3; ++j) B[13 + j] = F0[4] + F1[j];
    sort16_desc(B); merge16_desc(A, B);
#pragma unroll
    for (int j = 0; j < 4; ++j) B[j] = F0[3] + F1[j];
#pragma unroll
    for (int i = 0; i < 3; ++i) { B[4 + 2 * i] = F0[5 + i] + F1[0]; B[5 + 2 * i] = F0[5 + i] + F1[1]; }
#pragma unroll
    for (int i = 0; i < 6; ++i) B[10 + i] = F0[8 + i] + F1[0];
    sort16_desc(B); merge16_desc(A, B);
#pragma unroll
    for (int i = 14; i < 16; ++i) { unsigned xk = F0[i] + F1[0];
#pragma unroll
        for (int k = 0; k < 16; ++k) PK_CE(A[k], xk) }
    float ex[16]; float sum = 0.f; const float s0 = (float)((int)(A[0] >> 14) - 131072);
#pragma unroll
    for (int r = 0; r < 16; ++r) { const float s = (float)((int)(A[r] >> 14) - 131072); ex[r] = __expf((s - s0) * (1.0f / 4096.0f)); sum += ex[r]; }
    const float inv = 1.0f / sum;
    int4 i0, i1; float4 g0, g1;
    i0.x = (int)((p ? A[8] : A[0]) & 0x3FFFu); i0.y = (int)((p ? A[9] : A[1]) & 0x3FFFu); i0.z = (int)((p ? A[10] : A[2]) & 0x3FFFu); i0.w = (int)((p ? A[11] : A[3]) & 0x3FFFu);
    i1.x = (int)((p ? A[12] : A[4]) & 0x3FFFu); i1.y = (int)((p ? A[13] : A[5]) & 0x3FFFu); i1.z = (int)((p ? A[14] : A[6]) & 0x3FFFu); i1.w = (int)((p ? A[15] : A[7]) & 0x3FFFu);
    g0.x = (p ? ex[8] : ex[0]) * inv; g0.y = (p ? ex[9] : ex[1]) * inv; g0.z = (p ? ex[10] : ex[2]) * inv; g0.w = (p ? ex[11] : ex[3]) * inv;
    g1.x = (p ? ex[12] : ex[4]) * inv; g1.y = (p ? ex[13] : ex[5]) * inv; g1.z = (p ? ex[14] : ex[6]) * inv; g1.w = (p ? ex[15] : ex[7]) * inv;
    const size_t o = (size_t)t * 128 + (hp >> 1) * 16 + p * 8;
    *(int4*)(IDX + o) = i0; *(int4*)(IDX + o + 4) = i1; *(float4*)(GATE + o) = g0; *(float4*)(GATE + o + 4) = g1;
}

__device__ __forceinline__ void peer_u_token(const bf16_t* __restrict__ xs, const int* __restrict__ idxrow, const unsigned char* __restrict__ U8s, float* __restrict__ Arow, int lane) {
    const int g = lane >> 3, j = lane & 7;
    const uint4 xa = *(const uint4*)(xs + 16 * j), xb = *(const uint4*)(xs + 16 * j + 8);
    const unsigned xw[8] = {xa.x, xa.y, xa.z, xa.w, xb.x, xb.y, xb.z, xb.w};
    f32x2 xf[8];
#pragma unroll
    for (int k = 0; k < 8; ++k) { xf[k].x = __uint_as_float(xw[k] << 16); xf[k].y = __uint_as_float(xw[k] & 0xFFFF0000u); }
    int id[16];
#pragma unroll
    for (int i = 0; i < 4; ++i) { const int4 v = *(const int4*)(idxrow + g * 16 + 4 * i); id[4 * i] = v.x; id[4 * i + 1] = v.y; id[4 * i + 2] = v.z; id[4 * i + 3] = v.w; }
    uint4 d[16];
#pragma unroll
    for (int q = 0; q < 16; ++q) d[q] = *(const uint4*)(U8s + (size_t)id[q] * 128 + j * 16);
    float r0 = 0.f, r1 = 0.f;
#pragma unroll
    for (int q = 0; q < 16; ++q) {
        const unsigned w[4] = {d[q].x, d[q].y, d[q].z, d[q].w}; f32x2 acc = {0.f, 0.f};
#pragma unroll
        for (int k = 0; k < 4; ++k) { const f32x2 a = __builtin_amdgcn_cvt_pk_f32_fp8((int)w[k], false), b = __builtin_amdgcn_cvt_pk_f32_fp8((int)w[k], true); acc = a * xf[2 * k] + acc; acc = b * xf[2 * k + 1] + acc; }
        float s = acc.x + acc.y; s += dpp_f<0xB1>(s); s += dpp_f<0x4E>(s); s += dpp_f<0x141>(s);
        if (q < 8) r0 = (q & 7) == j ? s : r0; else r1 = (q & 7) == j ? s : r1;
    }
    Arow[g * 16 + j] = r0; Arow[g * 16 + 8 + j] = r1;
}
__device__ __forceinline__ void peer_combine(const float* __restrict__ A, const int* __restrict__ IDX, float* GATE, const float* __restrict__ SSQ, const float* __restrict__ iscu, const float* __restrict__ iscv, int i) {
    const int t = i >> 7, p = i & 127;
    const float4* sp = (const float4*)(SSQ + (size_t)t * 16); const float4 s0 = sp[0], s1 = sp[1], s2 = sp[2], s3 = sp[3];
    const float q = ((s0.x + s0.y) + (s0.z + s0.w)) + ((s1.x + s1.y) + (s1.z + s1.w)) + ((s2.x + s2.y) + (s2.z + s2.w)) + ((s3.x + s3.y) + (s3.z + s3.w));
    const float rstd = rsqrtf(q * (1.0f / DM) + EPS);
    float a = 0.f;
#pragma unroll
    for (int s = 0; s < 8; ++s) a += A[((size_t)s * T + t) * 128 + p];
    const int e = IDX[i];
    a *= rstd * iscu[e];
    GATE[i] = GATE[i] * 0.5f * a * (1.f + erff(a * 0.7071067811865476f)) * iscv[e];
}
__device__ __forceinline__ void peer_v_token(const float* __restrict__ wrow, const int* __restrict__ idxrow, const unsigned char* __restrict__ V8s, float* xr, bf16_t* xb, float* ssq2, int lane) {
    const int g = lane >> 3, j = lane & 7;
    int id[16]; float wv[16];
#pragma unroll
    for (int i = 0; i < 4; ++i) { const int4 v = *(const int4*)(idxrow + g * 16 + 4 * i); id[4 * i] = v.x; id[4 * i + 1] = v.y; id[4 * i + 2] = v.z; id[4 * i + 3] = v.w;
        const float4 f = *(const float4*)(wrow + g * 16 + 4 * i); wv[4 * i] = f.x; wv[4 * i + 1] = f.y; wv[4 * i + 2] = f.z; wv[4 * i + 3] = f.w; }
    uint4 d[16];
#pragma unroll
    for (int q = 0; q < 16; ++q) d[q] = *(const uint4*)(V8s + (size_t)id[q] * 128 + j * 16);
    f32x2 acc[8];
#pragma unroll
    for (int k = 0; k < 8; ++k) acc[k] = (f32x2){0.f, 0.f};
#pragma unroll
    for (int q = 0; q < 16; ++q) {
        const unsigned w[4] = {d[q].x, d[q].y, d[q].z, d[q].w}; const f32x2 ww = {wv[q], wv[q]};
#pragma unroll
        for (int k = 0; k < 4; ++k) { const f32x2 a = __builtin_amdgcn_cvt_pk_f32_fp8((int)w[k], false), b = __builtin_amdgcn_cvt_pk_f32_fp8((int)w[k], true); acc[2 * k] = a * ww + acc[2 * k]; acc[2 * k + 1] = b * ww + acc[2 * k + 1]; }
    }
#pragma unroll
    for (int k = 0; k < 8; ++k) {
        float a = acc[k].x, b = acc[k].y;
        a += dpp_f<0x128>(a); b += dpp_f<0x128>(b);
        a += __shfl_xor(a, 16); b += __shfl_xor(b, 16);
        a += __shfl_xor(a, 32); b += __shfl_xor(b, 32);
        acc[k].x = a; acc[k].y = b;
    }
    if (g == 0) {
        float ss = 0.f; float o[16];
#pragma unroll
        for (int i = 0; i < 4; ++i) { float4 x = ((const float4*)(xr + 16 * j))[i]; x.x += acc[2 * i].x; x.y += acc[2 * i].y; x.z += acc[2 * i + 1].x; x.w += acc[2 * i + 1].y; ((float4*)(xr + 16 * j))[i] = x;
            o[4 * i] = x.x; o[4 * i + 1] = x.y; o[4 * i + 2] = x.z; o[4 * i + 3] = x.w; ss += (x.x * x.x + x.y * x.y) + (x.z * x.z + x.w * x.w); }
        uint4 b0, b1; b0.x = pk2bf(o[0], o[1]); b0.y = pk2bf(o[2], o[3]); b0.z = pk2bf(o[4], o[5]); b0.w = pk2bf(o[6], o[7]); b1.x = pk2bf(o[8], o[9]); b1.y = pk2bf(o[10], o[11]); b1.z = pk2bf(o[12], o[13]); b1.w = pk2bf(o[14], o[15]);
        *(uint4*)(xb + 16 * j) = b0; *(uint4*)(xb + 16 * j + 8) = b1;
        ss += dpp_f<0xB1>(ss); ss += dpp_f<0x4E>(ss); ss += dpp_f<0x141>(ss);
        if (j == 0) { ssq2[0] = ss; ssq2[1] = 0.f; }
    }
}
struct Params { const float* in[18]; float* out; char* ws; };
constexpr int LDS_BYTES = 147456;
constexpr size_t MiB = 1u << 20;
constexpr size_t WS_ROT = 1, WS_SSQ = 2, WS_MEMSSQ = 4, WS_MEMB = 8, WS_KV = 16, WS_WIN = 48, WS_WOUT = 62, WS_WQ = 66, WS_WKV = 70, WS_WO = 78, WS_WP = 82,
                 WS_XB = 96, WS_MIXQ = 160, WS_PROJ2 = 224, WS_Q = 224, WS_O = 288, WS_SCORES = 224, WS_IDX = 384, WS_GATE = 400, WS_T8 = 416, WS_ISC = 5, WS_A = 224, WS_END = 480;
#ifndef PHMASK
#define PHMASK 0xFFFFF
#endif
#define PH(k) if constexpr ((PHMASK >> (k)) & 1)
#define VB_LOOP(nvb) for (int vb = bid * 2 + (tid >> 8); vb < (nvb); vb += G * 2)

#define PHASE_VARS \
    const __attribute__((address_space(4))) Params* kp = (const __attribute__((address_space(4))) Params*)__builtin_amdgcn_kernarg_segment_ptr(); asm volatile("" : "+s"(kp)); \
    int tid = threadIdx.x; asm volatile("" : "+v"(tid)); \
    const int lane = tid & 63, wave = __builtin_amdgcn_readfirstlane(tid >> 6), vtid = tid & 255; char* lds = lds_all + (tid >> 8) * 32768; \
    PG8_LAS unsigned char* glds = (PG8_LAS unsigned char*)lds_all; PG8_LAS float* rbuf = (PG8_LAS float*)(glds + 132096); \
    const int G = gridDim.x, bid = blockIdx.x; \
    const float* x = kp->in[0]; const float* mem = kp->in[1]; const float* mix_norm = kp->in[2]; const float* w_in = kp->in[3]; const float* sb_norm = kp->in[4]; const float* ret_norm = kp->in[5]; \
    const float* w_out = kp->in[6]; const float* xa_norm = kp->in[7]; const float* mem_norm = kp->in[8]; const float* xa_wq = kp->in[9]; const float* xa_wkv = kp->in[10]; const float* xa_wo = kp->in[11]; \
    const float* peer_norm = kp->in[12]; const float* peer_wq = kp->in[13]; const float* peer_keys = kp->in[14]; const float* peer_u = kp->in[15]; const float* peer_v = kp->in[16]; const float* final_norm = kp->in[17]; \
    float* XR = kp->out; char* ws = kp->ws; \
    float* SSQ = (float*)(ws + WS_SSQ * MiB); float* MEMSSQ = (float*)(ws + WS_MEMSSQ * MiB); \
    bf16_t* MEMB = (bf16_t*)(ws + WS_MEMB * MiB); bf16_t* KV = (bf16_t*)(ws + WS_KV * MiB); \
    bf16_t* WIN_T = (bf16_t*)(ws + WS_WIN * MiB); bf16_t* WOUT_T = (bf16_t*)(ws + WS_WOUT * MiB); bf16_t* WQ_T = (bf16_t*)(ws + WS_WQ * MiB); \
    bf16_t* WKV_T = (bf16_t*)(ws + WS_WKV * MiB); bf16_t* WO_T = (bf16_t*)(ws + WS_WO * MiB); bf16_t* WP_T = (bf16_t*)(ws + WS_WP * MiB); \
    bf16_t* XB = (bf16_t*)(ws + WS_XB * MiB); bf16_t* MIXQ = (bf16_t*)(ws + WS_MIXQ * MiB); bf16_t* PROJ2 = (bf16_t*)(ws + WS_PROJ2 * MiB); \
    bf16_t* Q = (bf16_t*)(ws + WS_Q * MiB); bf16_t* O = (bf16_t*)(ws + WS_O * MiB); bf16_t* SCORES = (bf16_t*)(ws + WS_SCORES * MiB); \
    int* IDX = (int*)(ws + WS_IDX * MiB); float* GATE = (float*)(ws + WS_GATE * MiB); unsigned char* T8 = (unsigned char*)(ws + WS_T8 * MiB); float* ISC = (float*)(ws + WS_ISC * MiB); float* APART = (float*)(ws + WS_A * MiB); \
    (void)lane; (void)wave; (void)vtid; (void)lds; (void)glds; (void)rbuf; (void)G; (void)bid; (void)x; (void)mem; (void)mix_norm; (void)w_in; (void)sb_norm; (void)ret_norm; (void)w_out; (void)xa_norm; (void)mem_norm; \
    (void)xa_wq; (void)xa_wkv; (void)xa_wo; (void)peer_norm; (void)peer_wq; (void)peer_keys; (void)peer_u; (void)peer_v; (void)final_norm; (void)XR; (void)SSQ; (void)MEMSSQ; (void)MEMB; (void)KV; (void)WIN_T; \
    (void)WOUT_T; (void)WQ_T; (void)WKV_T; (void)WO_T; (void)WP_T; (void)XB; (void)MIXQ; (void)PROJ2; (void)Q; (void)O; (void)SCORES; (void)IDX; (void)GATE; (void)T8; (void)ISC; (void)APART;

__global__ void __launch_bounds__(512, 2) mega(Params p_unused) {
    extern __shared__ __attribute__((aligned(16))) char lds_all[];
    cg::grid_group grid = cg::this_grid();
    PH(0) { PHASE_VARS
        const int gw = bid * 8 + wave, NGW = G * 8;
        float* scr = (float*)(lds_all + wave * 8448);
        for (int it = gw; it < 2 * 4352; it += NGW) {
            const int l = it / 4352; int r = it % 4352;
            if (r < 1792) { tr_item(w_in + (size_t)l * DM * INC, DM, INC, mix_norm + l * DM, true, WIN_T + (size_t)l * INC * DM, scr, r, lane); continue; } r -= 1792;
            if (r < 512) { tr_item(w_out + (size_t)l * DM * DM, DM, DM, nullptr, false, WOUT_T + (size_t)l * DM * DM, scr, r, lane); continue; } r -= 512;
            if (r < 512) { tr_item(xa_wq + (size_t)l * DM * DM, DM, DM, xa_norm + l * DM, false, WQ_T + (size_t)l * DM * DM, scr, r, lane); continue; } r -= 512;
            if (r < 1024) { tr_item(xa_wkv + (size_t)l * DM * 2048, DM, 2048, mem_norm + l * DM, false, WKV_T + (size_t)l * 2048 * DM, scr, r, lane); continue; } r -= 1024;
            tr_item(xa_wo + (size_t)l * DM * DM, DM, DM, nullptr, false, WO_T + (size_t)l * DM * DM, scr, r, lane);
        }
        for (int m = gw; m < T; m += NGW) row_to_bf16_ssq(x + (size_t)m * DM, XB + (size_t)m * DM, SSQ + (size_t)m * 16, lane);
        for (int m = gw; m < MROWS; m += NGW) row_to_bf16_ssq(mem + (size_t)m * DM, MEMB + (size_t)m * DM, MEMSSQ + (size_t)m * 16, lane);
        for (int r = gw; r < NL * 2 * NEXP; r += NGW) { const int lt = r >> 14, e = r & (NEXP - 1), l = lt >> 1, tab = lt & 1;
            table_row_to_fp8((tab ? peer_v : peer_u) + ((size_t)l * NEXP + e) * DM, tab ? nullptr : peer_norm + l * DM, T8 + (size_t)lt * 8 * NEXP * 128, ISC + (size_t)lt * NEXP, e, lane); }
        __syncthreads();
        for (int it = bid; it < NL * 256; it += G) { const int l = it >> 8;
            peer_fold_item(peer_wq + (size_t)l * DM * 2048, peer_keys + (size_t)l * 8 * 2 * 128 * 128, peer_norm + l * DM, WP_T + (size_t)l * 2048 * DM, (float*)lds_all, it & 255, tid); }
    }
    grid.sync();
    for (int l = 0; l < NL; ++l) {
        PH(1) { PHASE_VARS  pg8::Gemm g{XB, WIN_T + (size_t)l * INC * DM, T, INC, DM}; pg8::StaticOrder S; S.init(T, INC, G, bid, tid, SSQ, rbuf);
            pg8::EpiProj E{MIXQ, PROJ2, rbuf};
            pg8::gemm_phase<pg8::EpiProj, pg8::StaticOrder, true, true>(glds, g, S, E, tid); }
        PH(2) if (l == 0) { PHASE_VARS
#pragma unroll 1
            for (int ll = 0; ll < NL; ++ll) {
                pg8::Gemm g{MEMB, WKV_T + (size_t)ll * 2048 * DM, MROWS, 2048, DM}; pg8::StaticOrder S; S.init(MROWS, 2048, G, bid, tid, MEMSSQ, rbuf);
                pg8::EpiScale<false> E{KV + (size_t)ll * MROWS * 2048, 2048, rbuf, 1.0f};
                pg8::gemm_phase<pg8::EpiScale<false>, pg8::StaticOrder, true, true>(glds, g, S, E, tid); }
        }
        grid.sync();
        PH(3) { PHASE_VARS VB_LOOP(NB * 4) d_ret_naive(vb, vtid, lds, MIXQ, PROJ2, ret_norm + l * 512); }
        PH(4) { PHASE_VARS VB_LOOP(NB * 8 * SEQ / 4) d_sb_naive(vb, vtid, MIXQ, PROJ2, sb_norm + l * 512); }
        grid.sync();
        PH(5) { PHASE_VARS  pg8::Gemm g{MIXQ, WOUT_T + (size_t)l * DM * DM, T, DM, DM}; pg8::StaticOrder S; S.init(T, DM, G, bid, tid);
            pg8::EpiResid E{l == 0 ? x : XR, XR, XB, SSQ};
            pg8::gemm_phase<pg8::EpiResid, pg8::StaticOrder, true, true>(glds, g, S, E, tid); }
        grid.sync();
        PH(6) { PHASE_VARS  pg8::Gemm g{XB, WQ_T + (size_t)l * DM * DM, T, DM, DM}; pg8::StaticOrder S; S.init(T, DM, G, bid, tid, SSQ, rbuf);
            pg8::EpiScale<false> E{Q, 1024, rbuf, 1.0f};
            pg8::gemm_phase<pg8::EpiScale<false>, pg8::StaticOrder, true, true>(glds, g, S, E, tid); }
        grid.sync();
        PH(7) { PHASE_VARS VB_LOOP(T) d_xattn_naive(vb, vtid, lds, Q, KV + (size_t)l * MROWS * 2048, O); }
        grid.sync();
        PH(8) { PHASE_VARS  pg8::Gemm g{O, WO_T + (size_t)l * DM * DM, T, DM, DM}; pg8::StaticOrder S; S.init(T, DM, G, bid, tid);
            pg8::EpiResid E{XR, XR, XB, SSQ};
            pg8::gemm_phase<pg8::EpiResid, pg8::StaticOrder, true, true>(glds, g, S, E, tid); }
        grid.sync();
        PH(9) { PHASE_VARS  pg8::Gemm g{XB, WP_T + (size_t)l * 2048 * DM, T, 2048, DM}; pg8::StaticOrder S; S.init(T, 2048, G, bid, tid, SSQ, rbuf);
            pg8::EpiScale<true> E{SCORES, 2048, rbuf, 1.0f};
            pg8::gemm_phase<pg8::EpiScale<true>, pg8::StaticOrder, true, true>(glds, g, S, E, tid); }
        grid.sync();
        PH(10) { PHASE_VARS for (int it = bid; it < T / 32; it += G) peer_topk_fast(SCORES, IDX, GATE, it * 32 + (tid >> 4), tid & 15); }
        grid.sync();
        PH(11) { PHASE_VARS const unsigned char* U8 = T8 + (size_t)(l * 2 + 0) * 8 * NEXP * 128;
            for (int i = bid; i < 8 * (T / 64); i += G) { const int s = i & 7, t0 = (i >> 3) * 64 + wave * 8;
#pragma unroll 1
                for (int m = 0; m < 8; ++m) { const int t = t0 + m; peer_u_token(XB + (size_t)t * DM + s * 128, IDX + (size_t)t * 128, U8 + (size_t)s * NEXP * 128, APART + ((size_t)s * T + t) * 128, lane); } } }
        grid.sync();
        PH(11) { PHASE_VARS for (int i = bid * 512 + tid; i < T * 128; i += G * 512) peer_combine(APART, IDX, GATE, SSQ, ISC + (size_t)(l * 2 + 0) * NEXP, ISC + (size_t)(l * 2 + 1) * NEXP, i); }
        grid.sync();
        PH(11) { PHASE_VARS const unsigned char* V8 = T8 + (size_t)(l * 2 + 1) * 8 * NEXP * 128;
            for (int i = bid; i < 8 * (T / 64); i += G) { const int s = i & 7, t0 = (i >> 3) * 64 + wave * 8;
#pragma unroll 1
                for (int m = 0; m < 8; ++m) { const int t = t0 + m; peer_v_token(GATE + (size_t)t * 128, IDX + (size_t)t * 128, V8 + (size_t)s * NEXP * 128, XR + (size_t)t * DM + s * 128, XB + (size_t)t * DM + s * 128, SSQ + (size_t)t * 16 + 2 * s, lane); } } }
        grid.sync();
    }
    PH(12) { PHASE_VARS VB_LOOP(T / 4) d_rmsnorm_final(vb, vtid, XR, final_norm); }
}

extern "C" void kernel_launch(void* const* d_in, const int* in_sizes, int n_in, void* d_out, int out_size, void* d_ws, size_t ws_size, hipStream_t stream) {
    static int grid_blocks = 0;
    if (grid_blocks == 0) {
        int dev = 0, cus = 0, per_cu = 0;
        (void)hipGetDevice(&dev);
        (void)hipDeviceGetAttribute(&cus, hipDeviceAttributeMultiprocessorCount, dev);
        (void)hipFuncSetAttribute((const void*)mega, hipFuncAttributeMaxDynamicSharedMemorySize, LDS_BYTES);
        (void)hipOccupancyMaxActiveBlocksPerMultiprocessor(&per_cu, (const void*)mega, 512, LDS_BYTES);
        if (per_cu < 1) { fprintf(stderr, "occupancy query says %d blocks/CU\n", per_cu); per_cu = 1; }
        grid_blocks = cus * per_cu;
        if (ws_size < WS_END * MiB || n_in != 18) { fprintf(stderr, "bad ws_size %zu / n_in %d\n", ws_size, n_in); grid_blocks = -1; }
    }
    if (grid_blocks < 0) return;
    Params p{};
    for (int i = 0; i < 18; ++i) p.in[i] = (const float*)d_in[i];
    p.out = (float*)d_out; p.ws = (char*)d_ws;
    void* args[] = {&p};
    hipError_t e = hipLaunchCooperativeKernel((const void*)mega, dim3(grid_blocks), dim3(512), args, LDS_BYTES, stream);
    if (e != hipSuccess) fprintf(stderr, "cooperative launch failed: %s (grid %d)\n", hipGetErrorString(e), grid_blocks);
}
```

```cpp
#include <hip/hip_runtime.h>
#include <hip/hip_cooperative_groups.h>
#include <stdint.h>
#include <cstdio>
namespace cg = cooperative_groups;

typedef unsigned short bf16_t;
__device__ __forceinline__ float bf2f(bf16_t v) { return __uint_as_float(((unsigned)v) << 16); }
__device__ __forceinline__ bf16_t f2bf(float f) { unsigned u = __float_as_uint(f); u = (u + 0x7fffu + ((u >> 16) & 1u)) >> 16; return (bf16_t)u; }
__device__ __forceinline__ unsigned pk2bf(float lo, float hi) { return (unsigned)f2bf(lo) | ((unsigned)f2bf(hi) << 16); }
__device__ __forceinline__ unsigned short f2h(float f) { _Float16 h = (_Float16)f; return __builtin_bit_cast(unsigned short, h); }
__device__ __forceinline__ float h2f(unsigned short u) { return (float)__builtin_bit_cast(_Float16, u); }

constexpr int NB = 16, SEQ = 2048, DM = 1024, T = NB * SEQ, NL = 2, NMEM = 256, INC = 3584, MROWS = NB * NMEM;
constexpr float EPS = 1e-6f;

__device__ __forceinline__ float wave_sum(float v) {
#pragma unroll
    for (int o = 1; o < 64; o <<= 1) v += __shfl_xor(v, o);
    return v;
}
__device__ __forceinline__ float wave_max(float v) {
#pragma unroll
    for (int o = 1; o < 64; o <<= 1) v = fmaxf(v, __shfl_xor(v, o));
    return v;
}
namespace pg8 {
#define PG8_LAS __attribute__((address_space(3)))
typedef unsigned short bf16_t;
typedef short bf16x8 __attribute__((ext_vector_type(8)));
typedef float f32x4 __attribute__((ext_vector_type(4)));
typedef unsigned u32x4 __attribute__((ext_vector_type(4)));
constexpr int BM = 256, BK = 64, HALF = 128, HTB = HALF * BK * 2  , STAGE_BYTES = 8 * HTB, NXCD = 8, WGM = 8;

__host__ __device__ __forceinline__ int lds_byte(int r, int c) { const int st = (r >> 4) * 2 + (c >> 5), rr = r & 15, cc = c & 31, ob = rr * 64 + cc * 2; return st * 1024 + (ob ^ (((ob >> 9) & 1) << 5)); }
__host__ __device__ __forceinline__ void stage_rc(int b, int& R, int& C) { const int st = b / 1024, sb = b % 1024, swz = sb ^ (((sb >> 9) & 1) << 5); R = (st >> 1) * 16 + swz / 64; C = (st & 1) * 32 + (swz % 64) / 2; }
__host__ __device__ __forceinline__ int perm32(int rho) { const int n = rho >> 4, i = rho & 15; return 8 * (i >> 2) + 4 * n + (i & 3); }

struct Unit { int pm, pn; };
struct Gemm { const bf16_t* A; const bf16_t* Bt; int M, N, K; };

struct StaticOrder {
    int nM, nN, nwg, G, c;
    __host__ __device__ void init(int M, int N, int G_, int c_, int tid_in, const float* ssq = nullptr, PG8_LAS float* rb = nullptr) { tidm = tid_in; SSQ = ssq; rbuf = rb; nM = M / BM; nN = N / BM; nwg = nM * nN; G = G_; c = c_; }
    __host__ __device__ bool next(int i, Unit& u) const {
        const long L = (long)i * G + c; if (L >= nwg) return false;
        int wgid = (int)L; { const int q = nwg / NXCD, r = nwg % NXCD, xcd = wgid % NXCD, off = wgid / NXCD; wgid = (xcd < r ? xcd * (q + 1) : r * (q + 1) + (xcd - r) * q) + off; }
        const int nig = WGM * nN, gid = wgid / nig, fm = gid * WGM, gsz = (nM - fm) < WGM ? (nM - fm) : WGM;
        u.pm = fm + ((wgid % nig) % gsz); u.pn = (wgid % nig) / gsz; return true;
    }
    int tidm; const float* SSQ; PG8_LAS float* rbuf;
    __device__ __forceinline__ void a_ready(const Unit& u, int ui) const {
        if (SSQ) { const int t = tidm; if (t < 256) { const f32x4* p = (const f32x4*)(SSQ + (size_t)(u.pm * BM + t) * 16); const f32x4 a = p[0], b = p[1], c = p[2], d = p[3];
            const float q = ((a[0] + a[1]) + (a[2] + a[3])) + ((b[0] + b[1]) + (b[2] + b[3])) + ((c[0] + c[1]) + (c[2] + c[3])) + ((d[0] + d[1]) + (d[2] + d[3]));
            rbuf[(ui & 1) * 256 + t] = rsqrtf(q * (1.0f / 1024.0f) + 1e-6f); } }
    }
    __device__ __forceinline__ void done(const Unit&) const {}
};

__device__ __forceinline__ unsigned cvt_pk_bf16(float lo, float hi) { unsigned r; asm volatile("v_cvt_pk_bf16_f32 %0, %1, %2" : "=v"(r) : "v"(lo), "v"(hi)); return r; }
typedef float f32x2 __attribute__((ext_vector_type(2)));
template <class Epi, class Sched, bool ALIGN_EPI = false, bool SP2 = false>
__device__ __forceinline__ void gemm_phase(PG8_LAS unsigned char* lds, const Gemm g, const Sched& S, const Epi& E, const int tid_in) {
    const int tid = tid_in, wid = __builtin_amdgcn_readfirstlane(tid >> 6), lane = tid & 63, wr = wid >> 2, wc = wid & 3, fr = lane & 15, fq = lane >> 4;
    const int K = g.K, nt = K / BK;
    unsigned voffA[2], voffB[2];
#pragma unroll
    for (int i = 0; i < 2; ++i) { int R, C; stage_rc(tid * 16 + i * 8192, R, C); const int Rb = Epi::PERM ? ((R & ~31) + perm32(R & 31)) : R;
        voffA[i] = (unsigned)(R * K + C) * 2u; voffB[i] = (unsigned)(Rb * K + C) * 2u; }
    const size_t kstep = (size_t)(BK * 2);
    const size_t hstep = (size_t)HALF * K * 2;
    const size_t tstep = 2 * hstep;
    const unsigned ldsw = (unsigned)wid * 1024u;
    const int aoff = lds_byte(wr * 64 + fr, fq * 8), boff = lds_byte(wc * 32 + fr, fq * 8);
#define PG8_SA(b, h) (((b) * 2 + (h)) * HTB)
#define PG8_SB(b, h) ((4 + (b) * 2 + (h)) * HTB)
#define PG8_STAGE(bufoff, gbase, voff) do { _Pragma("unroll") for (int _i = 0; _i < 2; ++_i) \
        __builtin_amdgcn_global_load_lds((const unsigned*)((const char*)(gbase) + (voff)[_i]), (PG8_LAS unsigned*)(lds + (bufoff) + ldsw + _i * 8192), 16, 0, 0); } while (0)
#define PG8_LDA(dst, b, h) do { _Pragma("unroll") for (int m = 0; m < 4; ++m) _Pragma("unroll") for (int k = 0; k < 2; ++k) dst[m][k] = *(const PG8_LAS bf16x8*)(lds + PG8_SA(b, h) + aoff + m * 2048 + k * 1024); } while (0)
#define PG8_LDB(dst, b, h) do { _Pragma("unroll") for (int n = 0; n < 2; ++n) _Pragma("unroll") for (int k = 0; k < 2; ++k) dst[n][k] = *(const PG8_LAS bf16x8*)(lds + PG8_SB(b, h) + boff + n * 2048 + k * 1024); } while (0)
#define PG8_MMA(ai, bj, At, Bt) do { __builtin_amdgcn_s_setprio(1); _Pragma("unroll") for (int m = 0; m < 4; ++m) _Pragma("unroll") for (int n = 0; n < 2; ++n) _Pragma("unroll") for (int k = 0; k < 2; ++k) \
        acc[ai][bj][m][n] = __builtin_amdgcn_mfma_f32_16x16x32_bf16(Bt[n][k], At[m][k], acc[ai][bj][m][n], 0, 0, 0); __builtin_amdgcn_s_setprio(0); } while (0)
#define PG8_WAIT_V(n) asm volatile("s_waitcnt vmcnt(" #n ")" ::: "memory")
#define PG8_WAIT_L(n) asm volatile("s_waitcnt lgkmcnt(" #n ")" ::: "memory")
#define PG8_BAR __builtin_amdgcn_s_barrier()
#define PG8_SCHED __builtin_amdgcn_sched_barrier(0)
    Unit cur, nxt; int ui = 0;
    if (!S.next(0, cur)) return;
    f32x4 acc[2][2][4][2];
#pragma unroll
    for (int a = 0; a < 2; ++a)
#pragma unroll
        for (int b = 0; b < 2; ++b)
#pragma unroll
            for (int m = 0; m < 4; ++m)
#pragma unroll
                for (int n = 0; n < 2; ++n) acc[a][b][m][n] = (f32x4){0.f, 0.f, 0.f, 0.f};
    bf16x8 At[4][2], B0[2][2], B1[2][2];
    const char* cA = (const char*)g.A + (size_t)cur.pm * tstep; const char* cB = (const char*)g.Bt + (size_t)cur.pn * tstep;
    S.a_ready(cur, 0);
    if constexpr (SP2) {
        PG8_STAGE(PG8_SB(0, 0), cB, voffB); PG8_STAGE(PG8_SB(0, 1), cB + hstep, voffB); PG8_STAGE(PG8_SA(0, 0), cA, voffA); PG8_STAGE(PG8_SA(0, 1), cA + hstep, voffA);
        if (wr == 1) PG8_BAR;
        PG8_WAIT_V(2); PG8_BAR;
        PG8_STAGE(PG8_SB(1, 0), cB + kstep, voffB); PG8_STAGE(PG8_SA(1, 0), cA + kstep, voffA); PG8_STAGE(PG8_SB(1, 1), cB + hstep + kstep, voffB);
        PG8_WAIT_V(6); PG8_BAR;
    } else {
        PG8_STAGE(PG8_SB(0, 0), cB, voffB); PG8_STAGE(PG8_SA(0, 0), cA, voffA); PG8_STAGE(PG8_SB(0, 1), cB + hstep, voffB); PG8_STAGE(PG8_SA(0, 1), cA + hstep, voffA);
        if (wr == 1) PG8_BAR;
        PG8_WAIT_V(4); PG8_BAR;
        PG8_STAGE(PG8_SB(1, 0), cB + kstep, voffB); PG8_STAGE(PG8_SA(1, 0), cA + kstep, voffA); PG8_STAGE(PG8_SB(1, 1), cB + hstep + kstep, voffB);
        PG8_WAIT_V(6); PG8_BAR;
    }
    for (;;) {
        const bool has_next = S.next(ui + 1, nxt);
        const char* nA = has_next ? (const char*)g.A + (size_t)nxt.pm * tstep : cA; const char* nB = has_next ? (const char*)g.Bt + (size_t)nxt.pn * tstep : cB;
        for (int t = 0; t < nt; t += 2) {
            const bool last = (t == nt - 2);
            const char* a1 = cA + (size_t)(t + 1) * kstep;
            const char* a2 = last ? nA : cA + (size_t)(t + 2) * kstep; const char* b2 = last ? nB : cB + (size_t)(t + 2) * kstep;
            const char* a3 = a2 + kstep; const char* b3 = b2 + kstep;
            if (last && has_next) S.a_ready(nxt, ui + 1);
            if constexpr (SP2) {
            PG8_LDB(B0, 0, 0); PG8_LDB(B1, 0, 1); PG8_SCHED; PG8_LDA(At, 0, 0); PG8_STAGE(PG8_SA(1, 1), a1 + hstep, voffA);
            PG8_WAIT_V(8); PG8_WAIT_L(0); PG8_BAR; PG8_MMA(0, 0, At, B0); PG8_MMA(0, 1, At, B1); PG8_BAR; PG8_SCHED;
            PG8_LDA(At, 0, 1); PG8_STAGE(PG8_SB(0, 0), b2, voffB); PG8_STAGE(PG8_SB(0, 1), b2 + hstep, voffB); PG8_STAGE(PG8_SA(0, 0), a2, voffA);
            PG8_WAIT_V(8); PG8_WAIT_L(0); PG8_BAR; PG8_MMA(1, 0, At, B0); PG8_MMA(1, 1, At, B1); PG8_BAR; PG8_SCHED;
            PG8_LDB(B0, 1, 0); PG8_LDB(B1, 1, 1); PG8_SCHED; PG8_LDA(At, 1, 0); PG8_STAGE(PG8_SA(0, 1), a2 + hstep, voffA);
            PG8_WAIT_V(8); PG8_WAIT_L(0); PG8_BAR; PG8_MMA(0, 0, At, B0); PG8_MMA(0, 1, At, B1); PG8_BAR; PG8_SCHED;
            PG8_LDA(At, 1, 1); PG8_STAGE(PG8_SB(1, 0), b3, voffB); PG8_STAGE(PG8_SB(1, 1), b3 + hstep, voffB); PG8_STAGE(PG8_SA(1, 0), a3, voffA);
            PG8_WAIT_V(8); PG8_WAIT_L(0); PG8_BAR; PG8_MMA(1, 0, At, B0); PG8_MMA(1, 1, At, B1); PG8_BAR; PG8_SCHED;
            } else {
            PG8_LDB(B0, 0, 0); PG8_SCHED; PG8_LDA(At, 0, 0); PG8_STAGE(PG8_SA(1, 1), a1 + hstep, voffA);
            PG8_WAIT_L(8); PG8_BAR; PG8_WAIT_L(0); PG8_MMA(0, 0, At, B0); PG8_BAR; PG8_SCHED;
            PG8_LDB(B1, 0, 1); PG8_STAGE(PG8_SB(0, 0), b2, voffB);
            PG8_BAR; PG8_WAIT_L(0); PG8_MMA(0, 1, At, B1); PG8_BAR;
            PG8_LDA(At, 0, 1); PG8_STAGE(PG8_SA(0, 0), a2, voffA);
            PG8_BAR; PG8_WAIT_L(0); PG8_MMA(1, 0, At, B0); PG8_BAR; PG8_SCHED;
            PG8_STAGE(PG8_SB(0, 1), b2 + hstep, voffB);
            PG8_WAIT_V(6); PG8_BAR; PG8_MMA(1, 1, At, B1); PG8_BAR;
            PG8_LDB(B0, 1, 0); PG8_SCHED; PG8_LDA(At, 1, 0); PG8_STAGE(PG8_SA(0, 1), a2 + hstep, voffA);
            PG8_WAIT_L(8); PG8_BAR; PG8_WAIT_L(0); PG8_MMA(0, 0, At, B0); PG8_BAR; PG8_SCHED;
            PG8_LDB(B1, 1, 1); PG8_STAGE(PG8_SB(1, 0), b3, voffB);
            PG8_BAR; PG8_WAIT_L(0); PG8_MMA(0, 1, At, B1); PG8_BAR;
            PG8_LDA(At, 1, 1); PG8_STAGE(PG8_SA(1, 0), a3, voffA);
            PG8_BAR; PG8_WAIT_L(0); PG8_MMA(1, 0, At, B0); PG8_BAR; PG8_SCHED;
            PG8_STAGE(PG8_SB(1, 1), b3 + hstep, voffB);
            PG8_WAIT_V(6); PG8_BAR; PG8_MMA(1, 1, At, B1); PG8_BAR;
            }
        }
        if constexpr (ALIGN_EPI) { if (wr == 0) PG8_BAR; }
        if constexpr (!Epi::AFTER_DRAIN) { E(acc, cur, wr, wc, fr, fq, ui); S.done(cur); }
        if (!has_next) break;
#pragma unroll
        for (int a = 0; a < 2; ++a)
#pragma unroll
            for (int b = 0; b < 2; ++b)
#pragma unroll
                for (int m = 0; m < 4; ++m)
#pragma unroll
                    for (int n = 0; n < 2; ++n) acc[a][b][m][n] = (f32x4){0.f, 0.f, 0.f, 0.f};
        cur = nxt; cA = nA; cB = nB; ++ui;
        if constexpr (ALIGN_EPI) { if (wr == 1) PG8_BAR; }
    }
    PG8_WAIT_V(0);
    if constexpr (!ALIGN_EPI) { if (wr == 0) PG8_BAR; }
    PG8_BAR;
    if constexpr (Epi::AFTER_DRAIN) { E.fused(acc, cur, wr, wc, fr, fq, lds, wid, lane); S.done(cur); }
#undef PG8_SA
#undef PG8_SB
#undef PG8_STAGE
#undef PG8_LDA
#undef PG8_LDB
#undef PG8_MMA
#undef PG8_WAIT_V
#undef PG8_WAIT_L
#undef PG8_BAR
#undef PG8_SCHED
}
}
namespace pg8 {
struct EpiProj {
    static constexpr bool PERM = true, AFTER_DRAIN = false;
    bf16_t* MIXQ; bf16_t* PROJ2; bf16_t* SVT; bf16_t* RKT; bf16_t* RVT; const PG8_LAS float* rbuf;
    __device__ __forceinline__ void operator()(const f32x4 (&acc)[2][2][4][2], const Unit& u, int wr, int wc, int fr, int fq, int ui) const {
        int lr0 = wr * 64 + fr, cl0 = wc * 32 + 8 * fq; asm volatile("" : "+v"(lr0), "+v"(cl0));
        const int row0 = u.pm * BM + lr0; const int pn = u.pn;
        const PG8_LAS float* rb = rbuf + (ui & 1) * 256 + lr0;
        const bool rot = (pn >= 6 && pn < 10);
        float f[4] = {0.f, 0.f, 0.f, 0.f};
        if (rot) {
#pragma unroll
            for (int jj = 0; jj < 4; ++jj) f[jj] = exp2f(-(float)(2 * ((cl0 >> 1) + jj)) * (13.287712379549449f / 128.0f)) * 0.15915494309189535f;
        }
        const float sc = pn < 2 ? 0.125f * 1.4426950408889634f : ((pn == 8 || pn == 9) ? 0.08838834764831845f : 1.0f);
        const int bb = row0 >> 11, s0 = row0 & (SEQ - 1);
#pragma unroll
        for (int ai = 0; ai < 2; ++ai)
#pragma unroll
            for (int m = 0; m < 4; ++m) {
                const int row = row0 + ai * HALF + m * 16, spos = s0 + ai * HALF + m * 16; const float r = rb[ai * HALF + m * 16] * sc;
                float cs[4] = {1.f, 1.f, 1.f, 1.f}, sn[4] = {0.f, 0.f, 0.f, 0.f};
                if (rot) {
#pragma unroll
                    for (int jj = 0; jj < 4; ++jj) { const float xr = __builtin_amdgcn_fractf((float)spos * f[jj]); cs[jj] = __builtin_amdgcn_cosf(xr); sn[jj] = __builtin_amdgcn_sinf(xr); }
                }
#pragma unroll
                for (int bj = 0; bj < 2; ++bj) {
                    const f32x4 a = acc[ai][bj][m][0] * r, b = acc[ai][bj][m][1] * r; f32x4 v0 = a, v1 = b;
                    if (rot) {
                        v0[0] = a[0] * cs[0] - a[1] * sn[0]; v0[1] = a[0] * sn[0] + a[1] * cs[0]; v0[2] = a[2] * cs[1] - a[3] * sn[1]; v0[3] = a[2] * sn[1] + a[3] * cs[1];
                        v1[0] = b[0] * cs[2] - b[1] * sn[2]; v1[1] = b[0] * sn[2] + b[1] * cs[2]; v1[2] = b[2] * cs[3] - b[3] * sn[3]; v1[3] = b[2] * sn[3] + b[3] * cs[3];
                    }
                    const int ct = bj * HALF + cl0;
                    if (pn != 4 && pn != 5 && pn != 10 && pn != 11) {
                        bf16_t* dst;
                        if (pn < 2) dst = MIXQ + (size_t)row * 1024 + pn * 256 + ct;
                        else if (pn < 4) dst = PROJ2 + (size_t)row * 1536 + (pn - 2) * 256 + ct;
                        else if (pn < 8) dst = MIXQ + (size_t)row * 1024 + 512 + (pn - 6) * 256 + ct;
                        else if (pn < 10) dst = PROJ2 + (size_t)row * 1536 + 512 + (pn - 8) * 256 + ct;
                        else dst = PROJ2 + (size_t)row * 1536 + 1024 + (pn - 12) * 256 + ct;
                        u32x4 w; w.x = pk2bf(v0[0], v0[1]); w.y = pk2bf(v0[2], v0[3]); w.z = pk2bf(v1[0], v1[1]); w.w = pk2bf(v1[2], v1[3]);
                        *(u32x4*)dst = w;
                    }
                    if (pn == 4 || pn == 5) {
                        bf16_t* vt = SVT + ((size_t)(bb * 8 + (pn - 4) * 4 + (ct >> 6)) * 64 + (ct & 63)) * SEQ + spos;
                        vt[0 * SEQ] = f2bf(v0[0]); vt[1 * SEQ] = f2bf(v0[1]); vt[2 * SEQ] = f2bf(v0[2]); vt[3 * SEQ] = f2bf(v0[3]);
                        vt[4 * SEQ] = f2bf(v1[0]); vt[5 * SEQ] = f2bf(v1[1]); vt[6 * SEQ] = f2bf(v1[2]); vt[7 * SEQ] = f2bf(v1[3]);
                    }
                    if (pn >= 8 && pn < 12) {
                        const int hd = (pn & 1) * 2 + bj; float z = 1.0f;
                        if (pn < 10) z = exp2f((float)(127 - (spos & 127)) * log2f(1.0f - exp2f(-5.0f - (float)hd)));
                        bf16_t* vt = (pn < 10 ? RKT : RVT) + ((size_t)(bb * 4 + hd) * 128 + cl0) * SEQ + spos;
                        vt[0 * SEQ] = f2bf(v0[0] * z); vt[1 * SEQ] = f2bf(v0[1] * z); vt[2 * SEQ] = f2bf(v0[2] * z); vt[3 * SEQ] = f2bf(v0[3] * z);
                        vt[4 * SEQ] = f2bf(v1[0] * z); vt[5 * SEQ] = f2bf(v1[1] * z); vt[6 * SEQ] = f2bf(v1[2] * z); vt[7 * SEQ] = f2bf(v1[3] * z);
                    }
                }
            }
    }
};
struct EpiResid {
    static constexpr bool PERM = false, AFTER_DRAIN = false;
    const float* src; float* XR; bf16_t* XB; float* SSQ;
    __device__ __forceinline__ void operator()(const f32x4 (&acc)[2][2][4][2], const Unit& u, int wr, int wc, int fr, int fq, int ui) const {
        const int row0 = u.pm * BM + wr * 64 + fr; const int col0 = u.pn * BM + wc * 32 + 4 * fq;
#pragma unroll
        for (int ai = 0; ai < 2; ++ai)
#pragma unroll
            for (int m = 0; m < 4; ++m) {
                const int row = row0 + ai * HALF + m * 16; float ss = 0.f;
#pragma unroll
                for (int bj = 0; bj < 2; ++bj)
#pragma unroll
                    for (int n = 0; n < 2; ++n) {
                        const size_t off = (size_t)row * 1024 + col0 + bj * HALF + n * 16;
                        const f32x4 o = *(const f32x4*)(src + off) + acc[ai][bj][m][n];
                        *(f32x4*)(XR + off) = o;
                        uint2 w; w.x = pk2bf(o[0], o[1]); w.y = pk2bf(o[2], o[3]); *(uint2*)(XB + off) = w;
                        ss += (o[0] * o[0] + o[1] * o[1]) + (o[2] * o[2] + o[3] * o[3]);
                    }
                ss += __shfl_xor(ss, 16); ss += __shfl_xor(ss, 32);
                if (fq == 0) SSQ[(size_t)row * 16 + u.pn * 4 + wc] = ss;
                if (m & 1) asm volatile("" ::: "memory");
            }
    }
};
template <bool F16> struct EpiScale {
    static constexpr bool PERM = true, AFTER_DRAIN = false;
    bf16_t* O; int ldc; const PG8_LAS float* rbuf; float scale;
    __device__ __forceinline__ void operator()(const f32x4 (&acc)[2][2][4][2], const Unit& u, int wr, int wc, int fr, int fq, int ui) const {
        const int lr0 = wr * 64 + fr, row0 = u.pm * BM + lr0; const int col0 = u.pn * BM + wc * 32 + 8 * fq;
        const PG8_LAS float* rb = rbuf + (ui & 1) * 256 + lr0;
#pragma unroll
        for (int ai = 0; ai < 2; ++ai)
#pragma unroll
            for (int m = 0; m < 4; ++m) {
                const int row = row0 + ai * HALF + m * 16; const float r = rb[ai * HALF + m * 16] * scale;
#pragma unroll
                for (int bj = 0; bj < 2; ++bj) {
                    const f32x4 v0 = acc[ai][bj][m][0] * r, v1 = acc[ai][bj][m][1] * r; u32x4 w;
                    if (F16) { w.x = (unsigned)f2h(v0[0]) | ((unsigned)f2h(v0[1]) << 16); w.y = (unsigned)f2h(v0[2]) | ((unsigned)f2h(v0[3]) << 16); w.z = (unsigned)f2h(v1[0]) | ((unsigned)f2h(v1[1]) << 16); w.w = (unsigned)f2h(v1[2]) | ((unsigned)f2h(v1[3]) << 16); }
                    else { w.x = pk2bf(v0[0], v0[1]); w.y = pk2bf(v0[2], v0[3]); w.z = pk2bf(v1[0], v1[1]); w.w = pk2bf(v1[2], v1[3]); }
                    *(u32x4*)(O + (size_t)row * ldc + col0 + bj * HALF) = w;
                }
            }
    }
};
}
namespace pg8 {
struct EpiKV {
    static constexpr bool PERM = true, AFTER_DRAIN = false;
    bf16_t* KVl; bf16_t* VTl; const PG8_LAS float* rbuf;
    __device__ __forceinline__ void operator()(const f32x4 (&acc)[2][2][4][2], const Unit& u, int wr, int wc, int fr, int fq, int ui) const {
        int lr0 = wr * 64 + fr; int cl0 = wc * 32 + 8 * fq; asm volatile("" : "+v"(lr0), "+v"(cl0));
        const int row0 = u.pm * BM + lr0;
        const PG8_LAS float* rb = rbuf + (ui & 1) * 256 + lr0;
#pragma unroll
        for (int ai = 0; ai < 2; ++ai)
#pragma unroll
            for (int m = 0; m < 4; ++m) {
                const int lr = lr0 + ai * HALF + m * 16; const float r = rb[ai * HALF + m * 16];
#pragma unroll
                for (int bj = 0; bj < 2; ++bj) {
                    const f32x4 v0 = acc[ai][bj][m][0] * r, v1 = acc[ai][bj][m][1] * r;
                    if (u.pn < 4) { u32x4 w; w.x = pk2bf(v0[0], v0[1]); w.y = pk2bf(v0[2], v0[3]); w.z = pk2bf(v1[0], v1[1]); w.w = pk2bf(v1[2], v1[3]);
                        *(u32x4*)(KVl + (size_t)(row0 + ai * HALF + m * 16) * 2048 + u.pn * BM + cl0 + bj * HALF) = w; }
                    else { bf16_t* vt = VTl + ((size_t)(u.pm * 4 + (u.pn - 4)) * 256 + cl0 + bj * HALF) * 256 + lr;
                        vt[0 * 256] = f2bf(v0[0]); vt[1 * 256] = f2bf(v0[1]); vt[2 * 256] = f2bf(v0[2]); vt[3 * 256] = f2bf(v0[3]);
                        vt[4 * 256] = f2bf(v1[0]); vt[5 * 256] = f2bf(v1[1]); vt[6 * 256] = f2bf(v1[2]); vt[7 * 256] = f2bf(v1[3]); }
                }
            }
    }
};
}
__device__ __forceinline__ int win_colmap(int n) { if (n < 1536 || n >= 2560) return n; const int hb = n & ~127, j = n & 127; return hb + (j >> 1) + 64 * (j & 1); }
__device__ __forceinline__ void tr_item(const float* __restrict__ W, int K, int N, const float* __restrict__ g, bool perm, bf16_t* __restrict__ WT, float* scr, int item, int lane) {
    const int nblk = N / 32, kb = item / nblk, nb = item % nblk, k0 = 64 * kb, n0 = 32 * nb;
    const int nn = n0 + (lane & 31); const int ns = perm ? win_colmap(nn) : nn;
#pragma unroll 8
    for (int i = 0; i < 32; ++i) { const int kk = 2 * i + (lane >> 5); const float gg = g ? g[k0 + kk] : 1.0f; scr[kk * 33 + (lane & 31)] = W[(size_t)(k0 + kk) * N + ns] * gg; }
    asm volatile("s_waitcnt lgkmcnt(0)" ::: "memory");
    const int c = lane & 7;
#pragma unroll
    for (int j = 0; j < 4; ++j) { const int n = (lane >> 3) + 8 * j; const float* s = scr + (8 * c) * 33 + n;
        uint4 o; o.x = pk2bf(s[0 * 33], s[1 * 33]); o.y = pk2bf(s[2 * 33], s[3 * 33]); o.z = pk2bf(s[4 * 33], s[5 * 33]); o.w = pk2bf(s[6 * 33], s[7 * 33]);
        *(uint4*)(WT + (size_t)(n0 + n) * K + k0 + 8 * c) = o; }
    asm volatile("s_waitcnt lgkmcnt(0)" ::: "memory");
}
__device__ __forceinline__ void peer_fold_item(const float* __restrict__ wpq, const float* __restrict__ keys, const float* __restrict__ g, bf16_t* __restrict__ WPT, float* scr, int item, const int tid) {
    const int hp = item >> 4, k0 = (item & 15) * 64;
    float* ws_ = scr;
    float* ks_ = scr + 64 * 132;
    for (int i = tid; i < 64 * 32; i += 512) { const int kk = i >> 5, d4 = (i & 31) * 4; const float4 v = *(const float4*)(wpq + (size_t)(k0 + kk) * 2048 + hp * 128 + d4); const float gg = g[k0 + kk];
        float* o = ws_ + kk * 132 + d4; o[0] = v.x * gg; o[1] = v.y * gg; o[2] = v.z * gg; o[3] = v.w * gg; }
    for (int i = tid; i < 128 * 32; i += 512) { const int ky = i >> 5, d4 = (i & 31) * 4; const float4 v = *(const float4*)(keys + ((size_t)hp * 128 + ky) * 128 + d4);
        float* o = ks_ + ky * 132 + d4; o[0] = v.x; o[1] = v.y; o[2] = v.z; o[3] = v.w; }
    __syncthreads();
    const int key = tid & 127, kg = tid >> 7;
    float acc[16];
#pragma unroll
    for (int j = 0; j < 16; ++j) acc[j] = 0.f;
    for (int d = 0; d < 128; d += 4) {
        const float4 kv = *(const float4*)(ks_ + key * 132 + d);
#pragma unroll
        for (int j = 0; j < 16; ++j) { const float4 wv = *(const float4*)(ws_ + (kg * 16 + j) * 132 + d); acc[j] += kv.x * wv.x + kv.y * wv.y + kv.z * wv.z + kv.w * wv.w; }
    }
    uint4 o0, o1;
    o0.x = pk2bf(acc[0], acc[1]); o0.y = pk2bf(acc[2], acc[3]); o0.z = pk2bf(acc[4], acc[5]); o0.w = pk2bf(acc[6], acc[7]);
    o1.x = pk2bf(acc[8], acc[9]); o1.y = pk2bf(acc[10], acc[11]); o1.z = pk2bf(acc[12], acc[13]); o1.w = pk2bf(acc[14], acc[15]);
    uint4* dst = (uint4*)(WPT + (size_t)(hp * 128 + key) * 1024 + k0 + kg * 16);
    dst[0] = o0; dst[1] = o1;
    __syncthreads();
}
__device__ __forceinline__ void row_to_bf16_ssq(const float* __restrict__ xrow, bf16_t* __restrict__ orow, float* __restrict__ ssq, int lane) {
    const float4* xr = (const float4*)xrow; float s = 0.f;
#pragma unroll
    for (int i = 0; i < 4; ++i) { const float4 v = xr[lane + 64 * i]; s += (v.x * v.x + v.y * v.y) + (v.z * v.z + v.w * v.w);
        uint2 w; w.x = pk2bf(v.x, v.y); w.y = pk2bf(v.z, v.w); ((uint2*)orow)[lane + 64 * i] = w; }
    s = wave_sum(s);
    if (lane < 16) ssq[lane] = lane == 0 ? s : 0.f;
}
__device__ __forceinline__ void d_rmsnorm_final(const int vb, const int vtid, float* XR, const float* g) {
    const int row = vb * 4 + (vtid >> 6), lane = vtid & 63;
    float4* xr = (float4*)(XR + (size_t)row * DM);
    float4 v[4]; float s = 0.f;
#pragma unroll
    for (int i = 0; i < 4; ++i) { v[i] = xr[lane + 64 * i]; s += v[i].x * v[i].x + v[i].y * v[i].y + v[i].z * v[i].z + v[i].w * v[i].w; }
    s = wave_sum(s);
    const float r = rsqrtf(s * (1.0f / DM) + EPS);
#pragma unroll
    for (int i = 0; i < 4; ++i) { const float4 gg = ((const float4*)g)[lane + 64 * i];
        float4 y; y.x = v[i].x * r * gg.x; y.y = v[i].y * r * gg.y; y.z = v[i].z * r * gg.z; y.w = v[i].w * r * gg.w; xr[lane + 64 * i] = y; }
}
typedef float f32x2 __attribute__((ext_vector_type(2)));
template <int CTRL> __device__ __forceinline__ float dpp_f(float v) { return __builtin_bit_cast(float, __builtin_amdgcn_update_dpp(0, __builtin_bit_cast(int, v), CTRL, 0xF, 0xF, false)); }
template <int CTRL> __device__ __forceinline__ unsigned dpp_u(unsigned v) { return (unsigned)__builtin_amdgcn_update_dpp(0, (int)v, CTRL, 0xF, 0xF, false); }
constexpr int NEXP = 16384;
__device__ __forceinline__ void table_row_to_fp8(const float* __restrict__ row, const float* __restrict__ g, unsigned char* __restrict__ T8, float* __restrict__ isc, int e, int lane) {
    float v[16]; float mx = 0.f;
#pragma unroll
    for (int i = 0; i < 4; ++i) { const float4 a = ((const float4*)row)[lane * 4 + i]; float4 gg = make_float4(1.f, 1.f, 1.f, 1.f); if (g) gg = ((const float4*)g)[lane * 4 + i];
        v[4 * i] = a.x * gg.x; v[4 * i + 1] = a.y * gg.y; v[4 * i + 2] = a.z * gg.z; v[4 * i + 3] = a.w * gg.w;
        mx = fmaxf(mx, fmaxf(fmaxf(fabsf(v[4 * i]), fabsf(v[4 * i + 1])), fmaxf(fabsf(v[4 * i + 2]), fabsf(v[4 * i + 3])))); }
    mx = wave_max(mx);
    const float sc = mx > 0.f ? 224.0f / mx : 1.0f;
    uint4 o; unsigned w[4];
#pragma unroll
    for (int i = 0; i < 4; ++i) { int p = __builtin_amdgcn_cvt_pk_fp8_f32(v[4 * i] * sc, v[4 * i + 1] * sc, 0, false); p = __builtin_amdgcn_cvt_pk_fp8_f32(v[4 * i + 2] * sc, v[4 * i + 3] * sc, p, true); w[i] = (unsigned)p; }
    o.x = w[0]; o.y = w[1]; o.z = w[2]; o.w = w[3];
    *(uint4*)(T8 + ((size_t)(lane >> 3) * NEXP + e) * 128 + (lane & 7) * 16) = o;
    if (lane == 0) isc[e] = mx > 0.f ? mx * (1.0f / 224.0f) : 1.0f;
}

#define PK_CE(a, b) { const unsigned t_ = (a) > (b) ? (a) : (b); b = (a) > (b) ? (b) : (a); a = t_; }
__device__ __forceinline__ void sort16_desc(unsigned (&v)[16]) {
#pragma unroll
    for (int k = 2; k <= 16; k <<= 1)
#pragma unroll
        for (int j = k >> 1; j > 0; j >>= 1)
#pragma unroll
            for (int i = 0; i < 16; ++i) { const int l = i ^ j; if (l > i) { if ((i & k) == 0) PK_CE(v[i], v[l]) else PK_CE(v[l], v[i]) } }
}
__device__ __forceinline__ void merge16_desc(unsigned (&R)[16], const unsigned (&N)[16]) {
#pragma unroll
    for (int i = 0; i < 16; ++i) R[i] = R[i] > N[15 - i] ? R[i] : N[15 - i];
#pragma unroll
    for (int j = 8; j > 0; j >>= 1)
#pragma unroll
        for (int i = 0; i < 16; ++i) { const int l = i ^ j; if (l > i) PK_CE(R[i], R[l]) }
}
__device__ __forceinline__ void peer_topk_fast(const bf16_t* __restrict__ SC, int* __restrict__ IDX, float* __restrict__ GATE, int t, int hp) {
    const uint4* src = (const uint4*)(SC + (size_t)t * 2048 + hp * 128);
    unsigned R[16];
#pragma unroll
    for (int g = 0; g < 8; ++g) {
        const uint4 a = src[2 * g], b = src[2 * g + 1]; const unsigned dw[8] = {a.x, a.y, a.z, a.w, b.x, b.y, b.z, b.w};
        unsigned N[16];
#pragma unroll
        for (int k = 0; k < 8; ++k) { const unsigned w = dw[k]; const unsigned m = ((w >> 15) & 0x00010001u) * 0x7FFFu; const unsigned u = w ^ (m | 0x80008000u);
            N[2 * k] = (u << 16) | (unsigned)(127 - (g * 16 + 2 * k)); N[2 * k + 1] = (u & 0xFFFF0000u) | (unsigned)(127 - (g * 16 + 2 * k + 1)); }
        sort16_desc(N);
        if (g == 0) {
#pragma unroll
            for (int i = 0; i < 16; ++i) R[i] = N[i];
        } else merge16_desc(R, N);
    }
    const int p = hp & 1;
    unsigned F[16];
#pragma unroll
    for (int r = 0; r < 16; ++r) {
        const unsigned u = R[r] >> 16; const unsigned hb = (u & 0x8000u) ? (u & 0x7FFFu) : (~u & 0xFFFFu);
        const float s = h2f((unsigned short)hb); const int id = 127 - (int)(R[r] & 127u);
        int f = (int)rintf(s * 4096.0f); f = f < -65535 ? -65535 : (f > 65535 ? 65535 : f);
        F[r] = p ? (unsigned)(f * 16384 + id) : (((unsigned)(f + 131072) << 14) + ((unsigned)id << 7));
    }
    unsigned F0[16], F1[16];
#pragma unroll
    for (int r = 0; r < 16; ++r) { const unsigned o = dpp_u<0xB1>(F[r]); F0[r] = p ? o : F[r]; F1[r] = p ? F[r] : o; }
    unsigned A[16], B[16];
#pragma unroll
    for (int j = 0; j < 16; ++j) A[j] = F0[0] + F1[j];
#pragma unroll
    for (int j = 0; j < 8; ++j) B[j] = F0[1] + F1[j];
#pragma unroll
    for (int j = 0; j < 5; ++j) B[8 + j] = F0[2] + F1[j];
#pragma unroll
    for (int j = 0; j < 3; ++j) B[13 + j] = F0[4] + F1[j];
    sort16_desc(B); merge16_desc(A, B);
#pragma unroll
    for (int j = 0; j < 4; ++j) B[j] = F0[3] + F1[j];
#pragma unroll
    for (int i = 0; i < 3; ++i) { B[4 + 2 * i] = F0[5 + i] + F1[0]; B[5 + 2 * i] = F0[5 + i] + F1[1]; }
#pragma unroll
    for (int i = 0; i < 6; ++i) B[10 + i] = F0[8 + i] + F1[0];
    sort16_desc(B); merge16_desc(A, B);
#pragma unroll
    for (int i = 14; i < 16; ++i) { unsigned xk = F0[i] + F1[0];
#pragma unroll
        for (int k = 0; k < 16; ++k) PK_CE(A[k], xk) }
    float ex[16]; float sum = 0.f; const float s0 = (float)((int)(A[0] >> 14) - 131072);
#pragma unroll
    for (int r = 0; r < 16; ++r) { const float s = (float)((int)(A[r] >> 14) - 131072); ex[r] = __expf((s - s0) * (1.0f / 4096.0f)); sum += ex[r]; }
    const float inv = 1.0f / sum;
    int4 i0, i1; float4 g0, g1;
    i0.x = (int)((p ? A[8] : A[0]) & 0x3FFFu); i0.y = (int)((p ? A[9] : A[1]) & 0x3FFFu); i0.z = (int)((p ? A[10] : A[2]) & 0x3FFFu); i0.w = (int)((p ? A[11] : A[3]) & 0x3FFFu);
    i1.x = (int)((p ? A[12] : A[4]) & 0x3FFFu); i1.y = (int)((p ? A[13] : A[5]) & 0x3FFFu); i1.z = (int)((p ? A[14] : A[6]) & 0x3FFFu); i1.w = (int)((p ? A[15] : A[7]) & 0x3FFFu);
    g0.x = (p ? ex[8] : ex[0]) * inv; g0.y = (p ? ex[9] : ex[1]) * inv; g0.z = (p ? ex[10] : ex[2]) * inv; g0.w = (p ? ex[11] : ex[3]) * inv;
    g1.x = (p ? ex[12] : ex[4]) * inv; g1.y = (p ? ex[13] : ex[5]) * inv; g1.z = (p ? ex[14] : ex[6]) * inv; g1.w = (p ? ex[15] : ex[7]) * inv;
    const size_t o = (size_t)t * 128 + (hp >> 1) * 16 + p * 8;
    *(int4*)(IDX + o) = i0; *(int4*)(IDX + o + 4) = i1; *(float4*)(GATE + o) = g0; *(float4*)(GATE + o + 4) = g1;
}

__device__ __forceinline__ void peer_u_token(const bf16_t* __restrict__ xs, const int* __restrict__ idxrow, const unsigned char* __restrict__ U8s, float* __restrict__ Arow, int lane) {
    const int g = lane >> 3, j = lane & 7;
    const uint4 xa = *(const uint4*)(xs + 16 * j), xb = *(const uint4*)(xs + 16 * j + 8);
    const unsigned xw[8] = {xa.x, xa.y, xa.z, xa.w, xb.x, xb.y, xb.z, xb.w};
    f32x2 xf[8];
#pragma unroll
    for (int k = 0; k < 8; ++k) { xf[k].x = __uint_as_float(xw[k] << 16); xf[k].y = __uint_as_float(xw[k] & 0xFFFF0000u); }
    int id[16];
#pragma unroll
    for (int i = 0; i < 4; ++i) { const int4 v = *(const int4*)(idxrow + g * 16 + 4 * i); id[4 * i] = v.x; id[4 * i + 1] = v.y; id[4 * i + 2] = v.z; id[4 * i + 3] = v.w; }
    uint4 d[16];
#pragma unroll
    for (int q = 0; q < 16; ++q) d[q] = *(const uint4*)(U8s + (size_t)id[q] * 128 + j * 16);
    float r0 = 0.f, r1 = 0.f;
#pragma unroll
    for (int q = 0; q < 16; ++q) {
        const unsigned w[4] = {d[q].x, d[q].y, d[q].z, d[q].w}; f32x2 acc = {0.f, 0.f};
#pragma unroll
        for (int k = 0; k < 4; ++k) { const f32x2 a = __builtin_amdgcn_cvt_pk_f32_fp8((int)w[k], false), b = __builtin_amdgcn_cvt_pk_f32_fp8((int)w[k], true); acc = a * xf[2 * k] + acc; acc = b * xf[2 * k + 1] + acc; }
        float s = acc.x + acc.y; s += dpp_f<0xB1>(s); s += dpp_f<0x4E>(s); s += dpp_f<0x141>(s);
        if (q < 8) r0 = (q & 7) == j ? s : r0; else r1 = (q & 7) == j ? s : r1;
    }
    Arow[g * 16 + j] = r0; Arow[g * 16 + 8 + j] = r1;
}
__device__ __forceinline__ void peer_combine(const float* __restrict__ A, const int* __restrict__ IDX, float* GATE, const float* __restrict__ SSQ, const float* __restrict__ iscu, const float* __restrict__ iscv, int i) {
    const int t = i >> 7, p = i & 127;
    const float4* sp = (const float4*)(SSQ + (size_t)t * 16); const float4 s0 = sp[0], s1 = sp[1], s2 = sp[2], s3 = sp[3];
    const float q = ((s0.x + s0.y) + (s0.z + s0.w)) + ((s1.x + s1.y) + (s1.z + s1.w)) + ((s2.x + s2.y) + (s2.z + s2.w)) + ((s3.x + s3.y) + (s3.z + s3.w));
    const float rstd = rsqrtf(q * (1.0f / DM) + EPS);
    float a = 0.f;
#pragma unroll
    for (int s = 0; s < 8; ++s) a += A[((size_t)s * T + t) * 128 + p];
    const int e = IDX[i];
    a *= rstd * iscu[e];
    GATE[i] = GATE[i] * 0.5f * a * (1.f + erff(a * 0.7071067811865476f)) * iscv[e];
}
__device__ __forceinline__ void peer_v_token(const float* __restrict__ wrow, const int* __restrict__ idxrow, const unsigned char* __restrict__ V8s, float* xr, bf16_t* xb, float* ssq2, int lane) {
    const int g = lane >> 3, j = lane & 7;
    int id[16]; float wv[16];
#pragma unroll
    for (int i = 0; i < 4; ++i) { const int4 v = *(const int4*)(idxrow + g * 16 + 4 * i); id[4 * i] = v.x; id[4 * i + 1] = v.y; id[4 * i + 2] = v.z; id[4 * i + 3] = v.w;
        const float4 f = *(const float4*)(wrow + g * 16 + 4 * i); wv[4 * i] = f.x; wv[4 * i + 1] = f.y; wv[4 * i + 2] = f.z; wv[4 * i + 3] = f.w; }
    uint4 d[16];
#pragma unroll
    for (int q = 0; q < 16; ++q) d[q] = *(const uint4*)(V8s + (size_t)id[q] * 128 + j * 16);
    f32x2 acc[8];
#pragma unroll
    for (int k = 0; k < 8; ++k) acc[k] = (f32x2){0.f, 0.f};
#pragma unroll
    for (int q = 0; q < 16; ++q) {
        const unsigned w[4] = {d[q].x, d[q].y, d[q].z, d[q].w}; const f32x2 ww = {wv[q], wv[q]};
#pragma unroll
        for (int k = 0; k < 4; ++k) { const f32x2 a = __builtin_amdgcn_cvt_pk_f32_fp8((int)w[k], false), b = __builtin_amdgcn_cvt_pk_f32_fp8((int)w[k], true); acc[2 * k] = a * ww + acc[2 * k]; acc[2 * k + 1] = b * ww + acc[2 * k + 1]; }
    }
#pragma unroll
    for (int k = 0; k < 8; ++k) {
        float a = acc[k].x, b = acc[k].y;
        a += dpp_f<0x128>(a); b += dpp_f<0x128>(b);
        a += __shfl_xor(a, 16); b += __shfl_xor(b, 16);
        a += __shfl_xor(a, 32); b += __shfl_xor(b, 32);
        acc[k].x = a; acc[k].y = b;
    }
    if (g == 0) {
        float ss = 0.f; float o[16];
#pragma unroll
        for (int i = 0; i < 4; ++i) { float4 x = ((const float4*)(xr + 16 * j))[i]; x.x += acc[2 * i].x; x.y += acc[2 * i].y; x.z += acc[2 * i + 1].x; x.w += acc[2 * i + 1].y; ((float4*)(xr + 16 * j))[i] = x;
            o[4 * i] = x.x; o[4 * i + 1] = x.y; o[4 * i + 2] = x.z; o[4 * i + 3] = x.w; ss += (x.x * x.x + x.y * x.y) + (x.z * x.z + x.w * x.w); }
        uint4 b0, b1; b0.x = pk2bf(o[0], o[1]); b0.y = pk2bf(o[2], o[3]); b0.z = pk2bf(o[4], o[5]); b0.w = pk2bf(o[6], o[7]); b1.x = pk2bf(o[8], o[9]); b1.y = pk2bf(o[10], o[11]); b1.z = pk2bf(o[12], o[13]); b1.w = pk2bf(o[14], o[15]);
        *(uint4*)(xb + 16 * j) = b0; *(uint4*)(xb + 16 * j + 8) = b1;
        ss += dpp_f<0xB1>(ss); ss += dpp_f<0x4E>(ss); ss += dpp_f<0x141>(ss);
        if (j == 0) { ssq2[0] = ss; ssq2[1] = 0.f; }
    }
}
typedef short bf16x8_t __attribute__((ext_vector_type(8)));
typedef float f32x16_t __attribute__((ext_vector_type(16)));
__device__ __forceinline__ bf16x8_t mk_bf16x8(uint2 a, uint2 b) { uint4 v; v.x = a.x; v.y = a.y; v.z = b.x; v.w = b.y; return __builtin_bit_cast(bf16x8_t, v); }
__device__ __forceinline__ void xattn_unit(char* lds, const bf16_t* __restrict__ Q, const bf16_t* __restrict__ Kb, const bf16_t* __restrict__ VTb, bf16_t* __restrict__ O, int t0, int h, int tid) {
    const int lane = tid & 63, wave = __builtin_amdgcn_readfirstlane(tid >> 6), r = lane & 31, hh = lane >> 5, tq = wave & 3, dh = wave >> 2;
    char* Kl = lds; char* Vl = lds + 16896;
    bf16x8_t qf[16];
    {   const bf16_t* qrow = Q + (size_t)(t0 + tq * 32 + r) * DM + h * 256 + 8 * hh;
#pragma unroll
        for (int ks = 0; ks < 16; ++ks) qf[ks] = *(const bf16x8_t*)(qrow + 16 * ks); }
    f32x16_t o[4];
#pragma unroll
    for (int db = 0; db < 4; ++db)
#pragma unroll
        for (int i = 0; i < 16; ++i) o[db][i] = 0.f;
    float mrun = -INFINITY, lrun = 0.f;
#pragma unroll 1
    for (int mt = 0; mt < 8; ++mt) {
        const int c0 = tid, c1 = tid + 512;
        const uint4 kr0 = *(const uint4*)(Kb + (size_t)(mt * 32 + (c0 >> 5)) * 2048 + (c0 & 31) * 8);
        const uint4 kr1 = *(const uint4*)(Kb + (size_t)(mt * 32 + (c1 >> 5)) * 2048 + (c1 & 31) * 8);
        const uint4 vr0 = *(const uint4*)(VTb + (size_t)(c0 >> 2) * 256 + mt * 32 + (c0 & 3) * 8);
        const uint4 vr1 = *(const uint4*)(VTb + (size_t)(c1 >> 2) * 256 + mt * 32 + (c1 & 3) * 8);
        __syncthreads();
        *(uint4*)(Kl + (c0 >> 5) * 528 + (c0 & 31) * 16) = kr0;
        *(uint4*)(Kl + (c1 >> 5) * 528 + (c1 & 31) * 16) = kr1;
        { uint2 lo, hi; lo.x = vr0.x; lo.y = vr0.y; hi.x = vr0.z; hi.y = vr0.w; *(uint2*)(Vl + (c0 >> 2) * 72 + (c0 & 3) * 16) = lo; *(uint2*)(Vl + (c0 >> 2) * 72 + (c0 & 3) * 16 + 8) = hi; }
        { uint2 lo, hi; lo.x = vr1.x; lo.y = vr1.y; hi.x = vr1.z; hi.y = vr1.w; *(uint2*)(Vl + (c1 >> 2) * 72 + (c1 & 3) * 16) = lo; *(uint2*)(Vl + (c1 >> 2) * 72 + (c1 & 3) * 16 + 8) = hi; }
        __syncthreads();
        f32x16_t s;
#pragma unroll
        for (int i = 0; i < 16; ++i) s[i] = 0.f;
#pragma unroll
        for (int ks = 0; ks < 16; ++ks) { const bf16x8_t kf = *(const bf16x8_t*)(Kl + r * 528 + (16 * ks + 8 * hh) * 2); s = __builtin_amdgcn_mfma_f32_32x32x16_bf16(kf, qf[ks], s, 0, 0, 0); }
        float mx = s[0];
#pragma unroll
        for (int i = 1; i < 16; ++i) mx = fmaxf(mx, s[i]);
        mx = fmaxf(mx, __shfl_xor(mx, 32));
        const float mnew = fmaxf(mrun, mx); const float sc = __builtin_amdgcn_exp2f(mrun - mnew);
        float ps = 0.f;
#pragma unroll
        for (int i = 0; i < 16; ++i) { s[i] = __builtin_amdgcn_exp2f(s[i] - mnew); ps += s[i]; }
        ps += __shfl_xor(ps, 32);
        lrun = lrun * sc + ps; mrun = mnew;
#pragma unroll
        for (int db = 0; db < 4; ++db)
#pragma unroll
            for (int i = 0; i < 16; ++i) o[db][i] *= sc;
        bf16x8_t pf[2];
#pragma unroll
        for (int s2 = 0; s2 < 2; ++s2) { uint4 w; w.x = pk2bf(s[8 * s2], s[8 * s2 + 1]); w.y = pk2bf(s[8 * s2 + 2], s[8 * s2 + 3]); w.z = pk2bf(s[8 * s2 + 4], s[8 * s2 + 5]); w.w = pk2bf(s[8 * s2 + 6], s[8 * s2 + 7]); pf[s2] = __builtin_bit_cast(bf16x8_t, w); }
#pragma unroll
        for (int db = 0; db < 4; ++db)
#pragma unroll
            for (int s2 = 0; s2 < 2; ++s2) { const char* vp = Vl + (dh * 128 + db * 32 + r) * 72 + (16 * s2 + 4 * hh) * 2;
                const bf16x8_t vf = mk_bf16x8(*(const uint2*)vp, *(const uint2*)(vp + 16)); o[db] = __builtin_amdgcn_mfma_f32_32x32x16_bf16(vf, pf[s2], o[db], 0, 0, 0); }
    }
    const float inv = 1.0f / lrun;
    bf16_t* orow = O + (size_t)(t0 + tq * 32 + r) * DM + h * 256 + dh * 128 + 4 * hh;
#pragma unroll
    for (int db = 0; db < 4; ++db)
#pragma unroll
        for (int g = 0; g < 4; ++g) { uint2 w; w.x = pk2bf(o[db][4 * g] * inv, o[db][4 * g + 1] * inv); w.y = pk2bf(o[db][4 * g + 2] * inv, o[db][4 * g + 3] * inv); *(uint2*)(orow + db * 32 + 8 * g) = w; }
    __syncthreads();
}
__device__ __forceinline__ void sb_wave(bf16_t* MIXQ, const bf16_t* __restrict__ PROJ2, const bf16_t* __restrict__ SVT, const float* __restrict__ sbn, int b, int h, int t0, int lane) {
    const int r = lane & 31, hh = lane >> 5;
    bf16_t* qrow = MIXQ + ((size_t)b * SEQ + t0 + r) * DM + h * 64;
    bf16x8_t qf[4];
#pragma unroll
    for (int ks = 0; ks < 4; ++ks) qf[ks] = *(const bf16x8_t*)(qrow + 16 * ks + 8 * hh);
    const bf16_t* Kbase = PROJ2 + (size_t)b * SEQ * 1536 + h * 64 + 8 * hh;
    const bf16_t* Vbase = SVT + ((size_t)(b * 8 + h) * 64 + r) * SEQ + 4 * hh;
    f32x16_t o0, o1;
#pragma unroll
    for (int i = 0; i < 16; ++i) { o0[i] = 0.f; o1[i] = 0.f; }
    float carry = 0.f;
#pragma unroll 1
    for (int k0 = t0; k0 >= 0; k0 -= 32) {
        bf16x8_t kf[4];
#pragma unroll
        for (int ks = 0; ks < 4; ++ks) kf[ks] = *(const bf16x8_t*)(Kbase + (size_t)(k0 + r) * 1536 + 16 * ks);
        uint2 va[2][2], vb[2][2];
#pragma unroll
        for (int db = 0; db < 2; ++db)
#pragma unroll
            for (int s2 = 0; s2 < 2; ++s2) { const bf16_t* vp = Vbase + (size_t)db * 32 * SEQ + k0 + 16 * s2; va[db][s2] = *(const uint2*)vp; vb[db][s2] = *(const uint2*)(vp + 8); }
        f32x16_t s;
#pragma unroll
        for (int i = 0; i < 16; ++i) s[i] = 0.f;
#pragma unroll
        for (int ks = 0; ks < 4; ++ks) s = __builtin_amdgcn_mfma_f32_32x32x16_bf16(kf[ks], qf[ks], s, 0, 0, 0);
        const bool diag = (k0 == t0);
        float lb[16];
#pragma unroll
        for (int i = 0; i < 16; ++i) {
            const float z = s[i]; const float e = __builtin_amdgcn_exp2f(-fabsf(z));
            float v = -(fmaxf(z, 0.f) + __builtin_amdgcn_logf(1.0f + e));
            if (diag && ((i & 3) + 8 * (i >> 2) + 4 * hh >= r)) v = 0.f;
            lb[i] = v;
        }
        float gs[4], pg[4], off[4];
#pragma unroll
        for (int g = 0; g < 4; ++g) { lb[4 * g + 2] += lb[4 * g + 3]; lb[4 * g + 1] += lb[4 * g + 2]; lb[4 * g] += lb[4 * g + 1]; gs[g] = lb[4 * g]; }
#pragma unroll
        for (int g = 0; g < 4; ++g) pg[g] = __shfl_xor(gs[g], 32);
        float run = 0.f;
#pragma unroll
        for (int g = 3; g >= 0; --g) { off[g] = run + (hh == 0 ? pg[g] : 0.f); run += gs[g] + pg[g]; }
#pragma unroll
        for (int i = 0; i < 16; ++i) {
            float p = __builtin_amdgcn_exp2f(s[i] + lb[i] + off[i >> 2] + carry);
            if (diag && ((i & 3) + 8 * (i >> 2) + 4 * hh >= r)) p = 0.f;
            s[i] = p;
        }
        carry += run;
        bf16x8_t pf[2];
#pragma unroll
        for (int s2 = 0; s2 < 2; ++s2) { uint4 w; w.x = pk2bf(s[8 * s2], s[8 * s2 + 1]); w.y = pk2bf(s[8 * s2 + 2], s[8 * s2 + 3]); w.z = pk2bf(s[8 * s2 + 4], s[8 * s2 + 5]); w.w = pk2bf(s[8 * s2 + 6], s[8 * s2 + 7]); pf[s2] = __builtin_bit_cast(bf16x8_t, w); }
#pragma unroll
        for (int s2 = 0; s2 < 2; ++s2) { o0 = __builtin_amdgcn_mfma_f32_32x32x16_bf16(mk_bf16x8(va[0][s2], vb[0][s2]), pf[s2], o0, 0, 0, 0); o1 = __builtin_amdgcn_mfma_f32_32x32x16_bf16(mk_bf16x8(va[1][s2], vb[1][s2]), pf[s2], o1, 0, 0, 0); }
        if (__all(carry < -150.f)) break;
    }
    float ss = 0.f;
#pragma unroll
    for (int i = 0; i < 16; ++i) ss += o0[i] * o0[i] + o1[i] * o1[i];
    ss += __shfl_xor(ss, 32);
    const float rstd = rsqrtf(ss * (1.0f / 64.0f) + EPS);
#pragma unroll
    for (int g = 0; g < 4; ++g) {
        const int d = 8 * g + 4 * hh;
        const float4 g0 = *(const float4*)(sbn + h * 64 + d), g1 = *(const float4*)(sbn + h * 64 + 32 + d);
        uint2 w0, w1;
        w0.x = pk2bf(o0[4 * g] * rstd * g0.x, o0[4 * g + 1] * rstd * g0.y); w0.y = pk2bf(o0[4 * g + 2] * rstd * g0.z, o0[4 * g + 3] * rstd * g0.w);
        w1.x = pk2bf(o1[4 * g] * rstd * g1.x, o1[4 * g + 1] * rstd * g1.y); w1.y = pk2bf(o1[4 * g + 2] * rstd * g1.z, o1[4 * g + 3] * rstd * g1.w);
        *(uint2*)(qrow + d) = w0; *(uint2*)(qrow + 32 + d) = w1;
    }
}

__device__ __forceinline__ void ret_unit(char* lds, bf16_t* MIXQ, const bf16_t* __restrict__ PROJ2, const bf16_t* __restrict__ RKT, const bf16_t* __restrict__ RVT, const float* __restrict__ rn, int b, int h, int j, int tid) {
    const int lane = tid & 63, wave = __builtin_amdgcn_readfirstlane(tid >> 6), r = lane & 31, hh = lane >> 5;
    const int eh = wave >> 2, cq = eh ? 3 - (wave & 3) : (wave & 3);
    const int eb4 = wave & 3, dp = wave >> 2;
    char* Kl = lds; char* KzT = lds + 34816; char* VTl = lds + 69632; char* stT = lds + 104448; float* xch = (float*)(lds + 139264);
    const float lg2 = log2f(1.0f - exp2f(-5.0f - (float)h));
    const float g128 = exp2f(128.0f * lg2);
    f32x16_t st0, st1;
#pragma unroll
    for (int i = 0; i < 16; ++i) { st0[i] = 0.f; st1[i] = 0.f; }
    const size_t bh = (size_t)b * 4 + h;
#pragma unroll 1
    for (int n = 0; n < 4 * j + 4; ++n) {
        const bool full = n >= 4 * j;
        const size_t row0 = (size_t)b * SEQ + n * 128;
        __syncthreads();
#pragma unroll
        for (int i = 0; i < 4; ++i) { const int c = tid + 512 * i, rw = c >> 4, ch = c & 15;
            *(uint4*)(KzT + rw * 272 + ch * 16) = *(const uint4*)(RKT + (bh * 128 + rw) * SEQ + n * 128 + ch * 8);
            *(uint4*)(VTl + rw * 272 + ch * 16) = *(const uint4*)(RVT + (bh * 128 + rw) * SEQ + n * 128 + ch * 8);
            if (full) *(uint4*)(Kl + rw * 272 + ch * 16) = *(const uint4*)(PROJ2 + (row0 + rw) * 1536 + 512 + h * 128 + ch * 8); }
        if (full) {
#pragma unroll
            for (int g = 0; g < 4; ++g) { uint2 w0, w1; w0.x = pk2bf(st0[4 * g], st0[4 * g + 1]); w0.y = pk2bf(st0[4 * g + 2], st0[4 * g + 3]); w1.x = pk2bf(st1[4 * g], st1[4 * g + 1]); w1.y = pk2bf(st1[4 * g + 2], st1[4 * g + 3]);
                *(uint2*)(stT + (eb4 * 32 + r) * 272 + ((2 * dp) * 32 + 8 * g + 4 * hh) * 2) = w0; *(uint2*)(stT + (eb4 * 32 + r) * 272 + ((2 * dp + 1) * 32 + 8 * g + 4 * hh) * 2) = w1; }
        }
        __syncthreads();
        f32x16_t ot0, ot1;
        if (full) {
            bf16x8_t qf[8];
            {   const bf16_t* qrow = MIXQ + (row0 + cq * 32 + r) * DM + 512 + h * 128 + 8 * hh;
#pragma unroll
                for (int ks = 0; ks < 8; ++ks) qf[ks] = *(const bf16x8_t*)(qrow + 16 * ks); }
#pragma unroll
            for (int i = 0; i < 16; ++i) { ot0[i] = 0.f; ot1[i] = 0.f; }
#pragma unroll
            for (int ks = 0; ks < 8; ++ks) {
                const bf16x8_t a0 = *(const bf16x8_t*)(stT + (eh * 64 + r) * 272 + (16 * ks + 8 * hh) * 2), a1 = *(const bf16x8_t*)(stT + (eh * 64 + 32 + r) * 272 + (16 * ks + 8 * hh) * 2);
                ot0 = __builtin_amdgcn_mfma_f32_32x32x16_bf16(a0, qf[ks], ot0, 0, 0, 0); ot1 = __builtin_amdgcn_mfma_f32_32x32x16_bf16(a1, qf[ks], ot1, 0, 0, 0); }
            const float xi = exp2f((float)(cq * 32 + r + 1) * lg2);
#pragma unroll
            for (int i = 0; i < 16; ++i) { ot0[i] *= xi; ot1[i] *= xi; }
#pragma unroll 1
            for (int mb = 0; mb <= cq; ++mb) {
                f32x16_t s;
#pragma unroll
                for (int i = 0; i < 16; ++i) s[i] = 0.f;
#pragma unroll
                for (int ks = 0; ks < 8; ++ks) { const bf16x8_t a = *(const bf16x8_t*)(Kl + (mb * 32 + r) * 272 + (16 * ks + 8 * hh) * 2); s = __builtin_amdgcn_mfma_f32_32x32x16_bf16(a, qf[ks], s, 0, 0, 0); }
                const int cm = (cq - mb) * 32 + r - 4 * hh;
#pragma unroll
                for (int i = 0; i < 16; ++i) { const int dl = cm - ((i & 3) + 8 * (i >> 2)); s[i] = dl >= 0 ? s[i] * exp2f((float)dl * lg2) : 0.f; }
                bf16x8_t pf[2];
#pragma unroll
                for (int s2 = 0; s2 < 2; ++s2) { uint4 w; w.x = pk2bf(s[8 * s2], s[8 * s2 + 1]); w.y = pk2bf(s[8 * s2 + 2], s[8 * s2 + 3]); w.z = pk2bf(s[8 * s2 + 4], s[8 * s2 + 5]); w.w = pk2bf(s[8 * s2 + 6], s[8 * s2 + 7]); pf[s2] = __builtin_bit_cast(bf16x8_t, w); }
#pragma unroll
                for (int s2 = 0; s2 < 2; ++s2) {
                    const char* vp0 = VTl + (eh * 64 + r) * 272 + (mb * 32 + 16 * s2 + 4 * hh) * 2; const char* vp1 = vp0 + 32 * 272;
                    ot0 = __builtin_amdgcn_mfma_f32_32x32x16_bf16(mk_bf16x8(*(const uint2*)vp0, *(const uint2*)(vp0 + 16)), pf[s2], ot0, 0, 0, 0);
                    ot1 = __builtin_amdgcn_mfma_f32_32x32x16_bf16(mk_bf16x8(*(const uint2*)vp1, *(const uint2*)(vp1 + 16)), pf[s2], ot1, 0, 0, 0); }
            }
            float s1 = 0.f, s2v = 0.f;
#pragma unroll
            for (int i = 0; i < 16; ++i) { s1 += ot0[i] + ot1[i]; s2v += ot0[i] * ot0[i] + ot1[i] * ot1[i]; }
            s1 += __shfl_xor(s1, 32); s2v += __shfl_xor(s2v, 32);
            if (hh == 0) { xch[(eh * 128 + cq * 32 + r) * 2] = s1; xch[(eh * 128 + cq * 32 + r) * 2 + 1] = s2v; }
        }
#pragma unroll
        for (int i = 0; i < 16; ++i) { st0[i] *= g128; st1[i] *= g128; }
#pragma unroll
        for (int ks = 0; ks < 8; ++ks) {
            const bf16x8_t bv = *(const bf16x8_t*)(VTl + (eb4 * 32 + r) * 272 + (16 * ks + 8 * hh) * 2);
            const bf16x8_t a0 = *(const bf16x8_t*)(KzT + ((2 * dp) * 32 + r) * 272 + (16 * ks + 8 * hh) * 2), a1 = *(const bf16x8_t*)(KzT + ((2 * dp + 1) * 32 + r) * 272 + (16 * ks + 8 * hh) * 2);
            st0 = __builtin_amdgcn_mfma_f32_32x32x16_bf16(a0, bv, st0, 0, 0, 0); st1 = __builtin_amdgcn_mfma_f32_32x32x16_bf16(a1, bv, st1, 0, 0, 0); }
        if (full) {
            __syncthreads();
            const int c = cq * 32 + r;
            const float t1 = xch[c * 2] + xch[(128 + c) * 2], t2 = xch[c * 2 + 1] + xch[(128 + c) * 2 + 1];
            const float mu = t1 * (1.0f / 128.0f); const float var = fmaxf(t2 * (1.0f / 128.0f) - mu * mu, 0.f); const float rstd = rsqrtf(var + EPS);
            bf16_t* orow = MIXQ + (row0 + c) * DM + 512 + h * 128 + eh * 64 + 4 * hh;
            const bf16_t* grow = PROJ2 + (row0 + c) * 1536 + 1024 + h * 128 + eh * 64 + 4 * hh;
            const float* gn = rn + h * 128 + eh * 64 + 4 * hh;
#pragma unroll
            for (int g = 0; g < 4; ++g) {
                const uint2 ga = *(const uint2*)(grow + 8 * g), gb = *(const uint2*)(grow + 32 + 8 * g);
                const float4 na = *(const float4*)(gn + 8 * g), nb = *(const float4*)(gn + 32 + 8 * g);
                const float gav[4] = {__uint_as_float(ga.x << 16), __uint_as_float(ga.x & 0xFFFF0000u), __uint_as_float(ga.y << 16), __uint_as_float(ga.y & 0xFFFF0000u)};
                const float gbv[4] = {__uint_as_float(gb.x << 16), __uint_as_float(gb.x & 0xFFFF0000u), __uint_as_float(gb.y << 16), __uint_as_float(gb.y & 0xFFFF0000u)};
                const float nav[4] = {na.x, na.y, na.z, na.w}, nbv[4] = {nb.x, nb.y, nb.z, nb.w};
                float ya[4], yb[4];
#pragma unroll
                for (int k = 0; k < 4; ++k) { ya[k] = (ot0[4 * g + k] - mu) * rstd * nav[k] * (gav[k] / (1.0f + __expf(-gav[k]))); yb[k] = (ot1[4 * g + k] - mu) * rstd * nbv[k] * (gbv[k] / (1.0f + __expf(-gbv[k]))); }
                uint2 w0, w1; w0.x = pk2bf(ya[0], ya[1]); w0.y = pk2bf(ya[2], ya[3]); w1.x = pk2bf(yb[0], yb[1]); w1.y = pk2bf(yb[2], yb[3]);
                *(uint2*)(orow + 8 * g) = w0; *(uint2*)(orow + 32 + 8 * g) = w1;
            }
        }
    }
    __syncthreads();
}
struct Params { const float* in[18]; float* out; char* ws; };
constexpr int LDS_BYTES = 147456;
constexpr size_t MiB = 1u << 20;
constexpr size_t WS_ROT = 1, WS_SSQ = 2, WS_MEMSSQ = 4, WS_MEMB = 8, WS_KV = 16, WS_WIN = 48, WS_WOUT = 62, WS_WQ = 66, WS_WKV = 70, WS_WO = 78, WS_WP = 82,
                 WS_XB = 96, WS_MIXQ = 160, WS_PROJ2 = 224, WS_SVT = 320, WS_RVT = 352, WS_RKT = 384, WS_Q = 224, WS_O = 288, WS_SCORES = 224, WS_IDX = 384, WS_GATE = 400, WS_T8 = 416, WS_ISC = 5, WS_A = 224, WS_VT = 480, WS_END = 496;
#ifndef PHMASK
#define PHMASK 0xFFFFF
#endif
#define PH(k) if constexpr ((PHMASK >> (k)) & 1)
#define VB_LOOP(nvb) for (int vb = bid * 2 + (tid >> 8); vb < (nvb); vb += G * 2)

#define PHASE_VARS \
    const __attribute__((address_space(4))) Params* kp = (const __attribute__((address_space(4))) Params*)__builtin_amdgcn_kernarg_segment_ptr(); asm volatile("" : "+s"(kp)); \
    int tid = threadIdx.x; asm volatile("" : "+v"(tid)); \
    const int lane = tid & 63, wave = __builtin_amdgcn_readfirstlane(tid >> 6), vtid = tid & 255; char* lds = lds_all + (tid >> 8) * 32768; \
    PG8_LAS unsigned char* glds = (PG8_LAS unsigned char*)lds_all; PG8_LAS float* rbuf = (PG8_LAS float*)(glds + 132096); \
    const int G = gridDim.x, bid = blockIdx.x; \
    const float* x = kp->in[0]; const float* mem = kp->in[1]; const float* mix_norm = kp->in[2]; const float* w_in = kp->in[3]; const float* sb_norm = kp->in[4]; const float* ret_norm = kp->in[5]; \
    const float* w_out = kp->in[6]; const float* xa_norm = kp->in[7]; const float* mem_norm = kp->in[8]; const float* xa_wq = kp->in[9]; const float* xa_wkv = kp->in[10]; const float* xa_wo = kp->in[11]; \
    const float* peer_norm = kp->in[12]; const float* peer_wq = kp->in[13]; const float* peer_keys = kp->in[14]; const float* peer_u = kp->in[15]; const float* peer_v = kp->in[16]; const float* final_norm = kp->in[17]; \
    float* XR = kp->out; char* ws = kp->ws; \
    float* SSQ = (float*)(ws + WS_SSQ * MiB); float* MEMSSQ = (float*)(ws + WS_MEMSSQ * MiB); \
    bf16_t* MEMB = (bf16_t*)(ws + WS_MEMB * MiB); bf16_t* KV = (bf16_t*)(ws + WS_KV * MiB); \
    bf16_t* WIN_T = (bf16_t*)(ws + WS_WIN * MiB); bf16_t* WOUT_T = (bf16_t*)(ws + WS_WOUT * MiB); bf16_t* WQ_T = (bf16_t*)(ws + WS_WQ * MiB); \
    bf16_t* WKV_T = (bf16_t*)(ws + WS_WKV * MiB); bf16_t* WO_T = (bf16_t*)(ws + WS_WO * MiB); bf16_t* WP_T = (bf16_t*)(ws + WS_WP * MiB); \
    bf16_t* XB = (bf16_t*)(ws + WS_XB * MiB); bf16_t* MIXQ = (bf16_t*)(ws + WS_MIXQ * MiB); bf16_t* PROJ2 = (bf16_t*)(ws + WS_PROJ2 * MiB); \
    bf16_t* Q = (bf16_t*)(ws + WS_Q * MiB); bf16_t* O = (bf16_t*)(ws + WS_O * MiB); bf16_t* SCORES = (bf16_t*)(ws + WS_SCORES * MiB); \
    int* IDX = (int*)(ws + WS_IDX * MiB); float* GATE = (float*)(ws + WS_GATE * MiB); unsigned char* T8 = (unsigned char*)(ws + WS_T8 * MiB); float* ISC = (float*)(ws + WS_ISC * MiB); float* APART = (float*)(ws + WS_A * MiB); bf16_t* VT = (bf16_t*)(ws + WS_VT * MiB); bf16_t* SVT = (bf16_t*)(ws + WS_SVT * MiB); bf16_t* RVT = (bf16_t*)(ws + WS_RVT * MiB); bf16_t* RKT = (bf16_t*)(ws + WS_RKT * MiB); \
    (void)lane; (void)wave; (void)vtid; (void)lds; (void)glds; (void)rbuf; (void)G; (void)bid; (void)x; (void)mem; (void)mix_norm; (void)w_in; (void)sb_norm; (void)ret_norm; (void)w_out; (void)xa_norm; (void)mem_norm; \
    (void)xa_wq; (void)xa_wkv; (void)xa_wo; (void)peer_norm; (void)peer_wq; (void)peer_keys; (void)peer_u; (void)peer_v; (void)final_norm; (void)XR; (void)SSQ; (void)MEMSSQ; (void)MEMB; (void)KV; (void)WIN_T; \
    (void)WOUT_T; (void)WQ_T; (void)WKV_T; (void)WO_T; (void)WP_T; (void)XB; (void)MIXQ; (void)PROJ2; (void)Q; (void)O; (void)SCORES; (void)IDX; (void)GATE; (void)T8; (void)ISC; (void)APART; (void)VT; (void)SVT; (void)RVT; (void)RKT;

__global__ void __launch_bounds__(512, 2) mega(Params p_unused) {
    extern __shared__ __attribute__((aligned(16))) char lds_all[];
    cg::grid_group grid = cg::this_grid();
    PH(0) { PHASE_VARS
        const int gw = bid * 8 + wave, NGW = G * 8;
        float* scr = (float*)(lds_all + wave * 8448);
        for (int it = gw; it < 2 * 4352; it += NGW) {
            const int l = it / 4352; int r = it % 4352;
            if (r < 1792) { tr_item(w_in + (size_t)l * DM * INC, DM, INC, mix_norm + l * DM, true, WIN_T + (size_t)l * INC * DM, scr, r, lane); continue; } r -= 1792;
            if (r < 512) { tr_item(w_out + (size_t)l * DM * DM, DM, DM, nullptr, false, WOUT_T + (size_t)l * DM * DM, scr, r, lane); continue; } r -= 512;
            if (r < 512) { tr_item(xa_wq + (size_t)l * DM * DM, DM, DM, xa_norm + l * DM, false, WQ_T + (size_t)l * DM * DM, scr, r, lane); continue; } r -= 512;
            if (r < 1024) { tr_item(xa_wkv + (size_t)l * DM * 2048, DM, 2048, mem_norm + l * DM, false, WKV_T + (size_t)l * 2048 * DM, scr, r, lane); continue; } r -= 1024;
            tr_item(xa_wo + (size_t)l * DM * DM, DM, DM, nullptr, false, WO_T + (size_t)l * DM * DM, scr, r, lane);
        }
        for (int m = gw; m < T; m += NGW) row_to_bf16_ssq(x + (size_t)m * DM, XB + (size_t)m * DM, SSQ + (size_t)m * 16, lane);
        for (int m = gw; m < MROWS; m += NGW) row_to_bf16_ssq(mem + (size_t)m * DM, MEMB + (size_t)m * DM, MEMSSQ + (size_t)m * 16, lane);
        for (int r = gw; r < NL * 2 * NEXP; r += NGW) { const int lt = r >> 14, e = r & (NEXP - 1), l = lt >> 1, tab = lt & 1;
            table_row_to_fp8((tab ? peer_v : peer_u) + ((size_t)l * NEXP + e) * DM, tab ? nullptr : peer_norm + l * DM, T8 + (size_t)lt * 8 * NEXP * 128, ISC + (size_t)lt * NEXP, e, lane); }
        __syncthreads();
        for (int it = bid; it < NL * 256; it += G) { const int l = it >> 8;
            peer_fold_item(peer_wq + (size_t)l * DM * 2048, peer_keys + (size_t)l * 8 * 2 * 128 * 128, peer_norm + l * DM, WP_T + (size_t)l * 2048 * DM, (float*)lds_all, it & 255, tid); }
    }
    grid.sync();
    for (int l = 0; l < NL; ++l) {
        PH(1) { PHASE_VARS  pg8::Gemm g{XB, WIN_T + (size_t)l * INC * DM, T, INC, DM}; pg8::StaticOrder S; S.init(T, INC, G, bid, tid, SSQ, rbuf);
            pg8::EpiProj E{MIXQ, PROJ2, SVT, RKT, RVT, rbuf};
            pg8::gemm_phase<pg8::EpiProj, pg8::StaticOrder, true, true>(glds, g, S, E, tid); }
        PH(2) if (l == 0) { PHASE_VARS
#pragma unroll 1
            for (int ll = 0; ll < NL; ++ll) {
                pg8::Gemm g{MEMB, WKV_T + (size_t)ll * 2048 * DM, MROWS, 2048, DM}; pg8::StaticOrder S; S.init(MROWS, 2048, G, bid, tid, MEMSSQ, rbuf);
                pg8::EpiKV E{KV + (size_t)ll * MROWS * 2048, VT + (size_t)ll * NB * 4 * 256 * 256, rbuf};
                pg8::gemm_phase<pg8::EpiKV, pg8::StaticOrder, true, true>(glds, g, S, E, tid); }
        }
        grid.sync();
        PH(3) { PHASE_VARS for (int u = bid; u < NB * 4 * 4; u += G) ret_unit(lds_all, MIXQ, PROJ2, RKT, RVT, ret_norm + l * 512, u >> 4, (u >> 2) & 3, 3 - (u & 3), tid); }
        PH(4) { PHASE_VARS for (int wu = bid * 8 + wave; wu < NB * 8 * 64; wu += G * 8) sb_wave(MIXQ, PROJ2, SVT, sb_norm + l * 512, wu >> 9, (wu >> 6) & 7, (63 - (wu & 63)) * 32, lane); }
        grid.sync();
        PH(5) { PHASE_VARS  pg8::Gemm g{MIXQ, WOUT_T + (size_t)l * DM * DM, T, DM, DM}; pg8::StaticOrder S; S.init(T, DM, G, bid, tid);
            pg8::EpiResid E{l == 0 ? x : XR, XR, XB, SSQ};
            pg8::gemm_phase<pg8::EpiResid, pg8::StaticOrder, true, true>(glds, g, S, E, tid); }
        grid.sync();
        PH(6) { PHASE_VARS  pg8::Gemm g{XB, WQ_T + (size_t)l * DM * DM, T, DM, DM}; pg8::StaticOrder S; S.init(T, DM, G, bid, tid, SSQ, rbuf);
            pg8::EpiScale<false> E{Q, 1024, rbuf, 0.0625f * 1.4426950408889634f};
            pg8::gemm_phase<pg8::EpiScale<false>, pg8::StaticOrder, true, true>(glds, g, S, E, tid); }
        grid.sync();
        PH(7) { PHASE_VARS for (int u = bid; u < NB * 4 * 16; u += G) { const int tb = u & 15, h = (u >> 4) & 3, b = u >> 6;
            xattn_unit(lds_all, Q, KV + (size_t)l * MROWS * 2048 + (size_t)b * NMEM * 2048 + h * 256, VT + ((size_t)l * NB * 4 + b * 4 + h) * 65536, O, b * SEQ + tb * 128, h, tid); } }
        grid.sync();
        PH(8) { PHASE_VARS  pg8::Gemm g{O, WO_T + (size_t)l * DM * DM, T, DM, DM}; pg8::StaticOrder S; S.init(T, DM, G, bid, tid);
            pg8::EpiResid E{XR, XR, XB, SSQ};
            pg8::gemm_phase<pg8::EpiResid, pg8::StaticOrder, true, true>(glds, g, S, E, tid); }
        grid.sync();
        PH(9) { PHASE_VARS  pg8::Gemm g{XB, WP_T + (size_t)l * 2048 * DM, T, 2048, DM}; pg8::StaticOrder S; S.init(T, 2048, G, bid, tid, SSQ, rbuf);
            pg8::EpiScale<true> E{SCORES, 2048, rbuf, 1.0f};
            pg8::gemm_phase<pg8::EpiScale<true>, pg8::StaticOrder, true, true>(glds, g, S, E, tid); }
        grid.sync();
        PH(10) { PHASE_VARS for (int it = bid; it < T / 32; it += G) peer_topk_fast(SCORES, IDX, GATE, it * 32 + (tid >> 4), tid & 15); }
        grid.sync();
        PH(11) { PHASE_VARS const unsigned char* U8 = T8 + (size_t)(l * 2 + 0) * 8 * NEXP * 128;
            for (int i = bid; i < 8 * (T / 64); i += G) { const int s = i & 7, t0 = (i >> 3) * 64 + wave * 8;
#pragma unroll 1
                for (int m = 0; m < 8; ++m) { const int t = t0 + m; peer_u_token(XB + (size_t)t * DM + s * 128, IDX + (size_t)t * 128, U8 + (size_t)s * NEXP * 128, APART + ((size_t)s * T + t) * 128, lane); } } }
        grid.sync();
        PH(11) { PHASE_VARS for (int i = bid * 512 + tid; i < T * 128; i += G * 512) peer_combine(APART, IDX, GATE, SSQ, ISC + (size_t)(l * 2 + 0) * NEXP, ISC + (size_t)(l * 2 + 1) * NEXP, i); }
        grid.sync();
        PH(11) { PHASE_VARS const unsigned char* V8 = T8 + (size_t)(l * 2 + 1) * 8 * NEXP * 128;
            for (int i = bid; i < 8 * (T / 64); i += G) { const int s = i & 7, t0 = (i >> 3) * 64 + wave * 8;
#pragma unroll 1
                for (int m = 0; m < 8; ++m) { const int t = t0 + m; peer_v_token(GATE + (size_t)t * 128, IDX + (size_t)t * 128, V8 + (size_t)s * NEXP * 128, XR + (size_t)t * DM + s * 128, XB + (size_t)t * DM + s * 128, SSQ + (size_t)t * 16 + 2 * s, lane); } } }
        grid.sync();
    }
    PH(12) { PHASE_VARS VB_LOOP(T / 4) d_rmsnorm_final(vb, vtid, XR, final_norm); }
}

extern "C" void kernel_launch(void* const* d_in, const int* in_sizes, int n_in, void* d_out, int out_size, void* d_ws, size_t ws_size, hipStream_t stream) {
    static int grid_blocks = 0;
    if (grid_blocks == 0) {
        int dev = 0, cus = 0, per_cu = 0;
        (void)hipGetDevice(&dev);
        (void)hipDeviceGetAttribute(&cus, hipDeviceAttributeMultiprocessorCount, dev);
        (void)hipFuncSetAttribute((const void*)mega, hipFuncAttributeMaxDynamicSharedMemorySize, LDS_BYTES);
        (void)hipOccupancyMaxActiveBlocksPerMultiprocessor(&per_cu, (const void*)mega, 512, LDS_BYTES);
        if (per_cu < 1) { fprintf(stderr, "occupancy query says %d blocks/CU\n", per_cu); per_cu = 1; }
        grid_blocks = cus * per_cu;
        if (ws_size < WS_END * MiB || n_in != 18) { fprintf(stderr, "bad ws_size %zu / n_in %d\n", ws_size, n_in); grid_blocks = -1; }
    }
    if (grid_blocks < 0) return;
    Params p{};
    for (int i = 0; i < 18; ++i) p.in[i] = (const float*)d_in[i];
    p.out = (float*)d_out; p.ws = (char*)d_ws;
    void* args[] = {&p};
    hipError_t e = hipLaunchCooperativeKernel((const void*)mega, dim3(grid_blocks), dim3(512), args, LDS_BYTES, stream);
    if (e != hipSuccess) fprintf(stderr, "cooperative launch failed: %s (grid %d)\n", hipGetErrorString(e), grid_blocks);
}
```

```cpp
#include <hip/hip_runtime.h>
#include <hip/hip_cooperative_groups.h>
#include <stdint.h>
#include <cstdio>
#include <type_traits>
namespace cg = cooperative_groups;

typedef unsigned short bf16_t;
__device__ __forceinline__ float bf2f(bf16_t v) { return __uint_as_float(((unsigned)v) << 16); }
__device__ __forceinline__ bf16_t f2bf(float f) { unsigned u = __float_as_uint(f); u = (u + 0x7fffu + ((u >> 16) & 1u)) >> 16; return (bf16_t)u; }
typedef float f32x2_cv __attribute__((ext_vector_type(2))); typedef __bf16 bf16x2_cv __attribute__((ext_vector_type(2)));
__device__ __forceinline__ unsigned pk2bf(float lo, float hi) { f32x2_cv v = {lo, hi}; bf16x2_cv b = __builtin_convertvector(v, bf16x2_cv); return __builtin_bit_cast(unsigned, b); }
typedef unsigned u32x4_nt __attribute__((ext_vector_type(4)));
__device__ __forceinline__ void nt_st16(void* p, uint4 v) { u32x4_nt t = {v.x, v.y, v.z, v.w}; __builtin_nontemporal_store(t, (u32x4_nt*)p); }
__device__ __forceinline__ float xor32_sum(float v) { auto rr = __builtin_amdgcn_permlane32_swap(__float_as_uint(v), __float_as_uint(v), false, false); return __uint_as_float(rr[0]) + __uint_as_float(rr[1]); }
__device__ __forceinline__ float xor16_sum(float v) { auto rr = __builtin_amdgcn_permlane16_swap(__float_as_uint(v), __float_as_uint(v), false, false); return __uint_as_float(rr[0]) + __uint_as_float(rr[1]); }
__device__ __forceinline__ float xor16_max(float v) { auto rr = __builtin_amdgcn_permlane16_swap(__float_as_uint(v), __float_as_uint(v), false, false); return fmaxf(__uint_as_float(rr[0]), __uint_as_float(rr[1])); }
__device__ __forceinline__ int xor16_isum(int v) { auto rr = __builtin_amdgcn_permlane16_swap((unsigned)v, (unsigned)v, false, false); return (int)(rr[0] + rr[1]); }
__device__ __forceinline__ int xor32_isum(int v) { auto rr = __builtin_amdgcn_permlane32_swap((unsigned)v, (unsigned)v, false, false); return (int)(rr[0] + rr[1]); }
__device__ __forceinline__ float xor32_max(float v) { auto rr = __builtin_amdgcn_permlane32_swap(__float_as_uint(v), __float_as_uint(v), false, false); return fmaxf(__uint_as_float(rr[0]), __uint_as_float(rr[1])); }
__device__ __forceinline__ float xor32_get(float v, int hh) { auto rr = __builtin_amdgcn_permlane32_swap(__float_as_uint(v), __float_as_uint(v), false, false); return __uint_as_float(hh ? rr[0] : rr[1]); }
__device__ __forceinline__ unsigned short f2h(float f) { _Float16 h = (_Float16)f; return __builtin_bit_cast(unsigned short, h); }
__device__ __forceinline__ float h2f(unsigned short u) { return (float)__builtin_bit_cast(_Float16, u); }

constexpr int NB = 16, SEQ = 2048, DM = 1024, T = NB * SEQ, NL = 2, NMEM = 256, INC = 3584, MROWS = NB * NMEM;
constexpr float EPS = 1e-6f;

template <int CTRL> __device__ __forceinline__ float wdpp_f(float v) { return __builtin_bit_cast(float, __builtin_amdgcn_update_dpp(0, __builtin_bit_cast(int, v), CTRL, 0xF, 0xF, false)); }
__device__ __forceinline__ float wave_sum(float v) {
    v += wdpp_f<0xB1>(v); v += wdpp_f<0x4E>(v); v += wdpp_f<0x141>(v); v += wdpp_f<0x140>(v);
    return xor32_sum(xor16_sum(v));
}
__device__ __forceinline__ float wave_max(float v) {
    v = fmaxf(v, wdpp_f<0xB1>(v)); v = fmaxf(v, wdpp_f<0x4E>(v)); v = fmaxf(v, wdpp_f<0x141>(v)); v = fmaxf(v, wdpp_f<0x140>(v));
    return xor32_max(xor16_max(v));
}
namespace pg8 {
#define PG8_LAS __attribute__((address_space(3)))
typedef unsigned short bf16_t;
typedef short bf16x8 __attribute__((ext_vector_type(8)));
typedef float f32x4 __attribute__((ext_vector_type(4)));
typedef int i32x4 __attribute__((ext_vector_type(4)));
__device__ __forceinline__ f32x4 tof(f32x4 v) { return v; }
__device__ __forceinline__ f32x4 tof(i32x4 v) { return __builtin_convertvector(v, f32x4); }
typedef unsigned u32x4 __attribute__((ext_vector_type(4)));
constexpr int BM = 256, BK = 64, HALF = 128, HTB = HALF * BK * 2  , STAGE_BYTES = 8 * HTB, NXCD = 8, WGM = 8;

__host__ __device__ __forceinline__ int lds_byte(int r, int c) { const int st = (r >> 4) * 2 + (c >> 5), rr = r & 15, cc = c & 31, ob = rr * 64 + cc * 2; return st * 1024 + (ob ^ (((ob >> 9) & 1) << 5)); }
__host__ __device__ __forceinline__ void stage_rc(int b, int& R, int& C) { const int st = b / 1024, sb = b % 1024, swz = sb ^ (((sb >> 9) & 1) << 5); R = (st >> 1) * 16 + swz / 64; C = (st & 1) * 32 + (swz % 64) / 2; }
__host__ __device__ __forceinline__ int perm32(int rho) { const int n = rho >> 4, i = rho & 15; return 8 * (i >> 2) + 4 * n + (i & 3); }

struct Unit { int pm, pn; };
struct Gemm { const bf16_t* A; const bf16_t* Bt; int M, N, K; };

struct StaticOrder {
    int nM, nN, nwg, G, c;
    __host__ __device__ __forceinline__ void init(int M, int N, int G_, int c_, int tid_in, const float* ssq = nullptr, PG8_LAS float* rb = nullptr, const float* xs = nullptr, const float* cs = nullptr) { tidm = tid_in; SSQ = ssq; rbuf = rb; XS = xs; CS = cs; nM = M / BM; nN = N / BM; nwg = nM * nN; G = G_; c = c_; }
    __host__ __device__ __forceinline__ bool next(int i, Unit& u) const {
        const long L = (long)i * G + c; if (L >= nwg) return false;
        int wgid = (int)L; { const int q = nwg / NXCD, r = nwg % NXCD, xcd = wgid % NXCD, off = wgid / NXCD; wgid = (xcd < r ? xcd * (q + 1) : r * (q + 1) + (xcd - r) * q) + off; }
        const int nig = WGM * nN, gid = wgid / nig, fm = gid * WGM, gsz = (nM - fm) < WGM ? (nM - fm) : WGM;
        u.pm = fm + ((wgid % nig) % gsz); u.pn = (wgid % nig) / gsz; return true;
    }
    const float* XS;
    const float* CS;
    int tidm; const float* SSQ; PG8_LAS float* rbuf;
    __device__ __forceinline__ void a_ready(const Unit& u, int ui) const {
        if (SSQ) { const int t = tidm; if (t < 256) { const f32x4* p = (const f32x4*)(SSQ + (size_t)(u.pm * BM + t) * 16); const f32x4 a = p[0], b = p[1], c = p[2], d = p[3];
            const float xs = XS ? XS[u.pm * BM + t] : 1.0f; const float cs = CS ? CS[u.pn * BM + t] : 0.f;
            const float q = ((a[0] + a[1]) + (a[2] + a[3])) + ((b[0] + b[1]) + (b[2] + b[3])) + ((c[0] + c[1]) + (c[2] + c[3])) + ((d[0] + d[1]) + (d[2] + d[3]));
            rbuf[(ui & 1) * 256 + t] = rsqrtf(q * (1.0f / 1024.0f) + 1e-6f) * xs; if (CS) rbuf[512 + (ui & 1) * 256 + t] = cs; } }
    }
    __device__ __forceinline__ void done(const Unit&) const {}
};

__device__ __forceinline__ unsigned cvt_pk_bf16(float lo, float hi) { unsigned r; asm volatile("v_cvt_pk_bf16_f32 %0, %1, %2" : "=v"(r) : "v"(lo), "v"(hi)); return r; }
typedef float f32x2 __attribute__((ext_vector_type(2)));
template <class Epi, class Sched, bool ALIGN_EPI = false, bool SP2 = false, bool I8 = false>
__device__ __forceinline__ void gemm_phase(PG8_LAS unsigned char* lds, const Gemm g, const Sched& S, const Epi& E, const int tid_in) {
    const int tid = tid_in, wid = __builtin_amdgcn_readfirstlane(tid >> 6), lane = tid & 63, wr = wid >> 2, wc = wid & 3, fr = lane & 15, fq = lane >> 4;
    const int K = g.K, nt = K / BK;
    unsigned voffA[2], voffB[2];
#pragma unroll
    for (int i = 0; i < 2; ++i) { int R, C; stage_rc(tid * 16 + i * 8192, R, C); const int Rb = Epi::PERM ? ((R & ~31) + perm32(R & 31)) : R;
        voffA[i] = (unsigned)(R * K + C) * 2u; voffB[i] = (unsigned)(Rb * K + C) * 2u; }
    const size_t kstep = (size_t)(BK * 2);
    const size_t hstep = (size_t)HALF * K * 2;
    const size_t tstep = 2 * hstep;
    const unsigned ldsw = (unsigned)wid * 1024u;
    const int aoff = lds_byte(wr * 64 + fr, fq * 8), boff = lds_byte(wc * 32 + fr, fq * 8);
#define PG8_SA(b, h) (((b) * 2 + (h)) * HTB)
#define PG8_SB(b, h) ((4 + (b) * 2 + (h)) * HTB)
#define PG8_STAGE(bufoff, gbase, voff) do { _Pragma("unroll") for (int _i = 0; _i < 2; ++_i) \
        __builtin_amdgcn_global_load_lds((const unsigned*)((const char*)(gbase) + (voff)[_i]), (PG8_LAS unsigned*)(lds + (bufoff) + ldsw + _i * 8192), 16, 0, 0); } while (0)
#define PG8_LDA(dst, b, h) do { _Pragma("unroll") for (int m = 0; m < 4; ++m) _Pragma("unroll") for (int k = 0; k < 2; ++k) dst[m][k] = *(const PG8_LAS bf16x8*)(lds + PG8_SA(b, h) + aoff + m * 2048 + k * 1024); } while (0)
#define PG8_LDB(dst, b, h) do { _Pragma("unroll") for (int n = 0; n < 2; ++n) _Pragma("unroll") for (int k = 0; k < 2; ++k) dst[n][k] = *(const PG8_LAS bf16x8*)(lds + PG8_SB(b, h) + boff + n * 2048 + k * 1024); } while (0)
#define PG8_MMA(ai, bj, At, Bt) do { __builtin_amdgcn_s_setprio(1); _Pragma("unroll") for (int m = 0; m < 4; ++m) _Pragma("unroll") for (int n = 0; n < 2; ++n) _Pragma("unroll") for (int k = 0; k < 2; ++k) \
        { if constexpr (I8) acc[ai][bj][m][n] = __builtin_bit_cast(acc_t, __builtin_amdgcn_mfma_i32_16x16x64_i8(__builtin_bit_cast(i32x4, Bt[n][k]), __builtin_bit_cast(i32x4, At[m][k]), __builtin_bit_cast(i32x4, acc[ai][bj][m][n]), 0, 0, 0)); \
          else acc[ai][bj][m][n] = __builtin_bit_cast(acc_t, __builtin_amdgcn_mfma_f32_16x16x32_bf16(Bt[n][k], At[m][k], __builtin_bit_cast(f32x4, acc[ai][bj][m][n]), 0, 0, 0)); } __builtin_amdgcn_s_setprio(0); } while (0)
#define PG8_WAIT_V(n) asm volatile("s_waitcnt vmcnt(" #n ")" ::: "memory")
#define PG8_WAIT_L(n) asm volatile("s_waitcnt lgkmcnt(" #n ")" ::: "memory")
#define PG8_BAR __builtin_amdgcn_s_barrier()
#define PG8_SCHED __builtin_amdgcn_sched_barrier(0)
    Unit cur, nxt; int ui = 0;
    if (!S.next(0, cur)) return;
    typedef typename std::conditional<I8, i32x4, f32x4>::type acc_t;
    acc_t acc[2][2][4][2];
#pragma unroll
    for (int a = 0; a < 2; ++a)
#pragma unroll
        for (int b = 0; b < 2; ++b)
#pragma unroll
            for (int m = 0; m < 4; ++m)
#pragma unroll
                for (int n = 0; n < 2; ++n) acc[a][b][m][n] = acc_t{};
    bf16x8 At[4][2], B0[2][2], B1[2][2];
    const char* cA = (const char*)g.A + (size_t)cur.pm * tstep; const char* cB = (const char*)g.Bt + (size_t)cur.pn * tstep;
    S.a_ready(cur, 0);
    if constexpr (SP2) {
        PG8_STAGE(PG8_SB(0, 0), cB, voffB); PG8_STAGE(PG8_SB(0, 1), cB + hstep, voffB); PG8_STAGE(PG8_SA(0, 0), cA, voffA); PG8_STAGE(PG8_SA(0, 1), cA + hstep, voffA);
        if (wr == 1) PG8_BAR;
        PG8_WAIT_V(2); PG8_BAR;
        PG8_STAGE(PG8_SB(1, 0), cB + kstep, voffB); PG8_STAGE(PG8_SA(1, 0), cA + kstep, voffA); PG8_STAGE(PG8_SB(1, 1), cB + hstep + kstep, voffB);
        PG8_WAIT_V(6); PG8_BAR;
    } else {
        PG8_STAGE(PG8_SB(0, 0), cB, voffB); PG8_STAGE(PG8_SA(0, 0), cA, voffA); PG8_STAGE(PG8_SB(0, 1), cB + hstep, voffB); PG8_STAGE(PG8_SA(0, 1), cA + hstep, voffA);
        if (wr == 1) PG8_BAR;
        PG8_WAIT_V(4); PG8_BAR;
        PG8_STAGE(PG8_SB(1, 0), cB + kstep, voffB); PG8_STAGE(PG8_SA(1, 0), cA + kstep, voffA); PG8_STAGE(PG8_SB(1, 1), cB + hstep + kstep, voffB);
        PG8_WAIT_V(6); PG8_BAR;
    }
    for (;;) {
        const bool has_next = S.next(ui + 1, nxt);
        const char* nA = has_next ? (const char*)g.A + (size_t)nxt.pm * tstep : cA; const char* nB = has_next ? (const char*)g.Bt + (size_t)nxt.pn * tstep : cB;
        for (int t = 0; t < nt; t += 2) {
            const bool last = (t == nt - 2);
            const char* a1 = cA + (size_t)(t + 1) * kstep;
            const char* a2 = last ? nA : cA + (size_t)(t + 2) * kstep; const char* b2 = last ? nB : cB + (size_t)(t + 2) * kstep;
            const char* a3 = a2 + kstep; const char* b3 = b2 + kstep;
            if (last && has_next) S.a_ready(nxt, ui + 1);
            if constexpr (SP2) {
            PG8_LDB(B0, 0, 0); PG8_LDB(B1, 0, 1); PG8_SCHED; PG8_LDA(At, 0, 0); PG8_STAGE(PG8_SA(1, 1), a1 + hstep, voffA);
            PG8_WAIT_V(8); PG8_WAIT_L(0); PG8_BAR; PG8_MMA(0, 0, At, B0); PG8_MMA(0, 1, At, B1); PG8_BAR; PG8_SCHED;
            PG8_LDA(At, 0, 1); PG8_STAGE(PG8_SB(0, 0), b2, voffB); PG8_STAGE(PG8_SB(0, 1), b2 + hstep, voffB); PG8_STAGE(PG8_SA(0, 0), a2, voffA);
            PG8_WAIT_V(8); PG8_WAIT_L(0); PG8_BAR; PG8_MMA(1, 0, At, B0); PG8_MMA(1, 1, At, B1); PG8_BAR; PG8_SCHED;
            PG8_LDB(B0, 1, 0); PG8_LDB(B1, 1, 1); PG8_SCHED; PG8_LDA(At, 1, 0); PG8_STAGE(PG8_SA(0, 1), a2 + hstep, voffA);
            PG8_WAIT_V(8); PG8_WAIT_L(0); PG8_BAR; PG8_MMA(0, 0, At, B0); PG8_MMA(0, 1, At, B1); PG8_BAR; PG8_SCHED;
            PG8_LDA(At, 1, 1); PG8_STAGE(PG8_SB(1, 0), b3, voffB); PG8_STAGE(PG8_SB(1, 1), b3 + hstep, voffB); PG8_STAGE(PG8_SA(1, 0), a3, voffA);
            PG8_WAIT_V(8); PG8_WAIT_L(0); PG8_BAR; PG8_MMA(1, 0, At, B0); PG8_MMA(1, 1, At, B1); PG8_BAR; PG8_SCHED;
            } else {
            PG8_LDB(B0, 0, 0); PG8_SCHED; PG8_LDA(At, 0, 0); PG8_STAGE(PG8_SA(1, 1), a1 + hstep, voffA);
            PG8_WAIT_L(8); PG8_BAR; PG8_WAIT_L(0); PG8_MMA(0, 0, At, B0); PG8_BAR; PG8_SCHED;
            PG8_LDB(B1, 0, 1); PG8_STAGE(PG8_SB(0, 0), b2, voffB);
            PG8_BAR; PG8_WAIT_L(0); PG8_MMA(0, 1, At, B1); PG8_BAR;
            PG8_LDA(At, 0, 1); PG8_STAGE(PG8_SA(0, 0), a2, voffA);
            PG8_BAR; PG8_WAIT_L(0); PG8_MMA(1, 0, At, B0); PG8_BAR; PG8_SCHED;
            PG8_STAGE(PG8_SB(0, 1), b2 + hstep, voffB);
            PG8_WAIT_V(6); PG8_BAR; PG8_MMA(1, 1, At, B1); PG8_BAR;
            PG8_LDB(B0, 1, 0); PG8_SCHED; PG8_LDA(At, 1, 0); PG8_STAGE(PG8_SA(0, 1), a2 + hstep, voffA);
            PG8_WAIT_L(8); PG8_BAR; PG8_WAIT_L(0); PG8_MMA(0, 0, At, B0); PG8_BAR; PG8_SCHED;
            PG8_LDB(B1, 1, 1); PG8_STAGE(PG8_SB(1, 0), b3, voffB);
            PG8_BAR; PG8_WAIT_L(0); PG8_MMA(0, 1, At, B1); PG8_BAR;
            PG8_LDA(At, 1, 1); PG8_STAGE(PG8_SA(1, 0), a3, voffA);
            PG8_BAR; PG8_WAIT_L(0); PG8_MMA(1, 0, At, B0); PG8_BAR; PG8_SCHED;
            PG8_STAGE(PG8_SB(1, 1), b3 + hstep, voffB);
            PG8_WAIT_V(6); PG8_BAR; PG8_MMA(1, 1, At, B1); PG8_BAR;
            }
        }
        if constexpr (ALIGN_EPI) { if (wr == 0) PG8_BAR; }
        if constexpr (!Epi::AFTER_DRAIN) { E(acc, cur, wr, wc, fr, fq, ui); S.done(cur); }
        if (!has_next) break;
#pragma unroll
        for (int a = 0; a < 2; ++a)
#pragma unroll
            for (int b = 0; b < 2; ++b)
#pragma unroll
                for (int m = 0; m < 4; ++m)
#pragma unroll
                    for (int n = 0; n < 2; ++n) acc[a][b][m][n] = acc_t{};
        cur = nxt; cA = nA; cB = nB; ++ui;
        if constexpr (ALIGN_EPI) { if (wr == 1) PG8_BAR; }
    }
    PG8_WAIT_V(0);
    if constexpr (!ALIGN_EPI) { if (wr == 0) PG8_BAR; }
    PG8_BAR;
    if constexpr (Epi::AFTER_DRAIN) { E.fused(acc, cur, wr, wc, fr, fq, lds, wid, lane); S.done(cur); }
#undef PG8_SA
#undef PG8_SB
#undef PG8_STAGE
#undef PG8_LDA
#undef PG8_LDB
#undef PG8_MMA
#undef PG8_WAIT_V
#undef PG8_WAIT_L
#undef PG8_BAR
#undef PG8_SCHED
}
}
namespace pg8 {
struct EpiProj {
    static constexpr bool PERM = true, AFTER_DRAIN = false;
    bf16_t* MIXQ; bf16_t* PROJ2; bf16_t* SVT; bf16_t* RKT; bf16_t* RVT; const PG8_LAS float* rbuf; const float* WMAX; PG8_LAS unsigned char* tbuf;
    template <class AccT> __device__ __forceinline__ void operator()(const AccT (&acc)[2][2][4][2], const Unit& u, int wr, int wc, int fr, int fq, int ui) const {
        int lr0 = wr * 64 + fr, cl0 = wc * 32 + 8 * fq; asm volatile("" : "+v"(lr0), "+v"(cl0));
        const int row0 = u.pm * BM + lr0; const int pn = u.pn;
        const bool rowmajor = !(pn == 4 || pn == 5 || pn == 10 || pn == 11);
        if (rowmajor) { if (pn >= 6 && pn < 10) rows<true>(acc, u, lr0, cl0, ui); else rows<false>(acc, u, lr0, cl0, ui); }
        if (pn == 8 || pn == 9) trans<true>(acc, u, wr, wc, fr, fq, ui); else if (pn == 4 || pn == 5 || pn == 10 || pn == 11) trans<false>(acc, u, wr, wc, fr, fq, ui);
    }
    template <bool ROT, class AccT> __device__ __forceinline__ void rows(const AccT (&acc)[2][2][4][2], const Unit& u, int lr0, int cl0, int ui) const {
        const int row0 = u.pm * BM + lr0; const int pn = u.pn;
        f32x4 wsc[2][2];
#pragma unroll
        for (int bj = 0; bj < 2; ++bj) { const PG8_LAS f32x4* wp = (const PG8_LAS f32x4*)(rbuf + 512 + (ui & 1) * 256 + bj * HALF + cl0); wsc[bj][0] = wp[0]; wsc[bj][1] = wp[1]; }
        const PG8_LAS float* rb = rbuf + (ui & 1) * 256 + lr0;
        float f[4] = {0.f, 0.f, 0.f, 0.f};
        if (ROT) {
#pragma unroll
            for (int jj = 0; jj < 4; ++jj) f[jj] = exp2f(-(float)(2 * ((cl0 >> 1) + jj)) * (13.287712379549449f / 128.0f)) * 0.15915494309189535f;
        }
        const float sc = pn < 2 ? 0.125f * 1.4426950408889634f : ((pn == 8 || pn == 9) ? 0.08838834764831845f : 1.0f);
        const int s0 = row0 & (SEQ - 1);
        const bool toP = (pn >= 2 && pn < 4) || pn >= 8;
        const int dcol = pn < 2 ? pn * 256 : (pn < 4 ? (pn - 2) * 256 : (pn < 8 ? 512 + (pn - 6) * 256 : (pn < 10 ? 512 + (pn - 8) * 256 : 1024 + (pn - 12) * 256)));
        const size_t dstride = toP ? 1536 * 2 : 1024 * 2;
        char* dptr = (char*)MIXQ + (toP ? ((size_t)64 << 20) : (size_t)0) + (size_t)row0 * dstride + (size_t)(dcol + cl0) * 2;
#pragma unroll
        for (int ai = 0; ai < 2; ++ai)
#pragma unroll
            for (int m = 0; m < 4; ++m) {
                const int spos = s0 + ai * HALF + m * 16; const float r = rb[ai * HALF + m * 16] * sc;
                float cs[4] = {1.f, 1.f, 1.f, 1.f}, sn[4] = {0.f, 0.f, 0.f, 0.f};
                if (ROT) {
#pragma unroll
                    for (int jj = 0; jj < 4; ++jj) { const float xr = __builtin_amdgcn_fractf((float)spos * f[jj]); cs[jj] = __builtin_amdgcn_cosf(xr); sn[jj] = __builtin_amdgcn_sinf(xr); }
                }
#pragma unroll
                for (int bj = 0; bj < 2; ++bj) {
                    const f32x4 a = tof(acc[ai][bj][m][0]) * (wsc[bj][0] * r), b = tof(acc[ai][bj][m][1]) * (wsc[bj][1] * r); f32x4 v0 = a, v1 = b;
                    if (ROT) {
                        v0[0] = a[0] * cs[0] - a[1] * sn[0]; v0[1] = a[0] * sn[0] + a[1] * cs[0]; v0[2] = a[2] * cs[1] - a[3] * sn[1]; v0[3] = a[2] * sn[1] + a[3] * cs[1];
                        v1[0] = b[0] * cs[2] - b[1] * sn[2]; v1[1] = b[0] * sn[2] + b[1] * cs[2]; v1[2] = b[2] * cs[3] - b[3] * sn[3]; v1[3] = b[2] * sn[3] + b[3] * cs[3];
                    }
                    u32x4 w; w.x = pk2bf(v0[0], v0[1]); w.y = pk2bf(v0[2], v0[3]); w.z = pk2bf(v1[0], v1[1]); w.w = pk2bf(v1[2], v1[3]);
                    __builtin_nontemporal_store(w, (u32x4*)(dptr + (size_t)(ai * HALF + m * 16) * dstride + bj * (HALF * 2)));
                }
            }
    }
    template <bool isK, class AccT> __device__ __forceinline__ void trans(const AccT (&acc)[2][2][4][2], const Unit& u, int wr, int wc, int fr, int fq, int ui) const {
        int lr0 = wr * 64 + fr, lane = fq * 16 + fr, cl0 = wc * 32 + 8 * fq; asm volatile("" : "+v"(lr0), "+v"(lane), "+v"(cl0));
        const int pn = u.pn; const bool isSV = (pn < 8); const float sc = isK ? 0.08838834764831845f : 1.0f;
        const int row0 = u.pm * BM + lr0, bb = row0 >> 11, s0 = row0 & (SEQ - 1), sw = (u.pm * BM + wr * 64) & (SEQ - 1);
        const PG8_LAS float* rb = rbuf + (ui & 1) * 256 + lr0;
        PG8_LAS unsigned char* tb = tbuf + (wr * 4 + wc) * 1152;
        PG8_LAS unsigned char* tw = tb + (2 * fq) * 144 + fr * 2;
        const PG8_LAS unsigned char* tr = tb + (lane >> 3) * 144 + (lane & 7) * 16;
        const int rr = lane >> 3;
        const PG8_LAS float* cb = rbuf + 512 + (ui & 1) * 256 + cl0;
#pragma unroll
        for (int ai = 0; ai < 2; ++ai)
#pragma unroll
            for (int bj = 0; bj < 2; ++bj) {
                const int hd = (pn & 1) * 2 + bj;
                bf16_t* M; int rowbase;
                M = (bf16_t*)((char*)SVT + (isSV ? (size_t)0 : (isK ? ((size_t)64 << 20) : ((size_t)32 << 20))));
                if (isSV) rowbase = (bb * 8 + (pn - 4) * 4 + bj * 2 + (wc >> 1)) * 64 + (wc & 1) * 32;
                else rowbase = (bb * 4 + hd) * 128 + wc * 32;
                float z[4] = {1.f, 1.f, 1.f, 1.f}, rs[4];
                const float lg = log2f(1.0f - exp2f(-5.0f - (float)hd));
#pragma unroll
                for (int m = 0; m < 4; ++m) { rs[m] = rb[ai * HALF + m * 16] * sc; if (isK) z[m] = exp2f((float)(127 - ((s0 + ai * HALF + m * 16) & 127)) * lg); }
#pragma unroll
                for (int n = 0; n < 2; ++n)
#pragma unroll
                    for (int ch = 0; ch < 2; ++ch) {
                        const f32x2 wv = *(const PG8_LAS f32x2*)(cb + bj * HALF + 4 * n + 2 * ch); const float w0 = wv[0], w1 = wv[1];
                        const float fj = isK ? exp2f(-(float)(2 * ((cl0 >> 1) + 2 * n + ch)) * (13.287712379549449f / 128.0f)) * 0.15915494309189535f : 0.f;
#pragma unroll
                        for (int m = 0; m < 4; ++m) {
                            const f32x4 av = tof(acc[ai][bj][m][n]);
                            float x0 = av[2 * ch] * w0 * rs[m], x1 = av[2 * ch + 1] * w1 * rs[m];
                            if (isK) { const float xr = __builtin_amdgcn_fractf((float)(s0 + ai * HALF + m * 16) * fj); const float cs = __builtin_amdgcn_cosf(xr), sn = __builtin_amdgcn_sinf(xr);
                                const float y0 = x0 * cs - x1 * sn, y1 = x0 * sn + x1 * cs; x0 = y0 * z[m]; x1 = y1 * z[m]; }
                            const unsigned w = pk2bf(x0, x1);
                            *(PG8_LAS unsigned short*)(tw + m * 32) = (unsigned short)w; *(PG8_LAS unsigned short*)(tw + 144 + m * 32) = (unsigned short)(w >> 16);
                        }
                        const u32x4 v = *(const PG8_LAS u32x4*)tr;
                        __builtin_nontemporal_store(v, (u32x4*)(M + (size_t)(rowbase + 8 * (rr >> 1) + 4 * n + 2 * ch + (rr & 1)) * SEQ + sw + ai * HALF + 8 * (lane & 7)));
                        asm volatile("" ::: "memory");
                    }
            }
    }
};
template <bool SRC_F32> struct EpiResid {
    static constexpr bool PERM = true, AFTER_DRAIN = false;
    const float* srcf; bf16_t* XB; float* SSQ;
    struct f32x8 { f32x4 a, b; };
    typedef typename std::conditional<SRC_F32, f32x8, u32x4>::type res_t;
    __device__ __forceinline__ res_t ld(size_t off) const { if constexpr (SRC_F32) { f32x8 r; r.a = *(const f32x4*)(srcf + off); r.b = *(const f32x4*)(srcf + off + 4); return r; } else return *(const u32x4*)(XB + off); }
    __device__ __forceinline__ void operator()(const f32x4 (&acc)[2][2][4][2], const Unit& u, int wr, int wc, int fr, int fq, int ui) const {
        const int row0 = u.pm * BM + wr * 64 + fr; const int col0 = u.pn * BM + wc * 32 + 8 * fq;
        constexpr int MB = SRC_F32 ? 2 : 4;
#pragma unroll
        for (int b0 = 0; b0 < 8; b0 += MB) {
            res_t rs[MB][2];
#pragma unroll
            for (int mm = 0; mm < MB; ++mm)
#pragma unroll
                for (int bj = 0; bj < 2; ++bj) rs[mm][bj] = ld((size_t)(row0 + ((b0 + mm) >> 2) * HALF + ((b0 + mm) & 3) * 16) * 1024 + col0 + bj * HALF);
#pragma unroll
            for (int mm = 0; mm < MB; ++mm) {
                const int ai = (b0 + mm) >> 2, m = (b0 + mm) & 3;
                const int row = row0 + ai * HALF + m * 16; float ss = 0.f;
#pragma unroll
                for (int bj = 0; bj < 2; ++bj) {
                    const size_t off = (size_t)row * 1024 + col0 + bj * HALF;
                    f32x4 o0, o1;
                    if constexpr (SRC_F32) { o0 = rs[mm][bj].a; o1 = rs[mm][bj].b; }
                    else { const u32x4 w = rs[mm][bj]; o0[0] = __uint_as_float(w.x << 16); o0[1] = __uint_as_float(w.x & 0xFFFF0000u); o0[2] = __uint_as_float(w.y << 16); o0[3] = __uint_as_float(w.y & 0xFFFF0000u);
                        o1[0] = __uint_as_float(w.z << 16); o1[1] = __uint_as_float(w.z & 0xFFFF0000u); o1[2] = __uint_as_float(w.w << 16); o1[3] = __uint_as_float(w.w & 0xFFFF0000u); }
                    o0 = o0 + acc[ai][bj][m][0]; o1 = o1 + acc[ai][bj][m][1];
                    u32x4 w; w.x = pk2bf(o0[0], o0[1]); w.y = pk2bf(o0[2], o0[3]); w.z = pk2bf(o1[0], o1[1]); w.w = pk2bf(o1[2], o1[3]); *(u32x4*)(XB + off) = w;
                    const float r0 = __uint_as_float(w.x << 16), r1 = __uint_as_float(w.x & 0xFFFF0000u), r2 = __uint_as_float(w.y << 16), r3 = __uint_as_float(w.y & 0xFFFF0000u);
                    const float r4 = __uint_as_float(w.z << 16), r5 = __uint_as_float(w.z & 0xFFFF0000u), r6 = __uint_as_float(w.w << 16), r7 = __uint_as_float(w.w & 0xFFFF0000u);
                    ss += ((r0 * r0 + r1 * r1) + (r2 * r2 + r3 * r3)) + ((r4 * r4 + r5 * r5) + (r6 * r6 + r7 * r7));
                }
                ss = xor16_sum(ss); ss = xor32_sum(ss);
                if (fq == 0) SSQ[(size_t)row * 16 + u.pn * 4 + wc] = ss;
            }
            asm volatile("" ::: "memory");
        }
    }
};
template <bool F16> struct EpiScale {
    static constexpr bool PERM = true, AFTER_DRAIN = false;
    bf16_t* O; int ldc; const PG8_LAS float* rbuf; float scale;
    __device__ __forceinline__ void operator()(const f32x4 (&acc)[2][2][4][2], const Unit& u, int wr, int wc, int fr, int fq, int ui) const {
        const int lr0 = wr * 64 + fr, row0 = u.pm * BM + lr0; const int col0 = u.pn * BM + wc * 32 + 8 * fq;
        const PG8_LAS float* rb = rbuf + (ui & 1) * 256 + lr0;
#pragma unroll
        for (int ai = 0; ai < 2; ++ai)
#pragma unroll
            for (int m = 0; m < 4; ++m) {
                const int row = row0 + ai * HALF + m * 16; const float r = rb[ai * HALF + m * 16] * scale;
#pragma unroll
                for (int bj = 0; bj < 2; ++bj) {
                    const f32x4 v0 = acc[ai][bj][m][0] * r, v1 = acc[ai][bj][m][1] * r; u32x4 w;
                    if (F16) { w.x = (unsigned)f2h(v0[0]) | ((unsigned)f2h(v0[1]) << 16); w.y = (unsigned)f2h(v0[2]) | ((unsigned)f2h(v0[3]) << 16); w.z = (unsigned)f2h(v1[0]) | ((unsigned)f2h(v1[1]) << 16); w.w = (unsigned)f2h(v1[2]) | ((unsigned)f2h(v1[3]) << 16); }
                    else { w.x = pk2bf(v0[0], v0[1]); w.y = pk2bf(v0[2], v0[3]); w.z = pk2bf(v1[0], v1[1]); w.w = pk2bf(v1[2], v1[3]); }
                    *(u32x4*)(O + (size_t)row * ldc + col0 + bj * HALF) = w;
                }
            }
    }
};
}
namespace pg8 {
struct EpiKV {
    static constexpr bool PERM = true, AFTER_DRAIN = false;
    bf16_t* KVl; bf16_t* VTl; const PG8_LAS float* rbuf;
    __device__ __forceinline__ void operator()(const f32x4 (&acc)[2][2][4][2], const Unit& u, int wr, int wc, int fr, int fq, int ui) const {
        int lr0 = wr * 64 + fr; int cl0 = wc * 32 + 8 * fq; asm volatile("" : "+v"(lr0), "+v"(cl0));
        const int row0 = u.pm * BM + lr0;
        const PG8_LAS float* rb = rbuf + (ui & 1) * 256 + lr0;
#pragma unroll
        for (int ai = 0; ai < 2; ++ai)
#pragma unroll
            for (int m = 0; m < 4; ++m) {
                const int lr = lr0 + ai * HALF + m * 16; const float r = rb[ai * HALF + m * 16];
#pragma unroll
                for (int bj = 0; bj < 2; ++bj) {
                    const f32x4 v0 = acc[ai][bj][m][0] * r, v1 = acc[ai][bj][m][1] * r;
                    if (u.pn < 4) { u32x4 w; w.x = pk2bf(v0[0], v0[1]); w.y = pk2bf(v0[2], v0[3]); w.z = pk2bf(v1[0], v1[1]); w.w = pk2bf(v1[2], v1[3]);
                        *(u32x4*)(KVl + (size_t)(row0 + ai * HALF + m * 16) * 2048 + u.pn * BM + cl0 + bj * HALF) = w; }
                    else { bf16_t* vt = VTl + ((size_t)(u.pm * 4 + (u.pn - 4)) * 256 + cl0 + bj * HALF) * 256 + lr;
                        vt[0 * 256] = f2bf(v0[0]); vt[1 * 256] = f2bf(v0[1]); vt[2 * 256] = f2bf(v0[2]); vt[3 * 256] = f2bf(v0[3]);
                        vt[4 * 256] = f2bf(v1[0]); vt[5 * 256] = f2bf(v1[1]); vt[6 * 256] = f2bf(v1[2]); vt[7 * 256] = f2bf(v1[3]); }
                }
            }
    }
};
struct EpiMin {
    static constexpr bool PERM = true, AFTER_DRAIN = false;
    bf16_t* O;
    __device__ __forceinline__ void operator()(const f32x4 (&acc)[2][2][4][2], const Unit& u, int wr, int wc, int fr, int fq, int ui) const {
        f32x4 t = acc[0][0][0][0];
#pragma unroll
        for (int ai = 0; ai < 2; ++ai)
#pragma unroll
            for (int bj = 0; bj < 2; ++bj)
#pragma unroll
                for (int m = 0; m < 4; ++m)
#pragma unroll
                    for (int n = 0; n < 2; ++n) t = t + acc[ai][bj][m][n];
        *(f32x4*)(O + ((size_t)(u.pm * BM + wr * 64 + fr) * 1024 + u.pn * BM + wc * 32 + 8 * fq)) = t;
    }
};
}
__device__ __forceinline__ int win_colmap(int n) { if (n < 1536 || n >= 2560) return n; const int hb = n & ~127, j = n & 127; return hb + (j >> 1) + 64 * (j & 1); }
__device__ __forceinline__ void tr_item(const float* __restrict__ W, int K, int N, const float* __restrict__ g, bool perm, bf16_t* __restrict__ WT, float* scr, int item, int lane) {
    const int nblk = N / 32, kb = item / nblk, nb = item % nblk, k0 = 64 * kb, n0 = 32 * nb;
    const int nn = n0 + (lane & 31); const int ns = perm ? win_colmap(nn) : nn;
#pragma unroll 8
    for (int i = 0; i < 32; ++i) { const int kk = 2 * i + (lane >> 5); const float gg = g ? g[k0 + kk] : 1.0f; scr[kk * 33 + (lane & 31)] = W[(size_t)(k0 + kk) * N + ns] * gg; }
    asm volatile("s_waitcnt lgkmcnt(0)" ::: "memory");
    const int c = lane & 7;
#pragma unroll
    for (int j = 0; j < 4; ++j) { const int n = (lane >> 3) + 8 * j; const float* s = scr + (8 * c) * 33 + n;
        uint4 o; o.x = pk2bf(s[0 * 33], s[1 * 33]); o.y = pk2bf(s[2 * 33], s[3 * 33]); o.z = pk2bf(s[4 * 33], s[5 * 33]); o.w = pk2bf(s[6 * 33], s[7 * 33]);
        *(uint4*)(WT + (size_t)(n0 + n) * K + k0 + 8 * c) = o; }
    asm volatile("s_waitcnt lgkmcnt(0)" ::: "memory");
}
__device__ __forceinline__ void wmax_item(const float* __restrict__ W, int K, int N, const float* __restrict__ g, float* WMAXl, int item, int lane) {
    const int nblk = N / 32, kb = item / nblk, nb = item % nblk, k0 = 64 * kb, n0 = 32 * nb;
    const int nn = n0 + (lane & 31); const int ns = win_colmap(nn);
    float mx = 0.f;
#pragma unroll 8
    for (int i = 0; i < 32; ++i) { const int kk = 2 * i + (lane >> 5); mx = fmaxf(mx, fabsf(W[(size_t)(k0 + kk) * N + ns] * g[k0 + kk])); }
    mx = xor32_max(mx);
    if (lane < 32) atomicMax((unsigned*)WMAXl + nn, __float_as_uint(mx));
}
__device__ __forceinline__ void tr_item_i8(const float* __restrict__ W, int K, int N, const float* __restrict__ g, unsigned char* __restrict__ WQ, const float* __restrict__ WMAXl, float* __restrict__ WS127l, float* scr, int item, int lane) {
    const int nblk = N / 32, kb = item / nblk, nb = item % nblk, k0 = 64 * kb, n0 = 32 * nb;
    const int nn = n0 + (lane & 31); const int ns = win_colmap(nn);
    const float wm = WMAXl[nn]; const float qs = wm > 0.f ? 127.0f / wm : 0.f;
    if (kb == 0 && lane < 32) WS127l[nn] = wm * (1.0f / 127.0f);
#pragma unroll 8
    for (int i = 0; i < 32; ++i) { const int kk = 2 * i + (lane >> 5); scr[kk * 33 + (lane & 31)] = W[(size_t)(k0 + kk) * N + ns] * g[k0 + kk] * qs; }
    asm volatile("s_waitcnt lgkmcnt(0)" ::: "memory");
    const int c = lane & 3;
#pragma unroll
    for (int j = 0; j < 2; ++j) { const int n = (lane >> 2) + 16 * j; const float* sp = scr + (16 * c) * 33 + n; unsigned w[4];
#pragma unroll
        for (int d = 0; d < 4; ++d) w[d] = ((unsigned)(int)rintf(sp[(4 * d) * 33]) & 0xFFu) | (((unsigned)(int)rintf(sp[(4 * d + 1) * 33]) & 0xFFu) << 8) | (((unsigned)(int)rintf(sp[(4 * d + 2) * 33]) & 0xFFu) << 16) | (((unsigned)(int)rintf(sp[(4 * d + 3) * 33]) & 0xFFu) << 24);
        uint4 o; o.x = w[0]; o.y = w[1]; o.z = w[2]; o.w = w[3];
        *(uint4*)(WQ + (size_t)(n0 + n) * K + k0 + 16 * c) = o; }
    asm volatile("s_waitcnt lgkmcnt(0)" ::: "memory");
}
__device__ __forceinline__ void row_to_i8_ssq(const float* __restrict__ xrow, unsigned char* __restrict__ qrow, float* __restrict__ xs, float* __restrict__ ssq, int lane) {
    float4 v[4]; float s = 0.f, mx = 0.f;
#pragma unroll
    for (int i = 0; i < 4; ++i) { v[i] = ((const float4*)xrow)[lane + 64 * i]; s += (v[i].x * v[i].x + v[i].y * v[i].y) + (v[i].z * v[i].z + v[i].w * v[i].w); mx = fmaxf(mx, fmaxf(fmaxf(fabsf(v[i].x), fabsf(v[i].y)), fmaxf(fabsf(v[i].z), fabsf(v[i].w)))); }
    s = wave_sum(s); mx = wave_max(mx);
    const float sc = mx > 0.f ? 127.0f / mx : 1.0f;
#pragma unroll
    for (int i = 0; i < 4; ++i) ((unsigned*)qrow)[lane + 64 * i] = ((unsigned)(int)rintf(v[i].x * sc) & 0xFFu) | (((unsigned)(int)rintf(v[i].y * sc) & 0xFFu) << 8) | (((unsigned)(int)rintf(v[i].z * sc) & 0xFFu) << 16) | (((unsigned)(int)rintf(v[i].w * sc) & 0xFFu) << 24);
    if (lane < 16) ssq[lane] = lane == 0 ? s : 0.f;
    if (lane == 0) xs[0] = mx > 0.f ? mx * (1.0f / 127.0f) : 1.0f;
}
__device__ __forceinline__ void rowbf_to_i8(const bf16_t* __restrict__ xrow, unsigned char* __restrict__ qrow, float* __restrict__ xs, int lane) {
    float4 v[4]; float mx = 0.f;
#pragma unroll
    for (int i = 0; i < 4; ++i) { const uint2 w = ((const uint2*)xrow)[lane + 64 * i]; v[i].x = __uint_as_float(w.x << 16); v[i].y = __uint_as_float(w.x & 0xFFFF0000u); v[i].z = __uint_as_float(w.y << 16); v[i].w = __uint_as_float(w.y & 0xFFFF0000u);
        mx = fmaxf(mx, fmaxf(fmaxf(fabsf(v[i].x), fabsf(v[i].y)), fmaxf(fabsf(v[i].z), fabsf(v[i].w)))); }
    mx = wave_max(mx);
    const float sc = mx > 0.f ? 127.0f / mx : 1.0f;
#pragma unroll
    for (int i = 0; i < 4; ++i) ((unsigned*)qrow)[lane + 64 * i] = ((unsigned)(int)rintf(v[i].x * sc) & 0xFFu) | (((unsigned)(int)rintf(v[i].y * sc) & 0xFFu) << 8) | (((unsigned)(int)rintf(v[i].z * sc) & 0xFFu) << 16) | (((unsigned)(int)rintf(v[i].w * sc) & 0xFFu) << 24);
    if (lane == 0) xs[0] = mx > 0.f ? mx * (1.0f / 127.0f) : 1.0f;
}
__device__ __forceinline__ void peer_fold_item(const float* __restrict__ wpq, const float* __restrict__ keys, const float* __restrict__ g, bf16_t* __restrict__ WPT, float* scr, int item, const int tid) {
    const int hp = item >> 4, k0 = (item & 15) * 64;
    float* ws_ = scr;
    float* ks_ = scr + 64 * 132;
    for (int i = tid; i < 64 * 32; i += 512) { const int kk = i >> 5, d4 = (i & 31) * 4; const float4 v = *(const float4*)(wpq + (size_t)(k0 + kk) * 2048 + hp * 128 + d4); const float gg = g[k0 + kk];
        float* o = ws_ + kk * 132 + d4; o[0] = v.x * gg; o[1] = v.y * gg; o[2] = v.z * gg; o[3] = v.w * gg; }
    for (int i = tid; i < 128 * 32; i += 512) { const int ky = i >> 5, d4 = (i & 31) * 4; const float4 v = *(const float4*)(keys + ((size_t)hp * 128 + ky) * 128 + d4);
        float* o = ks_ + ky * 132 + d4; o[0] = v.x; o[1] = v.y; o[2] = v.z; o[3] = v.w; }
    __syncthreads();
    const int key = tid & 127, kg = tid >> 7;
    float acc[16];
#pragma unroll
    for (int j = 0; j < 16; ++j) acc[j] = 0.f;
    for (int d = 0; d < 128; d += 4) {
        const float4 kv = *(const float4*)(ks_ + key * 132 + d);
#pragma unroll
        for (int j = 0; j < 16; ++j) { const float4 wv = *(const float4*)(ws_ + (kg * 16 + j) * 132 + d); acc[j] += kv.x * wv.x + kv.y * wv.y + kv.z * wv.z + kv.w * wv.w; }
    }
    uint4 o0, o1;
    o0.x = pk2bf(acc[0], acc[1]); o0.y = pk2bf(acc[2], acc[3]); o0.z = pk2bf(acc[4], acc[5]); o0.w = pk2bf(acc[6], acc[7]);
    o1.x = pk2bf(acc[8], acc[9]); o1.y = pk2bf(acc[10], acc[11]); o1.z = pk2bf(acc[12], acc[13]); o1.w = pk2bf(acc[14], acc[15]);
    uint4* dst = (uint4*)(WPT + (size_t)(hp * 128 + key) * 1024 + k0 + kg * 16);
    dst[0] = o0; dst[1] = o1;
    __syncthreads();
}
__device__ __forceinline__ void row_to_bf16_ssq(const float* __restrict__ xrow, bf16_t* __restrict__ orow, float* __restrict__ ssq, int lane) {
    const float4* xr = (const float4*)xrow; float s = 0.f;
#pragma unroll
    for (int i = 0; i < 4; ++i) { const float4 v = xr[lane + 64 * i]; s += (v.x * v.x + v.y * v.y) + (v.z * v.z + v.w * v.w);
        uint2 w; w.x = pk2bf(v.x, v.y); w.y = pk2bf(v.z, v.w); ((uint2*)orow)[lane + 64 * i] = w; }
    s = wave_sum(s);
    if (lane < 16) ssq[lane] = lane == 0 ? s : 0.f;
}
constexpr int NEXP = 16384;
__device__ __forceinline__ void table_row_from_regs(const float4 a0, const float4 a1, const float4 a2, const float4 a3, const float* __restrict__ g, unsigned char* __restrict__ T8, float* __restrict__ isc, int e, int lane) {
    const float4 av[4] = {a0, a1, a2, a3};
    float v[16]; float mx = 0.f;
#pragma unroll
    for (int i = 0; i < 4; ++i) { const float4 gg = g ? ((const float4*)g)[lane * 4 + i] : make_float4(1.f, 1.f, 1.f, 1.f);
        v[4 * i] = av[i].x * gg.x; v[4 * i + 1] = av[i].y * gg.y; v[4 * i + 2] = av[i].z * gg.z; v[4 * i + 3] = av[i].w * gg.w;
        mx = fmaxf(mx, fmaxf(fmaxf(fabsf(v[4 * i]), fabsf(v[4 * i + 1])), fmaxf(fabsf(v[4 * i + 2]), fabsf(v[4 * i + 3])))); }
    mx = wave_max(mx);
    const float sc = mx > 0.f ? 127.0f / mx : 1.0f;
    unsigned w[4];
#pragma unroll
    for (int i = 0; i < 4; ++i) w[i] = ((unsigned)(int)rintf(v[4 * i] * sc) & 0xFFu) | (((unsigned)(int)rintf(v[4 * i + 1] * sc) & 0xFFu) << 8) | (((unsigned)(int)rintf(v[4 * i + 2] * sc) & 0xFFu) << 16) | (((unsigned)(int)rintf(v[4 * i + 3] * sc) & 0xFFu) << 24);
    uint4 o; o.x = w[0]; o.y = w[1]; o.z = w[2]; o.w = w[3];
    nt_st16(T8 + ((size_t)(lane >> 3) * NEXP + e) * 128 + (lane & 7) * 16, o);
    if (lane == 0) isc[e] = mx > 0.f ? mx * (1.0f / 127.0f) : 1.0f;
}
__device__ __forceinline__ void table_rows_run(const float* __restrict__ peer_u, const float* __restrict__ peer_v, const float* __restrict__ peer_norm, unsigned char* __restrict__ T8, float* __restrict__ ISC, int l, int r0, int cnt, int lane) {
    if (cnt <= 0) return;
    float4 a0, a1, a2, a3, b0, b1, b2, b3, c0, c1, c2, c3, d0, d1, d2, d3;
#define TR_PTR(r_) (((((r_) >> 14) ? peer_v : peer_u)) + ((size_t)l * NEXP + ((r_) & (NEXP - 1))) * DM)
#define TR_LOAD(X_, r_) do { const float4* p_ = (const float4*)TR_PTR(r_) + lane * 4; X_##0 = p_[0]; X_##1 = p_[1]; X_##2 = p_[2]; X_##3 = p_[3]; } while (0)
#define TR_PROC(X_, r_) do { const int tab_ = (r_) >> 14, lt_ = l * 2 + tab_; table_row_from_regs(X_##0, X_##1, X_##2, X_##3, tab_ ? nullptr : peer_norm + l * DM, T8 + (size_t)lt_ * 8 * NEXP * 128, ISC + (size_t)lt_ * NEXP, (r_) & (NEXP - 1), lane); } while (0)
    TR_LOAD(a, r0); TR_LOAD(b, r0 + 1); TR_LOAD(c, r0 + 2); TR_LOAD(d, r0 + 3);
#pragma unroll 1
    for (int i = 0; i < cnt; i += 4) {
        const int r = r0 + i; const bool more = i + 4 < cnt;
        TR_PROC(a, r);     if (more) TR_LOAD(a, r + 4);
        TR_PROC(b, r + 1); if (more) TR_LOAD(b, r + 5);
        TR_PROC(c, r + 2); if (more) TR_LOAD(c, r + 6);
        TR_PROC(d, r + 3); if (more) TR_LOAD(d, r + 7);
    }
#undef TR_PTR
#undef TR_LOAD
#undef TR_PROC
}
__device__ __forceinline__ void d_rmsnorm_final(const int vb, const int vtid, const bf16_t* __restrict__ XB, float* __restrict__ out, const float* __restrict__ g) {
    const int row = vb * 4 + (vtid >> 6), lane = vtid & 63;
    const uint2* xr = (const uint2*)(XB + (size_t)row * DM);
    float4 v[4]; float s = 0.f;
#pragma unroll
    for (int i = 0; i < 4; ++i) { const uint2 w = xr[lane + 64 * i]; v[i].x = __uint_as_float(w.x << 16); v[i].y = __uint_as_float(w.x & 0xFFFF0000u); v[i].z = __uint_as_float(w.y << 16); v[i].w = __uint_as_float(w.y & 0xFFFF0000u);
        s += v[i].x * v[i].x + v[i].y * v[i].y + v[i].z * v[i].z + v[i].w * v[i].w; }
    s = wave_sum(s);
    const float r = rsqrtf(s * (1.0f / DM) + EPS);
#pragma unroll
    for (int i = 0; i < 4; ++i) { const float4 gg = ((const float4*)g)[lane + 64 * i];
        float4 y; y.x = v[i].x * r * gg.x; y.y = v[i].y * r * gg.y; y.z = v[i].z * r * gg.z; y.w = v[i].w * r * gg.w; ((float4*)(out + (size_t)row * DM))[lane + 64 * i] = y; }
}
typedef float f32x2 __attribute__((ext_vector_type(2)));
template <int CTRL> __device__ __forceinline__ float dpp_f(float v) { return __builtin_bit_cast(float, __builtin_amdgcn_update_dpp(0, __builtin_bit_cast(int, v), CTRL, 0xF, 0xF, false)); }
template <int CTRL> __device__ __forceinline__ unsigned dpp_u(unsigned v) { return (unsigned)__builtin_amdgcn_update_dpp(0, (int)v, CTRL, 0xF, 0xF, false); }
typedef unsigned u32x4nt __attribute__((ext_vector_type(4))); typedef int i32x4nt __attribute__((ext_vector_type(4)));
__device__ __forceinline__ uint4 nt_ld16(const void* p) { const u32x4nt v = __builtin_nontemporal_load((const u32x4nt*)p); uint4 r; r.x = v[0]; r.y = v[1]; r.z = v[2]; r.w = v[3]; return r; }
__device__ __forceinline__ int4 nt_ld16i(const void* p) { const i32x4nt v = __builtin_nontemporal_load((const i32x4nt*)p); int4 r; r.x = v[0]; r.y = v[1]; r.z = v[2]; r.w = v[3]; return r; }
__device__ __forceinline__ void table_row_to_i8(const float* __restrict__ row, const float* __restrict__ g, unsigned char* __restrict__ T8, float* __restrict__ isc, int e, int lane) {
    float v[16]; float mx = 0.f;
#pragma unroll
    for (int i = 0; i < 4; ++i) { const float4 a = ((const float4*)row)[lane * 4 + i]; const float4 gg = g ? ((const float4*)g)[lane * 4 + i] : make_float4(1.f, 1.f, 1.f, 1.f);
        v[4 * i] = a.x * gg.x; v[4 * i + 1] = a.y * gg.y; v[4 * i + 2] = a.z * gg.z; v[4 * i + 3] = a.w * gg.w;
        mx = fmaxf(mx, fmaxf(fmaxf(fabsf(v[4 * i]), fabsf(v[4 * i + 1])), fmaxf(fabsf(v[4 * i + 2]), fabsf(v[4 * i + 3])))); }
    mx = wave_max(mx);
    const float sc = mx > 0.f ? 127.0f / mx : 1.0f;
    unsigned w[4];
#pragma unroll
    for (int i = 0; i < 4; ++i) w[i] = ((unsigned)(int)rintf(v[4 * i] * sc) & 0xFFu) | (((unsigned)(int)rintf(v[4 * i + 1] * sc) & 0xFFu) << 8) | (((unsigned)(int)rintf(v[4 * i + 2] * sc) & 0xFFu) << 16) | (((unsigned)(int)rintf(v[4 * i + 3] * sc) & 0xFFu) << 24);
    uint4 o; o.x = w[0]; o.y = w[1]; o.z = w[2]; o.w = w[3];
    nt_st16(T8 + ((size_t)(lane >> 3) * NEXP + e) * 128 + (lane & 7) * 16, o);
    if (lane == 0) isc[e] = mx > 0.f ? mx * (1.0f / 127.0f) : 1.0f;
}
__device__ __forceinline__ void table_row_to_fp8(const float* __restrict__ row, const float* __restrict__ g, unsigned char* __restrict__ T8, float* __restrict__ isc, int e, int lane) {
    float v[16]; float mx = 0.f;
#pragma unroll
    for (int i = 0; i < 4; ++i) { const float4 a = ((const float4*)row)[lane * 4 + i]; float4 gg = make_float4(1.f, 1.f, 1.f, 1.f); if (g) gg = ((const float4*)g)[lane * 4 + i];
        v[4 * i] = a.x * gg.x; v[4 * i + 1] = a.y * gg.y; v[4 * i + 2] = a.z * gg.z; v[4 * i + 3] = a.w * gg.w;
        mx = fmaxf(mx, fmaxf(fmaxf(fabsf(v[4 * i]), fabsf(v[4 * i + 1])), fmaxf(fabsf(v[4 * i + 2]), fabsf(v[4 * i + 3])))); }
    mx = wave_max(mx);
    const float sc = mx > 0.f ? 224.0f / mx : 1.0f;
    uint4 o; unsigned w[4];
#pragma unroll
    for (int i = 0; i < 4; ++i) { int p = __builtin_amdgcn_cvt_pk_fp8_f32(v[4 * i] * sc, v[4 * i + 1] * sc, 0, false); p = __builtin_amdgcn_cvt_pk_fp8_f32(v[4 * i + 2] * sc, v[4 * i + 3] * sc, p, true); w[i] = (unsigned)p; }
    o.x = w[0]; o.y = w[1]; o.z = w[2]; o.w = w[3];
    nt_st16(T8 + ((size_t)(lane >> 3) * NEXP + e) * 128 + (lane & 7) * 16, o);
    if (lane == 0) isc[e] = mx > 0.f ? mx * (1.0f / 224.0f) : 1.0f;
}

#define PK_CE(a, b) { const unsigned t_ = (a) > (b) ? (a) : (b); b = (a) > (b) ? (b) : (a); a = t_; }
__device__ __forceinline__ void sort16_desc(unsigned (&v)[16]) {
    PK_CE(v[0], v[13]) PK_CE(v[1], v[12]) PK_CE(v[2], v[15]) PK_CE(v[3], v[14]) PK_CE(v[4], v[8]) PK_CE(v[5], v[6]) PK_CE(v[7], v[11]) PK_CE(v[9], v[10])
    PK_CE(v[0], v[5]) PK_CE(v[1], v[7]) PK_CE(v[2], v[9]) PK_CE(v[3], v[4]) PK_CE(v[6], v[13]) PK_CE(v[8], v[14]) PK_CE(v[10], v[15]) PK_CE(v[11], v[12])
    PK_CE(v[0], v[1]) PK_CE(v[2], v[3]) PK_CE(v[4], v[5]) PK_CE(v[6], v[8]) PK_CE(v[7], v[9]) PK_CE(v[10], v[11]) PK_CE(v[12], v[13]) PK_CE(v[14], v[15])
    PK_CE(v[0], v[2]) PK_CE(v[1], v[3]) PK_CE(v[4], v[10]) PK_CE(v[5], v[11]) PK_CE(v[6], v[7]) PK_CE(v[8], v[9]) PK_CE(v[12], v[14]) PK_CE(v[13], v[15])
    PK_CE(v[1], v[2]) PK_CE(v[3], v[12]) PK_CE(v[4], v[6]) PK_CE(v[5], v[7]) PK_CE(v[8], v[10]) PK_CE(v[9], v[11]) PK_CE(v[13], v[14])
    PK_CE(v[1], v[4]) PK_CE(v[2], v[6]) PK_CE(v[5], v[8]) PK_CE(v[7], v[10]) PK_CE(v[9], v[13]) PK_CE(v[11], v[14])
    PK_CE(v[2], v[4]) PK_CE(v[3], v[6]) PK_CE(v[9], v[12]) PK_CE(v[11], v[13])
    PK_CE(v[3], v[5]) PK_CE(v[6], v[8]) PK_CE(v[7], v[9]) PK_CE(v[10], v[12])
    PK_CE(v[3], v[4]) PK_CE(v[5], v[6]) PK_CE(v[7], v[8]) PK_CE(v[9], v[10]) PK_CE(v[11], v[12])
    PK_CE(v[6], v[7]) PK_CE(v[8], v[9])
}
__device__ __forceinline__ void merge16_desc(unsigned (&R)[16], const unsigned (&N)[16]) {
#pragma unroll
    for (int i = 0; i < 16; ++i) R[i] = R[i] > N[15 - i] ? R[i] : N[15 - i];
#pragma unroll
    for (int j = 8; j > 0; j >>= 1)
#pragma unroll
        for (int i = 0; i < 16; ++i) { const int l = i ^ j; if (l > i) PK_CE(R[i], R[l]) }
}
__device__ __forceinline__ void peer_topk_fast(const bf16_t* __restrict__ SC, int* __restrict__ IDX, float* __restrict__ GATE, int t, int hp) {
    const uint4* src = (const uint4*)(SC + (size_t)t * 2048 + hp * 128);
    unsigned R[16];
#pragma unroll
    for (int g = 0; g < 8; ++g) {
        const uint4 a = src[2 * g], b = src[2 * g + 1]; const unsigned dw[8] = {a.x, a.y, a.z, a.w, b.x, b.y, b.z, b.w};
        unsigned N[16];
#pragma unroll
        for (int k = 0; k < 8; ++k) { const unsigned w = dw[k]; const unsigned m = ((w >> 15) & 0x00010001u) * 0x7FFFu; const unsigned u = w ^ (m | 0x80008000u);
            N[2 * k] = (u << 16) | (unsigned)(127 - (g * 16 + 2 * k)); N[2 * k + 1] = (u & 0xFFFF0000u) | (unsigned)(127 - (g * 16 + 2 * k + 1)); }
        sort16_desc(N);
        if (g == 0) {
#pragma unroll
            for (int i = 0; i < 16; ++i) R[i] = N[i];
        } else merge16_desc(R, N);
    }
    const int p = hp & 1;
    unsigned F[16];
#pragma unroll
    for (int r = 0; r < 16; ++r) {
        const unsigned u = R[r] >> 16; const unsigned hb = (u & 0x8000u) ? (u & 0x7FFFu) : (~u & 0xFFFFu);
        const float s = h2f((unsigned short)hb); const int id = 127 - (int)(R[r] & 127u);
        int f = (int)rintf(s * 4096.0f); f = f < -65535 ? -65535 : (f > 65535 ? 65535 : f);
        F[r] = p ? (unsigned)(f * 16384 + id) : (((unsigned)(f + 131072) << 14) + ((unsigned)id << 7));
    }
    unsigned F0[16], F1[16];
#pragma unroll
    for (int r = 0; r < 16; ++r) { const unsigned o = dpp_u<0xB1>(F[r]); F0[r] = p ? o : F[r]; F1[r] = p ? F[r] : o; }
    unsigned A[16], B[16];
#pragma unroll
    for (int j = 0; j < 16; ++j) A[j] = F0[0] + F1[j];
#pragma unroll
    for (int j = 0; j < 8; ++j) B[j] = F0[1] + F1[j];
#pragma unroll
    for (int j = 0; j < 5; ++j) B[8 + j] = F0[2] + F1[j];
#pragma unroll
    for (int j = 0; j < 3; ++j) B[13 + j] = F0[4] + F1[j];
    sort16_desc(B); merge16_desc(A, B);
#pragma unroll
    for (int j = 0; j < 4; ++j) B[j] = F0[3] + F1[j];
#pragma unroll
    for (int i = 0; i < 3; ++i) { B[4 + 2 * i] = F0[5 + i] + F1[0]; B[5 + 2 * i] = F0[5 + i] + F1[1]; }
#pragma unroll
    for (int i = 0; i < 6; ++i) B[10 + i] = F0[8 + i] + F1[0];
    sort16_desc(B); merge16_desc(A, B);
#pragma unroll
    for (int i = 14; i < 16; ++i) { unsigned xk = F0[i] + F1[0];
#pragma unroll
        for (int k = 0; k < 16; ++k) PK_CE(A[k], xk) }
    float ex[16]; float sum = 0.f; const float s0 = (float)((int)(A[0] >> 14) - 131072);
#pragma unroll
    for (int r = 0; r < 16; ++r) { const float s = (float)((int)(A[r] >> 14) - 131072); ex[r] = __expf((s - s0) * (1.0f / 4096.0f)); sum += ex[r]; }
    const float inv = 1.0f / sum;
    int4 i0, i1; float4 g0, g1;
    i0.x = (int)((p ? A[8] : A[0]) & 0x3FFFu); i0.y = (int)((p ? A[9] : A[1]) & 0x3FFFu); i0.z = (int)((p ? A[10] : A[2]) & 0x3FFFu); i0.w = (int)((p ? A[11] : A[3]) & 0x3FFFu);
    i1.x = (int)((p ? A[12] : A[4]) & 0x3FFFu); i1.y = (int)((p ? A[13] : A[5]) & 0x3FFFu); i1.z = (int)((p ? A[14] : A[6]) & 0x3FFFu); i1.w = (int)((p ? A[15] : A[7]) & 0x3FFFu);
    g0.x = (p ? ex[8] : ex[0]) * inv; g0.y = (p ? ex[9] : ex[1]) * inv; g0.z = (p ? ex[10] : ex[2]) * inv; g0.w = (p ? ex[11] : ex[3]) * inv;
    g1.x = (p ? ex[12] : ex[4]) * inv; g1.y = (p ? ex[13] : ex[5]) * inv; g1.z = (p ? ex[14] : ex[6]) * inv; g1.w = (p ? ex[15] : ex[7]) * inv;
    const size_t o = (size_t)t * 128 + (hp >> 1) * 16 + p * 8;
    *(int4*)(IDX + o) = i0; *(int4*)(IDX + o + 4) = i1; *(float4*)(GATE + o) = g0; *(float4*)(GATE + o + 4) = g1;
}

struct PeerStep { int t, s; bool ok; };
__device__ __forceinline__ PeerStep peer_step(int k, int bid, int G, int wave) { PeerStep r; const int i = bid + (k >> 3) * G; r.ok = i < 8 * (T / 64);
#ifdef XTEST
    r.s = (i >> 3) & 7; r.t = ((((i >> 6) << 3) | (i & 7))) * 64 + wave * 8 + (k & 7);
#else
    r.s = i & 7; r.t = (i >> 3) * 64 + wave * 8 + (k & 7);
#endif
    return r; }
#define PEER_LD_IDX(ID, ST) do { const int* ip_ = IDX + (size_t)(ST).t * 128 + g * 16; const int4 a_ = *(const int4*)ip_, b_ = *(const int4*)(ip_ + 4), c_ = *(const int4*)(ip_ + 8), d_ = *(const int4*)(ip_ + 12); \
    ID[0] = a_.x; ID[1] = a_.y; ID[2] = a_.z; ID[3] = a_.w; ID[4] = b_.x; ID[5] = b_.y; ID[6] = b_.z; ID[7] = b_.w; ID[8] = c_.x; ID[9] = c_.y; ID[10] = c_.z; ID[11] = c_.w; ID[12] = d_.x; ID[13] = d_.y; ID[14] = d_.z; ID[15] = d_.w; } while (0)
#define PEER_LD_TAB(D, ID, TAB, ST) do { const unsigned char* tb_ = (TAB) + (size_t)(ST).s * NEXP * 128 + j * 16; _Pragma("unroll") for (int q_ = 0; q_ < 16; ++q_) D[q_] = *(const uint4*)(tb_ + (size_t)((ID[q_]) & 0x3FFF) * 128); } while (0)
__device__ __forceinline__ unsigned perm_b(unsigned hi, unsigned lo, unsigned sel) { return __builtin_amdgcn_perm(hi, lo, sel); }
__device__ __forceinline__ void peer_u_compute(const uint4 (&d)[16], const uint4& xa, const uint4& xb, bf16_t* __restrict__ Arow, int g, int j) {
    const unsigned xw[8] = {xa.x, xa.y, xa.z, xa.w, xb.x, xb.y, xb.z, xb.w};
    f32x2 xf[8]; float mx = 0.f;
#pragma unroll
    for (int k = 0; k < 8; ++k) { xf[k][0] = __uint_as_float(xw[k] << 16); xf[k][1] = __uint_as_float(xw[k] & 0xFFFF0000u); mx = fmaxf(mx, fmaxf(fabsf(xf[k][0]), fabsf(xf[k][1]))); }
    mx = fmaxf(mx, dpp_f<0xB1>(mx)); mx = fmaxf(mx, dpp_f<0x4E>(mx)); mx = fmaxf(mx, dpp_f<0x141>(mx));
    const float sx = mx > 0.f ? 127.0f / mx : 1.0f, inv = mx > 0.f ? mx * (1.0f / 127.0f) : 1.0f;
    const f32x2 sx2 = {sx, sx}, magic = {12582912.0f, 12582912.0f};
    unsigned yb[16];
#pragma unroll
    for (int k = 0; k < 8; ++k) { const f32x2 y = __builtin_elementwise_fma(xf[k], sx2, magic); yb[2 * k] = __float_as_uint(y[0]); yb[2 * k + 1] = __float_as_uint(y[1]); }
    int xq[4];
#pragma unroll
    for (int k = 0; k < 4; ++k) xq[k] = (int)perm_b(perm_b(yb[4 * k + 3], yb[4 * k + 2], 0x0c0c0400u), perm_b(yb[4 * k + 1], yb[4 * k], 0x0c0c0400u), 0x05040100u);
    unsigned sacc[16];
#pragma unroll
    for (int q = 0; q < 16; ++q) {
        int acc = __builtin_amdgcn_sdot4((int)d[q].x, xq[0], 0, false); acc = __builtin_amdgcn_sdot4((int)d[q].y, xq[1], acc, false); acc = __builtin_amdgcn_sdot4((int)d[q].z, xq[2], acc, false); acc = __builtin_amdgcn_sdot4((int)d[q].w, xq[3], acc, false);
        sacc[q] = (unsigned)acc;
    }
    const bool b2 = (j & 4) != 0, b0 = (j & 1) != 0, b1 = (j & 2) != 0;
    unsigned s8[8], s4[4], s2[2];
#pragma unroll
    for (int i = 0; i < 8; ++i) { const int q = (i & 3) + 8 * (i >> 2); s8[i] = (b2 ? sacc[q + 4] : sacc[q]) + dpp_u<0x141>(b2 ? sacc[q] : sacc[q + 4]); }
#pragma unroll
    for (int i = 0; i < 4; ++i) { const int p = 2 * (i & 1) + 4 * (i >> 1); s4[i] = (b0 ? s8[p + 1] : s8[p]) + dpp_u<0xB1>(b0 ? s8[p] : s8[p + 1]); }
#pragma unroll
    for (int i = 0; i < 2; ++i) { const int p = 2 * i; s2[i] = (b1 ? s4[p + 1] : s4[p]) + dpp_u<0x4E>(b1 ? s4[p] : s4[p + 1]); }
    Arow[g * 16 + j] = f2bf((float)(int)s2[0] * inv); Arow[g * 16 + 8 + j] = f2bf((float)(int)s2[1] * inv);
}
__device__ __forceinline__ void peer_u_phase(const bf16_t* __restrict__ XB, const int* __restrict__ IDX, const unsigned char* __restrict__ U8, bf16_t* __restrict__ APART, int bid, int G, int wave, int lane) {
    const int g = lane >> 3, j = lane & 7;
    const int nk = ((8 * (T / 64) - bid + G - 1) / G) * 8;
    if (nk <= 0) return;
    int idA[16], idB[16]; uint4 dA[16], dB[16]; uint4 xA0, xA1, xB0, xB1;
    PeerStep sA = peer_step(0, bid, G, wave), sB = peer_step(1, bid, G, wave);
    PEER_LD_IDX(idA, sA); { const bf16_t* xs = XB + (size_t)sA.t * DM + sA.s * 128 + 16 * j; xA0 = *(const uint4*)xs; xA1 = *(const uint4*)(xs + 8); }
    PEER_LD_TAB(dA, idA, U8, sA);
    PEER_LD_IDX(idB, sB); { const bf16_t* xs = XB + (size_t)sB.t * DM + sB.s * 128 + 16 * j; xB0 = *(const uint4*)xs; xB1 = *(const uint4*)(xs + 8); }
#pragma unroll 1
    for (int k = 0; k < nk; k += 2) {
        PEER_LD_TAB(dB, idB, U8, sB);
        const PeerStep nA = peer_step(k + 2 < nk ? k + 2 : k, bid, G, wave), nB = peer_step(k + 3 < nk ? k + 3 : k + 1, bid, G, wave);
        PEER_LD_IDX(idA, nA);
        peer_u_compute(dA, xA0, xA1, APART + ((size_t)sA.s * T + sA.t) * 128, g, j);
        { const bf16_t* xs = XB + (size_t)nA.t * DM + nA.s * 128 + 16 * j; xA0 = *(const uint4*)xs; xA1 = *(const uint4*)(xs + 8); }
        PEER_LD_TAB(dA, idA, U8, nA);
        PEER_LD_IDX(idB, nB);
        peer_u_compute(dB, xB0, xB1, APART + ((size_t)sB.s * T + sB.t) * 128, g, j);
        { const bf16_t* xs = XB + (size_t)nB.t * DM + nB.s * 128 + 16 * j; xB0 = *(const uint4*)xs; xB1 = *(const uint4*)(xs + 8); }
        sA = nA; sB = nB;
    }
}
__device__ __forceinline__ void peer_combine4(const bf16_t* __restrict__ A, int* IDX, const float* __restrict__ GATE, const float* __restrict__ SSQ, const float* __restrict__ iscu, const float* __restrict__ iscv, float* __restrict__ WSC, int i4) {
    const int i = i4 * 4, t = i >> 7, p = i & 127;
    const float4* sp = (const float4*)(SSQ + (size_t)t * 16); const float4 s0 = sp[0], s1 = sp[1], s2 = sp[2], s3 = sp[3];
    const float q = ((s0.x + s0.y) + (s0.z + s0.w)) + ((s1.x + s1.y) + (s1.z + s1.w)) + ((s2.x + s2.y) + (s2.z + s2.w)) + ((s3.x + s3.y) + (s3.z + s3.w));
    const float rstd = rsqrtf(q * (1.0f / DM) + EPS);
    float4 a = make_float4(0.f, 0.f, 0.f, 0.f);
#pragma unroll
    for (int s = 0; s < 8; ++s) { const uint2 v = *(const uint2*)(A + ((size_t)s * T + t) * 128 + p); a.x += __uint_as_float(v.x << 16); a.y += __uint_as_float(v.x & 0xFFFF0000u); a.z += __uint_as_float(v.y << 16); a.w += __uint_as_float(v.y & 0xFFFF0000u); }
    const int4 ev = *(const int4*)(IDX + i); const float4 gv = *(const float4*)(GATE + i);
    const int e[4] = {ev.x & 0x3FFF, ev.y & 0x3FFF, ev.z & 0x3FFF, ev.w & 0x3FFF}; const float av[4] = {a.x, a.y, a.z, a.w}; const float gg[4] = {gv.x, gv.y, gv.z, gv.w};
    float w[4]; float mx = 0.f;
#pragma unroll
    for (int k = 0; k < 4; ++k) { const float x = av[k] * rstd * iscu[e[k]]; w[k] = gg[k] * 0.5f * x * (1.f + erff(x * 0.7071067811865476f)) * iscv[e[k]]; mx = fmaxf(mx, fabsf(w[k])); }
    mx = fmaxf(mx, dpp_f<0xB1>(mx)); mx = fmaxf(mx, dpp_f<0x4E>(mx)); mx = fmaxf(mx, dpp_f<0x141>(mx)); mx = fmaxf(mx, dpp_f<0x140>(mx)); mx = xor16_max(mx);
    const float sw = mx > 0.f ? 127.0f / mx : 1.0f;
    int o[4];
#pragma unroll
    for (int k = 0; k < 4; ++k) o[k] = (int)((((unsigned)(int)rintf(w[k] * sw) & 0xFFu) << 16) | (unsigned)e[k]);
    int4 ov; ov.x = o[0]; ov.y = o[1]; ov.z = o[2]; ov.w = o[3];
    *(int4*)(IDX + i) = ov;
    if (p == 0) WSC[t] = mx > 0.f ? mx * (1.0f / 127.0f) : 1.0f;
}
__device__ __forceinline__ void peer_v_compute(const uint4 (&d)[16], const int (&pw)[16], const float wsc, bf16_t* xb, float* ssq2, int g, int j, const bool do_store) {
    int acc[16];
#pragma unroll
    for (int c = 0; c < 16; ++c) acc[c] = 0;
#pragma unroll
    for (int m = 0; m < 4; ++m) {
        const unsigned wlo = perm_b((unsigned)pw[4 * m + 1], (unsigned)pw[4 * m], 0x0c0c0602u), whi = perm_b((unsigned)pw[4 * m + 3], (unsigned)pw[4 * m + 2], 0x0c0c0602u);
        const int wb = (int)perm_b(whi, wlo, 0x05040100u);
        const unsigned r0[4] = {d[4 * m].x, d[4 * m].y, d[4 * m].z, d[4 * m].w}, r1[4] = {d[4 * m + 1].x, d[4 * m + 1].y, d[4 * m + 1].z, d[4 * m + 1].w};
        const unsigned r2[4] = {d[4 * m + 2].x, d[4 * m + 2].y, d[4 * m + 2].z, d[4 * m + 2].w}, r3[4] = {d[4 * m + 3].x, d[4 * m + 3].y, d[4 * m + 3].z, d[4 * m + 3].w};
#pragma unroll
        for (int k = 0; k < 4; ++k) {
            const unsigned t0 = perm_b(r1[k], r0[k], 0x05010400u), t1 = perm_b(r1[k], r0[k], 0x07030602u), t2 = perm_b(r3[k], r2[k], 0x05010400u), t3 = perm_b(r3[k], r2[k], 0x07030602u);
            const unsigned c0 = perm_b(t2, t0, 0x05040100u), c1 = perm_b(t2, t0, 0x07060302u), c2 = perm_b(t3, t1, 0x05040100u), c3 = perm_b(t3, t1, 0x07060302u);
            acc[4 * k] = __builtin_amdgcn_sdot4((int)c0, wb, acc[4 * k], false); acc[4 * k + 1] = __builtin_amdgcn_sdot4((int)c1, wb, acc[4 * k + 1], false);
            acc[4 * k + 2] = __builtin_amdgcn_sdot4((int)c2, wb, acc[4 * k + 2], false); acc[4 * k + 3] = __builtin_amdgcn_sdot4((int)c3, wb, acc[4 * k + 3], false);
        }
    }
    int r8[8], r4[4];
#pragma unroll
    for (int i = 0; i < 8; ++i) { auto rr = __builtin_amdgcn_permlane32_swap((unsigned)acc[i], (unsigned)acc[i + 8], false, false); r8[i] = (int)(rr[0] + rr[1]); }
#pragma unroll
    for (int i = 0; i < 4; ++i) { auto rr = __builtin_amdgcn_permlane16_swap((unsigned)r8[i], (unsigned)r8[i + 4], false, false); r4[i] = (int)(rr[0] + rr[1]); }
    const bool e = (g & 1) != 0;
    const int t0 = (e ? r4[2] : r4[0]) + (int)dpp_u<0x128>((unsigned)(e ? r4[0] : r4[2])), t1 = (e ? r4[3] : r4[1]) + (int)dpp_u<0x128>((unsigned)(e ? r4[1] : r4[3]));
    if (do_store) {
        unsigned* xp = (unsigned*)(xb + 16 * j + 2 * g);
        const unsigned xw = *xp;
        const float lo = __uint_as_float(xw << 16) + (float)t0 * wsc, hi = __uint_as_float(xw & 0xFFFF0000u) + (float)t1 * wsc;
        const unsigned ow = pk2bf(lo, hi);
        *xp = ow;
        const float rl = __uint_as_float(ow << 16), rh = __uint_as_float(ow & 0xFFFF0000u);
        const float ss = wave_sum(rl * rl + rh * rh);
        if (g == 0 && j == 0) { ssq2[0] = ss; ssq2[1] = 0.f; }
    }
}
__device__ __forceinline__ void peer_v_phase(const int* __restrict__ IDX, const float* __restrict__ WSC, const unsigned char* __restrict__ V8, bf16_t* XB, float* SSQ, int bid, int G, int wave, int lane, const bool do_store = true) {
    const int g = lane >> 3, j = lane & 7;
    const int nk = ((8 * (T / 64) - bid + G - 1) / G) * 8;
    if (nk <= 0) return;
    int idA[16], idB[16]; uint4 dA[16], dB[16];
    PeerStep sA = peer_step(0, bid, G, wave), sB = peer_step(1, bid, G, wave);
    PEER_LD_IDX(idA, sA); PEER_LD_TAB(dA, idA, V8, sA); PEER_LD_IDX(idB, sB);
#pragma unroll 1
    for (int k = 0; k < nk; k += 2) {
        PEER_LD_TAB(dB, idB, V8, sB);
        const PeerStep nA = peer_step(k + 2 < nk ? k + 2 : k, bid, G, wave), nB = peer_step(k + 3 < nk ? k + 3 : k + 1, bid, G, wave);
        peer_v_compute(dA, idA, WSC[sA.t], XB + (size_t)sA.t * DM + sA.s * 128, SSQ + (size_t)sA.t * 16 + 2 * sA.s, g, j, do_store);
        PEER_LD_IDX(idA, nA); PEER_LD_TAB(dA, idA, V8, nA);
        peer_v_compute(dB, idB, WSC[sB.t], XB + (size_t)sB.t * DM + sB.s * 128, SSQ + (size_t)sB.t * 16 + 2 * sB.s, g, j, do_store);
        PEER_LD_IDX(idB, nB);
        sA = nA; sB = nB;
    }
}
typedef short bf16x8_t __attribute__((ext_vector_type(8)));
typedef float f32x16_t __attribute__((ext_vector_type(16)));
__device__ __forceinline__ bf16x8_t mk_bf16x8(uint2 a, uint2 b) { uint4 v; v.x = a.x; v.y = a.y; v.z = b.x; v.w = b.y; return __builtin_bit_cast(bf16x8_t, v); }
__device__ __forceinline__ void xattn_unit(char* lds, const bf16_t* __restrict__ Q, const bf16_t* __restrict__ Kb, const bf16_t* __restrict__ VTb, bf16_t* __restrict__ O, int t0, int h, int tid_in, const bool do_store = true) {
    int tid = tid_in; asm volatile("" : "+v"(tid));
    const int lane = tid & 63, wave = __builtin_amdgcn_readfirstlane(tid >> 6), r = lane & 31, hh = lane >> 5, tq = wave & 3, dh = wave >> 2;
    char* Il = lds;
    uint4 kr0, kr1, kr2, kr3, kr4, kr5, kr6, kr7, kr8, kr9, kr10, kr11, kr12, kr13, kr14, kr15;
#define XA_LDK(i_) do { const int c = tid + 512 * (i_); kr##i_ = *(const uint4*)(Kb + (size_t)(c >> 5) * 2048 + (c & 31) * 8); } while (0)
    XA_LDK(0); XA_LDK(1); XA_LDK(2); XA_LDK(3); XA_LDK(4); XA_LDK(5); XA_LDK(6); XA_LDK(7); XA_LDK(8); XA_LDK(9); XA_LDK(10); XA_LDK(11); XA_LDK(12); XA_LDK(13); XA_LDK(14); XA_LDK(15);
#undef XA_LDK
#pragma unroll
    for (int i = 0; i < 8; ++i) { const int c = tid + 512 * i; *(uint4*)(Il + (c >> 5) * 528 + (c & 31) * 16) = *(const uint4*)(Q + (size_t)(t0 + (c >> 5)) * DM + h * 256 + (c & 31) * 8); }
    __syncthreads();
    bf16x8_t qf[16];
#pragma unroll
    for (int ks = 0; ks < 16; ++ks) qf[ks] = *(const bf16x8_t*)(Il + (tq * 32 + r) * 528 + (16 * ks + 8 * hh) * 2);
    __syncthreads();
#define XA_STK(i_) do { const int c = tid + 512 * (i_); *(uint4*)(Il + (c >> 5) * 528 + (c & 31) * 16) = kr##i_; } while (0)
    XA_STK(0); XA_STK(1); XA_STK(2); XA_STK(3); XA_STK(4); XA_STK(5); XA_STK(6); XA_STK(7); XA_STK(8); XA_STK(9); XA_STK(10); XA_STK(11); XA_STK(12); XA_STK(13); XA_STK(14); XA_STK(15);
#undef XA_STK
    __syncthreads();
    f32x16_t sc0, sc1, sc2, sc3, sc4, sc5, sc6, sc7;
#define XA_S(S_, mb_) do { _Pragma("unroll") for (int i = 0; i < 16; ++i) S_[i] = 0.f; \
        _Pragma("unroll") for (int ks = 0; ks < 16; ++ks) { const bf16x8_t kf = *(const bf16x8_t*)(Il + ((mb_) * 32 + r) * 528 + (16 * ks + 8 * hh) * 2); S_ = __builtin_amdgcn_mfma_f32_32x32x16_bf16(kf, qf[ks], S_, 0, 0, 0); } } while (0)
    XA_S(sc0, 0); XA_S(sc1, 1); XA_S(sc2, 2); XA_S(sc3, 3); XA_S(sc4, 4); XA_S(sc5, 5); XA_S(sc6, 6); XA_S(sc7, 7);
#undef XA_S
    float mx = sc0[0];
#define XA_MAX(S_) do { _Pragma("unroll") for (int i = 0; i < 16; ++i) mx = fmaxf(mx, S_[i]); } while (0)
    XA_MAX(sc0); XA_MAX(sc1); XA_MAX(sc2); XA_MAX(sc3); XA_MAX(sc4); XA_MAX(sc5); XA_MAX(sc6); XA_MAX(sc7);
#undef XA_MAX
    mx = xor32_max(mx);
    float ps = 0.f;
    bf16x8_t pf00, pf01, pf10, pf11, pf20, pf21, pf30, pf31, pf40, pf41, pf50, pf51, pf60, pf61, pf70, pf71;
#define XA_P(S_, P0_, P1_) do { _Pragma("unroll") for (int i = 0; i < 16; ++i) { S_[i] = __builtin_amdgcn_exp2f(S_[i] - mx); ps += S_[i]; } \
        { uint4 w; w.x = pk2bf(S_[0], S_[1]); w.y = pk2bf(S_[2], S_[3]); w.z = pk2bf(S_[4], S_[5]); w.w = pk2bf(S_[6], S_[7]); P0_ = __builtin_bit_cast(bf16x8_t, w); } \
        { uint4 w; w.x = pk2bf(S_[8], S_[9]); w.y = pk2bf(S_[10], S_[11]); w.z = pk2bf(S_[12], S_[13]); w.w = pk2bf(S_[14], S_[15]); P1_ = __builtin_bit_cast(bf16x8_t, w); } } while (0)
    XA_P(sc0, pf00, pf01); XA_P(sc1, pf10, pf11); XA_P(sc2, pf20, pf21); XA_P(sc3, pf30, pf31); XA_P(sc4, pf40, pf41); XA_P(sc5, pf50, pf51); XA_P(sc6, pf60, pf61); XA_P(sc7, pf70, pf71);
#undef XA_P
    ps = xor32_sum(ps);
    const float inv = 1.0f / ps;
    uint4 vr0, vr1, vr2, vr3, vr4, vr5, vr6, vr7, vr8, vr9, vr10, vr11, vr12, vr13, vr14, vr15;
    int tv = tid; asm volatile("" : "+v"(tv));
#define XA_LDV(i_) do { const int c = tv + 512 * (i_); vr##i_ = *(const uint4*)(VTb + (size_t)(c >> 5) * 256 + (c & 31) * 8); } while (0)
    XA_LDV(0); XA_LDV(1); XA_LDV(2); XA_LDV(3); XA_LDV(4); XA_LDV(5); XA_LDV(6); XA_LDV(7); XA_LDV(8); XA_LDV(9); XA_LDV(10); XA_LDV(11); XA_LDV(12); XA_LDV(13); XA_LDV(14); XA_LDV(15);
#undef XA_LDV
    __syncthreads();
#define XA_STV(i_) do { const int c = tv + 512 * (i_); *(uint4*)(Il + (c >> 5) * 528 + (c & 31) * 16) = vr##i_; } while (0)
    XA_STV(0); XA_STV(1); XA_STV(2); XA_STV(3); XA_STV(4); XA_STV(5); XA_STV(6); XA_STV(7); XA_STV(8); XA_STV(9); XA_STV(10); XA_STV(11); XA_STV(12); XA_STV(13); XA_STV(14); XA_STV(15);
#undef XA_STV
    __syncthreads();
    f32x16_t o[4];
#define XA_PV(db_, mb_, P0_, P1_) do { const char* vp = Il + (dh * 128 + (db_) * 32 + r) * 528 + ((mb_) * 32 + 4 * hh) * 2; \
        o[db_] = __builtin_amdgcn_mfma_f32_32x32x16_bf16(mk_bf16x8(*(const uint2*)vp, *(const uint2*)(vp + 16)), P0_, o[db_], 0, 0, 0); \
        o[db_] = __builtin_amdgcn_mfma_f32_32x32x16_bf16(mk_bf16x8(*(const uint2*)(vp + 32), *(const uint2*)(vp + 48)), P1_, o[db_], 0, 0, 0); } while (0)
#pragma unroll
    for (int db = 0; db < 4; ++db) {
#pragma unroll
        for (int i = 0; i < 16; ++i) o[db][i] = 0.f;
        XA_PV(db, 0, pf00, pf01); XA_PV(db, 1, pf10, pf11); XA_PV(db, 2, pf20, pf21); XA_PV(db, 3, pf30, pf31); XA_PV(db, 4, pf40, pf41); XA_PV(db, 5, pf50, pf51); XA_PV(db, 6, pf60, pf61); XA_PV(db, 7, pf70, pf71);
    }
#undef XA_PV
    __syncthreads();
    char* Ost = Il + wave * 8704;
#pragma unroll
    for (int db = 0; db < 4; ++db)
#pragma unroll
        for (int g = 0; g < 4; ++g) { uint2 w; w.x = pk2bf(o[db][4 * g] * inv, o[db][4 * g + 1] * inv); w.y = pk2bf(o[db][4 * g + 2] * inv, o[db][4 * g + 3] * inv); *(uint2*)(Ost + r * 272 + (db * 32 + 8 * g + 4 * hh) * 2) = w; }
    bf16_t* obase = O + (size_t)(t0 + tq * 32) * DM + h * 256 + dh * 128;
#pragma unroll
    for (int i = 0; i < 8; ++i) { const int c = lane + 64 * i, row = c >> 4, ch = c & 15; const uint4 v = *(const uint4*)(Ost + row * 272 + ch * 16); if (do_store) nt_st16(obase + (size_t)row * DM + ch * 8, v); }
    __syncthreads();
}
__device__ __forceinline__ void sb_wave(char* ldsw, bf16_t* MIXQ, const bf16_t* __restrict__ PROJ2, const bf16_t* __restrict__ SVT, const float* __restrict__ sbn, int b, int h, int t0, int lane, const bool do_store = true) {
    const int r = lane & 31, hh = lane >> 5;
    char* Kw = ldsw; char* Vw = ldsw + 4608;
    bf16_t* qrow = MIXQ + ((size_t)b * SEQ + t0 + r) * DM + h * 64;
    bf16x8_t qf[4];
#pragma unroll
    for (int ks = 0; ks < 4; ++ks) qf[ks] = *(const bf16x8_t*)(qrow + 16 * ks + 8 * hh);
    const bf16_t* Kg = PROJ2 + ((size_t)b * SEQ + (lane >> 3)) * 1536 + h * 64 + (lane & 7) * 8;
    const bf16_t* Vg = SVT + ((size_t)(b * 8 + h) * 64 + (lane >> 2)) * SEQ + (lane & 3) * 8;
    char* Kst = Kw + (lane >> 3) * 144 + (lane & 7) * 16; char* Vst = Vw + (lane >> 2) * 72 + (lane & 3) * 16;
    const char* Kfr = Kw + r * 144 + 16 * hh; const char* Vfr = Vw + r * 72 + 8 * hh;
    f32x16_t o0, o1;
#pragma unroll
    for (int i = 0; i < 16; ++i) { o0[i] = 0.f; o1[i] = 0.f; }
    float carry = 0.f;
    uint4 gk0, gk1, gk2, gk3, gv0, gv1, gv2, gv3;
#define SB_GLOAD(k0_) do { const bf16_t* kp_ = Kg + (size_t)(k0_) * 1536; gk0 = *(const uint4*)kp_; gk1 = *(const uint4*)(kp_ + 8 * 1536); gk2 = *(const uint4*)(kp_ + 16 * 1536); gk3 = *(const uint4*)(kp_ + 24 * 1536); \
        const bf16_t* vp_ = Vg + (k0_); gv0 = *(const uint4*)vp_; gv1 = *(const uint4*)(vp_ + 16 * SEQ); gv2 = *(const uint4*)(vp_ + 32 * SEQ); gv3 = *(const uint4*)(vp_ + 48 * SEQ); } while (0)
#define SB_VST(p_, v_) do { uint2 lo_, hi_; lo_.x = (v_).x; lo_.y = (v_).y; hi_.x = (v_).z; hi_.y = (v_).w; *(uint2*)(p_) = lo_; *(uint2*)((p_) + 8) = hi_; } while (0)
    SB_GLOAD(t0);
#pragma unroll 1
    for (int k0 = t0; k0 >= 0; k0 -= 32) {
        *(uint4*)Kst = gk0; *(uint4*)(Kst + 8 * 144) = gk1; *(uint4*)(Kst + 16 * 144) = gk2; *(uint4*)(Kst + 24 * 144) = gk3;
        SB_VST(Vst, gv0); SB_VST(Vst + 16 * 72, gv1); SB_VST(Vst + 32 * 72, gv2); SB_VST(Vst + 48 * 72, gv3);
        if (k0 >= 32) SB_GLOAD(k0 - 32);
        bf16x8_t kf[4], vf[4];
#pragma unroll
        for (int ks = 0; ks < 4; ++ks) kf[ks] = *(const bf16x8_t*)(Kfr + 32 * ks);
#pragma unroll
        for (int db = 0; db < 2; ++db)
#pragma unroll
            for (int s2 = 0; s2 < 2; ++s2) { const char* vp = Vfr + db * 32 * 72 + 32 * s2; vf[db * 2 + s2] = mk_bf16x8(*(const uint2*)vp, *(const uint2*)(vp + 16)); }
        f32x16_t s;
#pragma unroll
        for (int i = 0; i < 16; ++i) s[i] = 0.f;
#pragma unroll
        for (int ks = 0; ks < 4; ++ks) s = __builtin_amdgcn_mfma_f32_32x32x16_bf16(kf[ks], qf[ks], s, 0, 0, 0);
        const bool diag = (k0 == t0);
        float lb[16];
#pragma unroll
        for (int i = 0; i < 16; ++i) {
            const float z = s[i]; const float e = __builtin_amdgcn_exp2f(-fabsf(z));
            float v = -(fmaxf(z, 0.f) + __builtin_amdgcn_logf(1.0f + e));
            if (diag && ((i & 3) + 8 * (i >> 2) + 4 * hh >= r)) v = 0.f;
            lb[i] = v;
        }
        float gs[4], pg[4], off[4];
#pragma unroll
        for (int g = 0; g < 4; ++g) { lb[4 * g + 2] += lb[4 * g + 3]; lb[4 * g + 1] += lb[4 * g + 2]; lb[4 * g] += lb[4 * g + 1]; gs[g] = lb[4 * g]; }
#pragma unroll
        for (int g = 0; g < 4; ++g) pg[g] = xor32_get(gs[g], hh);
        float run = 0.f;
#pragma unroll
        for (int g = 3; g >= 0; --g) { off[g] = run + (hh == 0 ? pg[g] : 0.f); run += gs[g] + pg[g]; }
#pragma unroll
        for (int i = 0; i < 16; ++i) {
            float p = __builtin_amdgcn_exp2f(s[i] + lb[i] + off[i >> 2] + carry);
            if (diag && ((i & 3) + 8 * (i >> 2) + 4 * hh >= r)) p = 0.f;
            s[i] = p;
        }
        carry += run;
        bf16x8_t pf[2];
#pragma unroll
        for (int s2 = 0; s2 < 2; ++s2) { uint4 w; w.x = pk2bf(s[8 * s2], s[8 * s2 + 1]); w.y = pk2bf(s[8 * s2 + 2], s[8 * s2 + 3]); w.z = pk2bf(s[8 * s2 + 4], s[8 * s2 + 5]); w.w = pk2bf(s[8 * s2 + 6], s[8 * s2 + 7]); pf[s2] = __builtin_bit_cast(bf16x8_t, w); }
#pragma unroll
        for (int s2 = 0; s2 < 2; ++s2) { o0 = __builtin_amdgcn_mfma_f32_32x32x16_bf16(vf[s2], pf[s2], o0, 0, 0, 0); o1 = __builtin_amdgcn_mfma_f32_32x32x16_bf16(vf[2 + s2], pf[s2], o1, 0, 0, 0); }
        if (__all(carry < -64.f)) break;
    }
#undef SB_GLOAD
#undef SB_VST
    float ss = 0.f;
#pragma unroll
    for (int i = 0; i < 16; ++i) ss += o0[i] * o0[i] + o1[i] * o1[i];
    ss = xor32_sum(ss);
    const float rstd = rsqrtf(ss * (1.0f / 64.0f) + EPS);
#pragma unroll
    for (int g = 0; g < 4; ++g) {
        const int d = 8 * g + 4 * hh;
        const float4 g0 = *(const float4*)(sbn + h * 64 + d), g1 = *(const float4*)(sbn + h * 64 + 32 + d);
        uint2 w0, w1;
        w0.x = pk2bf(o0[4 * g] * rstd * g0.x, o0[4 * g + 1] * rstd * g0.y); w0.y = pk2bf(o0[4 * g + 2] * rstd * g0.z, o0[4 * g + 3] * rstd * g0.w);
        w1.x = pk2bf(o1[4 * g] * rstd * g1.x, o1[4 * g + 1] * rstd * g1.y); w1.y = pk2bf(o1[4 * g + 2] * rstd * g1.z, o1[4 * g + 3] * rstd * g1.w);
        if (do_store) { *(uint2*)(qrow + d) = w0; *(uint2*)(qrow + 32 + d) = w1; }
    }
}

__device__ __forceinline__ void ret_unit(char* lds, bf16_t* MIXQ, const bf16_t* __restrict__ PROJ2, const bf16_t* __restrict__ RKT, const bf16_t* __restrict__ RVT, const float* __restrict__ rn, int b, int h, int j, int tid, const bool do_store = true) {
    const int lane = tid & 63, wave = __builtin_amdgcn_readfirstlane(tid >> 6), r = lane & 31, hh = lane >> 5;
    const int eh = wave >> 2, cq = eh ? 3 - (wave & 3) : (wave & 3);
    const int eb4 = wave & 3, dp = wave >> 2;
    char* Kl = lds; char* KzT = lds + 34816; char* VTl = lds + 69632; char* stT = lds + 104448; float* xch = (float*)(lds + 139264);
    const float lg2 = log2f(1.0f - exp2f(-5.0f - (float)h));
    const float g128 = exp2f(128.0f * lg2);
    f32x16_t st0, st1;
#pragma unroll
    for (int i = 0; i < 16; ++i) { st0[i] = 0.f; st1[i] = 0.f; }
    const size_t bh = (size_t)b * 4 + h;
#pragma unroll 1
    for (int n = 0; n < 4 * j + 4; ++n) {
        const bool full = n >= 4 * j;
        const size_t row0 = (size_t)b * SEQ + n * 128;
        bf16x8_t qf[8]; uint2 gA0, gA1, gA2, gA3, gB0, gB1, gB2, gB3;
        if (full) {
            const bf16_t* qrow = MIXQ + (row0 + cq * 32 + r) * DM + 512 + h * 128 + 8 * hh;
#pragma unroll
            for (int ks = 0; ks < 8; ++ks) qf[ks] = *(const bf16x8_t*)(qrow + 16 * ks);
            const bf16_t* grow = PROJ2 + (row0 + cq * 32 + r) * 1536 + 1024 + h * 128 + eh * 64 + 4 * hh;
            gA0 = *(const uint2*)(grow); gA1 = *(const uint2*)(grow + 8); gA2 = *(const uint2*)(grow + 16); gA3 = *(const uint2*)(grow + 24);
            gB0 = *(const uint2*)(grow + 32); gB1 = *(const uint2*)(grow + 40); gB2 = *(const uint2*)(grow + 48); gB3 = *(const uint2*)(grow + 56);
        }
        __syncthreads();
#pragma unroll
        for (int i = 0; i < 4; ++i) { const int c = tid + 512 * i, rw = c >> 4, ch = c & 15;
            *(uint4*)(KzT + rw * 272 + ch * 16) = *(const uint4*)(RKT + (bh * 128 + rw) * SEQ + n * 128 + ch * 8);
            *(uint4*)(VTl + rw * 272 + ch * 16) = *(const uint4*)(RVT + (bh * 128 + rw) * SEQ + n * 128 + ch * 8);
            if (full) *(uint4*)(Kl + rw * 272 + ch * 16) = *(const uint4*)(PROJ2 + (row0 + rw) * 1536 + 512 + h * 128 + ch * 8); }
        if (full) {
#pragma unroll
            for (int g = 0; g < 4; ++g) { uint2 w0, w1; w0.x = pk2bf(st0[4 * g], st0[4 * g + 1]); w0.y = pk2bf(st0[4 * g + 2], st0[4 * g + 3]); w1.x = pk2bf(st1[4 * g], st1[4 * g + 1]); w1.y = pk2bf(st1[4 * g + 2], st1[4 * g + 3]);
                *(uint2*)(stT + (eb4 * 32 + r) * 272 + ((2 * dp) * 32 + 8 * g + 4 * hh) * 2) = w0; *(uint2*)(stT + (eb4 * 32 + r) * 272 + ((2 * dp + 1) * 32 + 8 * g + 4 * hh) * 2) = w1; }
        }
        __syncthreads();
        f32x16_t ot0, ot1;
        if (full) {
#pragma unroll
            for (int i = 0; i < 16; ++i) { ot0[i] = 0.f; ot1[i] = 0.f; }
#pragma unroll
            for (int ks = 0; ks < 8; ++ks) {
                const bf16x8_t a0 = *(const bf16x8_t*)(stT + (eh * 64 + r) * 272 + (16 * ks + 8 * hh) * 2), a1 = *(const bf16x8_t*)(stT + (eh * 64 + 32 + r) * 272 + (16 * ks + 8 * hh) * 2);
                ot0 = __builtin_amdgcn_mfma_f32_32x32x16_bf16(a0, qf[ks], ot0, 0, 0, 0); ot1 = __builtin_amdgcn_mfma_f32_32x32x16_bf16(a1, qf[ks], ot1, 0, 0, 0); }
            const float xi = exp2f((float)(cq * 32 + r + 1) * lg2);
#pragma unroll
            for (int i = 0; i < 16; ++i) { ot0[i] *= xi; ot1[i] *= xi; }
#pragma unroll 1
            for (int mb = 0; mb <= cq; ++mb) {
                f32x16_t s;
#pragma unroll
                for (int i = 0; i < 16; ++i) s[i] = 0.f;
#pragma unroll
                for (int ks = 0; ks < 8; ++ks) { const bf16x8_t a = *(const bf16x8_t*)(Kl + (mb * 32 + r) * 272 + (16 * ks + 8 * hh) * 2); s = __builtin_amdgcn_mfma_f32_32x32x16_bf16(a, qf[ks], s, 0, 0, 0); }
                const int cm = (cq - mb) * 32 + r - 4 * hh;
#pragma unroll
                for (int i = 0; i < 16; ++i) { const int dl = cm - ((i & 3) + 8 * (i >> 2)); s[i] = dl >= 0 ? s[i] * exp2f((float)dl * lg2) : 0.f; }
                bf16x8_t pf[2];
#pragma unroll
                for (int s2 = 0; s2 < 2; ++s2) { uint4 w; w.x = pk2bf(s[8 * s2], s[8 * s2 + 1]); w.y = pk2bf(s[8 * s2 + 2], s[8 * s2 + 3]); w.z = pk2bf(s[8 * s2 + 4], s[8 * s2 + 5]); w.w = pk2bf(s[8 * s2 + 6], s[8 * s2 + 7]); pf[s2] = __builtin_bit_cast(bf16x8_t, w); }
#pragma unroll
                for (int s2 = 0; s2 < 2; ++s2) {
                    const char* vp0 = VTl + (eh * 64 + r) * 272 + (mb * 32 + 16 * s2 + 4 * hh) * 2; const char* vp1 = vp0 + 32 * 272;
                    ot0 = __builtin_amdgcn_mfma_f32_32x32x16_bf16(mk_bf16x8(*(const uint2*)vp0, *(const uint2*)(vp0 + 16)), pf[s2], ot0, 0, 0, 0);
                    ot1 = __builtin_amdgcn_mfma_f32_32x32x16_bf16(mk_bf16x8(*(const uint2*)vp1, *(const uint2*)(vp1 + 16)), pf[s2], ot1, 0, 0, 0); }
            }
            float s1 = 0.f, s2v = 0.f;
#pragma unroll
            for (int i = 0; i < 16; ++i) { s1 += ot0[i] + ot1[i]; s2v += ot0[i] * ot0[i] + ot1[i] * ot1[i]; }
            s1 = xor32_sum(s1); s2v = xor32_sum(s2v);
            if (hh == 0) { xch[(eh * 128 + cq * 32 + r) * 2] = s1; xch[(eh * 128 + cq * 32 + r) * 2 + 1] = s2v; }
        }
#pragma unroll
        for (int i = 0; i < 16; ++i) { st0[i] *= g128; st1[i] *= g128; }
#pragma unroll
        for (int ks = 0; ks < 8; ++ks) {
            const bf16x8_t bv = *(const bf16x8_t*)(VTl + (eb4 * 32 + r) * 272 + (16 * ks + 8 * hh) * 2);
            const bf16x8_t a0 = *(const bf16x8_t*)(KzT + ((2 * dp) * 32 + r) * 272 + (16 * ks + 8 * hh) * 2), a1 = *(const bf16x8_t*)(KzT + ((2 * dp + 1) * 32 + r) * 272 + (16 * ks + 8 * hh) * 2);
            st0 = __builtin_amdgcn_mfma_f32_32x32x16_bf16(a0, bv, st0, 0, 0, 0); st1 = __builtin_amdgcn_mfma_f32_32x32x16_bf16(a1, bv, st1, 0, 0, 0); }
        if (full) {
            __syncthreads();
            const int c = cq * 32 + r;
            const float t1 = xch[c * 2] + xch[(128 + c) * 2], t2 = xch[c * 2 + 1] + xch[(128 + c) * 2 + 1];
            const float mu = t1 * (1.0f / 128.0f); const float var = fmaxf(t2 * (1.0f / 128.0f) - mu * mu, 0.f); const float rstd = rsqrtf(var + EPS);
            bf16_t* orow = MIXQ + (row0 + c) * DM + 512 + h * 128 + eh * 64 + 4 * hh;
            const float* gn = rn + h * 128 + eh * 64 + 4 * hh;
#pragma unroll
            for (int g = 0; g < 4; ++g) {
                const uint2 ga = g == 0 ? gA0 : (g == 1 ? gA1 : (g == 2 ? gA2 : gA3)), gb = g == 0 ? gB0 : (g == 1 ? gB1 : (g == 2 ? gB2 : gB3));
                const float4 na = *(const float4*)(gn + 8 * g), nb = *(const float4*)(gn + 32 + 8 * g);
                const float gav[4] = {__uint_as_float(ga.x << 16), __uint_as_float(ga.x & 0xFFFF0000u), __uint_as_float(ga.y << 16), __uint_as_float(ga.y & 0xFFFF0000u)};
                const float gbv[4] = {__uint_as_float(gb.x << 16), __uint_as_float(gb.x & 0xFFFF0000u), __uint_as_float(gb.y << 16), __uint_as_float(gb.y & 0xFFFF0000u)};
                const float nav[4] = {na.x, na.y, na.z, na.w}, nbv[4] = {nb.x, nb.y, nb.z, nb.w};
                float ya[4], yb[4];
#pragma unroll
                for (int k = 0; k < 4; ++k) { ya[k] = (ot0[4 * g + k] - mu) * rstd * nav[k] * (gav[k] / (1.0f + __expf(-gav[k]))); yb[k] = (ot1[4 * g + k] - mu) * rstd * nbv[k] * (gbv[k] / (1.0f + __expf(-gbv[k]))); }
                uint2 w0, w1; w0.x = pk2bf(ya[0], ya[1]); w0.y = pk2bf(ya[2], ya[3]); w1.x = pk2bf(yb[0], yb[1]); w1.y = pk2bf(yb[2], yb[3]);
                if (do_store) { *(uint2*)(orow + 8 * g) = w0; *(uint2*)(orow + 32 + 8 * g) = w1; }
            }
        }
    }
    __syncthreads();
}
#define XB_TMO      128
#define XB_XCNT(j)  (256  + 64 * (j))
#define XB_XSUB(j)  (1280 + 64 * (j))
#define XB_XGEN(j)  (2304 + 64 * (j))
#define XB_TOP      3328
#define XB_TOPGEN   3392
#define XB_SPIN_CAP (1u << 20)
typedef __attribute__((address_space(3))) unsigned lds_u32;
__device__ __forceinline__ unsigned xb_ld(unsigned* p)              { return __hip_atomic_load(p, __ATOMIC_RELAXED, __HIP_MEMORY_SCOPE_AGENT); }
__device__ __forceinline__ unsigned xb_add(unsigned* p, unsigned v) { return __hip_atomic_fetch_add(p, v, __ATOMIC_RELAXED, __HIP_MEMORY_SCOPE_AGENT); }
__device__ __forceinline__ unsigned xb_xcc_id() { return (unsigned)__builtin_amdgcn_s_getreg((3 << 11) | 20) & 0xFu; }
#define XB_SPIN(cond, bar) do { unsigned _sp = 0; while (cond) { __builtin_amdgcn_s_sleep(1); \
    if ((++_sp & 255u) == 0u) { if (xb_ld(&(bar)[XB_TMO])) break; if (_sp > XB_SPIN_CAP) { atomicAdd(&(bar)[XB_TMO], 1u); break; } } } } while (0)
__device__ __forceinline__ void xcd_barrier_post(unsigned* bar) { if (threadIdx.x == 0) (void)xb_add(&bar[XB_XCNT(xb_xcc_id())], 1u); }
__device__ __forceinline__ void xcd_barrier_complete(unsigned* bar, unsigned x, unsigned& nloc, unsigned& nx) {
    const unsigned G = gridDim.x * gridDim.y * gridDim.z;
    unsigned sum, cnt, mine, sp = 0u;
    for (;;) {
        sum = 0u; cnt = 0u; mine = 0u;
#pragma unroll
        for (unsigned j = 0; j < 16; ++j) { const unsigned c = xb_ld(&bar[XB_XCNT(j)]); sum += c; cnt += (c > 0u) ? 1u : 0u; mine = (j == x) ? c : mine; }
        if (sum == G) break;
        __builtin_amdgcn_s_sleep(1);
        if ((++sp & 255u) == 0u) { if (xb_ld(&bar[XB_TMO])) break; if (sp > XB_SPIN_CAP) { atomicAdd(&bar[XB_TMO], 1u); break; } }
    }
    nloc = mine > 0u ? mine : 1u; nx = cnt > 0u ? cnt : 1u;
}
__device__ __forceinline__ void xcd_barrier(unsigned* bar, volatile lds_u32* st, const bool thread0) {
    asm volatile("s_waitcnt vmcnt(0)" ::: "memory");
    __syncthreads();
    if (thread0) {
        __builtin_amdgcn_s_waitcnt(0);
        const unsigned x = xb_xcc_id();
        unsigned nloc = st[0], nx = st[1];
        if (nloc == 0u) { xcd_barrier_complete(bar, x, nloc, nx); st[0] = nloc; st[1] = nx; }
        const unsigned old = xb_add(&bar[XB_XSUB(x)], 1u);
        const unsigned gen = old / nloc;
        if (old + 1u == (gen + 1u) * nloc) {
            __builtin_amdgcn_fence(__ATOMIC_RELEASE, "agent");
            asm volatile("s_waitcnt vmcnt(0)" ::: "memory");
            const unsigned og = xb_add(&bar[XB_TOP], 1u);
            const unsigned tg = og / nx;
            if (og + 1u == (tg + 1u) * nx) xb_add(&bar[XB_TOPGEN], 1u);
            else XB_SPIN(xb_ld(&bar[XB_TOPGEN]) == tg, bar);
            __builtin_amdgcn_fence(__ATOMIC_ACQUIRE, "agent");
            xb_add(&bar[XB_XGEN(x)], 1u);
            asm volatile("s_waitcnt vmcnt(0)" ::: "memory");
        } else {
            XB_SPIN(xb_ld(&bar[XB_XGEN(x)]) == gen, bar);
            __builtin_amdgcn_fence(__ATOMIC_ACQUIRE, "agent");
            asm volatile("s_waitcnt vmcnt(0)" ::: "memory");
        }
    }
    __syncthreads();
}
__device__ __forceinline__ int lane_id_volatile() { int l; asm volatile("v_mbcnt_lo_u32_b32 %0, -1, 0\n\tv_mbcnt_hi_u32_b32 %0, -1, %0" : "=v"(l)); return l; }
struct Params { const float* in[18]; float* out; char* ws; };
constexpr int LDS_BYTES = 147456, BARW_OFF = 147392;
#define GRID_BAR() do { const __attribute__((address_space(4))) Params* kpb = (const __attribute__((address_space(4))) Params*)__builtin_amdgcn_kernarg_segment_ptr(); asm volatile("" : "+s"(kpb)); xcd_barrier((unsigned*)kpb->ws + 4096, (volatile lds_u32*)(lds_all + BARW_OFF), wave_s == 0 && lane_id_volatile() == 0); } while (0)
constexpr size_t MiB = 1u << 20;
constexpr size_t WS_ROT = 1, WS_SSQ = 2, WS_MEMSSQ = 4, WS_MEMB = 8, WS_KV = 16, WS_WIN = 48, WS_WOUT = 62, WS_WQ = 66, WS_WKV = 70, WS_WO = 78, WS_WP = 82,
                 WS_XB = 96, WS_MIXQ = 160, WS_PROJ2 = 224, WS_SVT = 320, WS_RVT = 352, WS_RKT = 384, WS_Q = 224, WS_O = 288, WS_SCORES = 224, WS_IDX = 384, WS_GATE = 400, WS_T8 = 416, WS_ISC = 5, WS_A = 224, WS_VT = 480, WS_END = 496;
#ifndef PHMASK
#define PHMASK 0xFFFFF
#endif
#define PH(k) if constexpr ((PHMASK >> (k)) & 1)
#ifndef REP0
#define REP0 1
#endif
#ifndef REP1
#define REP1 1
#endif
#ifndef REP12
#define REP12 1
#endif
#ifndef REP9B
#define REP9B 1
#endif
#ifndef REP9C
#define REP9C 1
#endif
#ifndef REP4
#define REP4 1
#endif
#ifndef REPR
#define REPR 1
#endif
#ifndef REPS
#define REPS 1
#endif
#ifndef REP5ST
#define REP5ST 1
#endif
#ifndef REP5
#define REP5 1
#endif
#ifndef REP8
#define REP8 1
#endif
#ifndef REP89
#define REP89 1
#endif
#ifdef PROBE_T
#define STAMP(i) do { if (blockIdx.x == 0 && wave_s == 0 && lane_id_volatile() == 0) ((volatile unsigned long long*)(lds_all + 146432))[i] = __builtin_amdgcn_s_memrealtime(); } while (0)
#else
#define STAMP(i) do {} while (0)
#endif
#define VB_LOOP(nvb) for (int vb = bid * 2 + (tid >> 8); vb < (nvb); vb += G * 2)

#define PHASE_VARS \
    const __attribute__((address_space(4))) Params* kp = (const __attribute__((address_space(4))) Params*)__builtin_amdgcn_kernarg_segment_ptr(); asm volatile("" : "+s"(kp)); \
    int tid; asm volatile("v_mbcnt_lo_u32_b32 %0, -1, 0\n\tv_mbcnt_hi_u32_b32 %0, -1, %0" : "=v"(tid)); tid += wave_s * 64; \
    const int lane = tid & 63, wave = __builtin_amdgcn_readfirstlane(tid >> 6), vtid = tid & 255; char* lds = lds_all + (tid >> 8) * 32768; \
    PG8_LAS unsigned char* glds = (PG8_LAS unsigned char*)lds_all; PG8_LAS float* rbuf = (PG8_LAS float*)(glds + 132096); \
    const int G = gridDim.x, bid = blockIdx.x; \
    const float* x = kp->in[0]; const float* mem = kp->in[1]; const float* mix_norm = kp->in[2]; const float* w_in = kp->in[3]; const float* sb_norm = kp->in[4]; const float* ret_norm = kp->in[5]; \
    const float* w_out = kp->in[6]; const float* xa_norm = kp->in[7]; const float* mem_norm = kp->in[8]; const float* xa_wq = kp->in[9]; const float* xa_wkv = kp->in[10]; const float* xa_wo = kp->in[11]; \
    const float* peer_norm = kp->in[12]; const float* peer_wq = kp->in[13]; const float* peer_keys = kp->in[14]; const float* peer_u = kp->in[15]; const float* peer_v = kp->in[16]; const float* final_norm = kp->in[17]; \
    float* XR = kp->out; char* ws = kp->ws; \
    float* SSQ = (float*)(ws + WS_SSQ * MiB); float* MEMSSQ = (float*)(ws + WS_MEMSSQ * MiB); \
    bf16_t* MEMB = (bf16_t*)(ws + WS_MEMB * MiB); bf16_t* KV = (bf16_t*)(ws + WS_KV * MiB); \
    bf16_t* WIN_T = (bf16_t*)(ws + WS_WIN * MiB); bf16_t* WOUT_T = (bf16_t*)(ws + WS_WOUT * MiB); bf16_t* WQ_T = (bf16_t*)(ws + WS_WQ * MiB); \
    bf16_t* WKV_T = (bf16_t*)(ws + WS_WKV * MiB); bf16_t* WO_T = (bf16_t*)(ws + WS_WO * MiB); bf16_t* WP_T = (bf16_t*)(ws + WS_WP * MiB); \
    bf16_t* XB = (bf16_t*)(ws + WS_XB * MiB); bf16_t* MIXQ = (bf16_t*)(ws + WS_MIXQ * MiB); bf16_t* PROJ2 = (bf16_t*)(ws + WS_PROJ2 * MiB); \
    bf16_t* Q = (bf16_t*)(ws + WS_Q * MiB); bf16_t* O = (bf16_t*)(ws + WS_O * MiB); bf16_t* SCORES = (bf16_t*)(ws + WS_SCORES * MiB); \
    int* IDX = (int*)(ws + WS_IDX * MiB); float* GATE = (float*)(ws + WS_GATE * MiB); unsigned char* T8 = (unsigned char*)(ws + WS_T8 * MiB); float* ISC = (float*)(ws + WS_ISC * MiB); float* WSC = (float*)(ws + WS_ISC * MiB + 524288); float* WMAX = (float*)(ws + 65536); unsigned char* WINQ = (unsigned char*)(ws + WS_WIN * MiB); unsigned char* XQ = (unsigned char*)XR; float* XS = (float*)((char*)XR + 64 * MiB); bf16_t* APART = (bf16_t*)(ws + WS_A * MiB); bf16_t* VT = (bf16_t*)(ws + WS_VT * MiB); bf16_t* SVT = (bf16_t*)(ws + WS_SVT * MiB); bf16_t* RVT = (bf16_t*)(ws + WS_RVT * MiB); bf16_t* RKT = (bf16_t*)(ws + WS_RKT * MiB); \
    (void)lane; (void)wave; (void)vtid; (void)lds; (void)glds; (void)rbuf; (void)G; (void)bid; (void)x; (void)mem; (void)mix_norm; (void)w_in; (void)sb_norm; (void)ret_norm; (void)w_out; (void)xa_norm; (void)mem_norm; \
    (void)xa_wq; (void)xa_wkv; (void)xa_wo; (void)peer_norm; (void)peer_wq; (void)peer_keys; (void)peer_u; (void)peer_v; (void)final_norm; (void)XR; (void)SSQ; (void)MEMSSQ; (void)MEMB; (void)KV; (void)WIN_T; \
    (void)WOUT_T; (void)WQ_T; (void)WKV_T; (void)WO_T; (void)WP_T; (void)XB; (void)MIXQ; (void)PROJ2; (void)Q; (void)O; (void)SCORES; (void)IDX; (void)GATE; (void)T8; (void)ISC; (void)WSC; (void)WMAX; (void)WINQ; (void)XQ; (void)XS; (void)APART; (void)VT; (void)SVT; (void)RVT; (void)RKT;

__global__ void __launch_bounds__(512, 2) mega(Params p_unused) {
    extern __shared__ __attribute__((aligned(16))) char lds_all[];
    cg::grid_group grid = cg::this_grid();
    const int wave_s = __builtin_amdgcn_readfirstlane((int)(threadIdx.x >> 6));
    if (threadIdx.x < 2) ((volatile lds_u32*)(lds_all + BARW_OFF))[threadIdx.x] = 0u;
    __syncthreads();
    { const __attribute__((address_space(4))) Params* kp0 = (const __attribute__((address_space(4))) Params*)__builtin_amdgcn_kernarg_segment_ptr(); xcd_barrier_post((unsigned*)kp0->ws + 4096); }
    STAMP(0);
    for (int rep0 = 0; rep0 < REP0; ++rep0)
    PH(0) { PHASE_VARS
        const int gw = bid * 8 + wave, NGW = G * 8;
        for (int it = gw; it < NL * 1792; it += NGW) { const int l = it / 1792; wmax_item(w_in + (size_t)l * DM * INC, DM, INC, mix_norm + l * DM, WMAX + l * INC, it % 1792, lane); }
    }
    GRID_BAR();
    PH(0) { PHASE_VARS
        const int gw = bid * 8 + wave, NGW = G * 8;
        float* scr = (float*)(lds_all + wave * 8448);
        for (int it = gw; it < 2 * 4352; it += NGW) {
            const int l = it / 4352; int r = it % 4352;
            if (r < 1792) { tr_item_i8(w_in + (size_t)l * DM * INC, DM, INC, mix_norm + l * DM, WINQ + (size_t)l * INC * DM, WMAX + l * INC, WMAX + 8192 + l * INC, scr, r, lane); continue; } r -= 1792;
            if (r < 512) { tr_item(w_out + (size_t)l * DM * DM, DM, DM, nullptr, false, WOUT_T + (size_t)l * DM * DM, scr, r, lane); continue; } r -= 512;
            if (r < 512) { tr_item(xa_wq + (size_t)l * DM * DM, DM, DM, xa_norm + l * DM, false, WQ_T + (size_t)l * DM * DM, scr, r, lane); continue; } r -= 512;
            if (r < 1024) { tr_item(xa_wkv + (size_t)l * DM * 2048, DM, 2048, mem_norm + l * DM, false, WKV_T + (size_t)l * 2048 * DM, scr, r, lane); continue; } r -= 1024;
            tr_item(xa_wo + (size_t)l * DM * DM, DM, DM, nullptr, false, WO_T + (size_t)l * DM * DM, scr, r, lane);
        }
        for (int m = gw; m < T; m += NGW) row_to_i8_ssq(x + (size_t)m * DM, XQ + (size_t)m * DM, XS + m, SSQ + (size_t)m * 16, lane);
        for (int m = gw; m < MROWS; m += NGW) row_to_bf16_ssq(mem + (size_t)m * DM, MEMB + (size_t)m * DM, MEMSSQ + (size_t)m * 16, lane);
        __syncthreads();
        for (int it = bid; it < NL * 256; it += G) { const int l = it >> 8;
            peer_fold_item(peer_wq + (size_t)l * DM * 2048, peer_keys + (size_t)l * 8 * 2 * 128 * 128, peer_norm + l * DM, WP_T + (size_t)l * 2048 * DM, (float*)lds_all, it & 255, tid); }
    }
    grid.sync();
    STAMP(1);
    for (int l = 0; l < NL; ++l) {
        int stamp_i = 2 + l * 11; (void)stamp_i;
        if (l > 0) {
            PH(1) { PHASE_VARS const int gw = bid * 8 + wave, NGW = G * 8; for (int m = gw; m < T; m += NGW) rowbf_to_i8(XB + (size_t)m * DM, XQ + (size_t)m * DM, XS + m, lane); }
            GRID_BAR();
        }
        for (int rep12 = 0; rep12 < REP12; ++rep12) {
        for (int rep1 = 0; rep1 < REP1; ++rep1) {
        PH(1) { PHASE_VARS  pg8::Gemm g{(const bf16_t*)XQ, (const bf16_t*)(WINQ + (size_t)l * INC * DM), T, INC, DM / 2}; pg8::StaticOrder S; S.init(T, INC, G, bid, tid, SSQ, rbuf, XS, WMAX + 8192 + l * INC);
            pg8::EpiProj E{MIXQ, PROJ2, SVT, RKT, RVT, rbuf, WMAX + 8192 + l * INC, glds + 136192};
            pg8::gemm_phase<pg8::EpiProj, pg8::StaticOrder, true, true, true>(glds, g, S, E, tid); }
        PH(2) if (l == 0) { PHASE_VARS
#pragma unroll 1
            for (int ll = 0; ll < NL; ++ll) {
                pg8::Gemm g{MEMB, WKV_T + (size_t)ll * 2048 * DM, MROWS, 2048, DM}; pg8::StaticOrder S; S.init(MROWS, 2048, G, (bid + ll * (G / 2)) % G, tid, MEMSSQ, rbuf);
                pg8::EpiKV E{KV + (size_t)ll * MROWS * 2048, VT + (size_t)ll * NB * 4 * 256 * 256, rbuf};
                pg8::gemm_phase<pg8::EpiKV, pg8::StaticOrder, true, true>(glds, g, S, E, tid); }
        }
        GRID_BAR(); STAMP(stamp_i); ++stamp_i;
        }
        for (int repr = 0; repr < REPR; ++repr)
        PH(3) { PHASE_VARS for (int u = bid; u < NB * 4 * 4; u += G) ret_unit(lds_all, MIXQ, PROJ2, RKT, RVT, ret_norm + l * 512, u >> 4, (u >> 2) & 3, 3 - (u & 3), tid, repr == REPR - 1); }
        for (int reps = 0; reps < REPS; ++reps)
        PH(4) { PHASE_VARS
            if (G == NB * 16) {
                const int q4 = bid & 3, base = (bid >> 2) * 128 + (q4 == 0 ? 0 : (q4 == 1 ? 24 : (q4 == 2 ? 56 : 88))), cnt = q4 == 0 ? 24 : (q4 == 3 ? 40 : 32);
                for (int i = wave; i < cnt; i += 8) { const int wu = base + i; sb_wave(lds_all + wave * 9216, MIXQ, PROJ2, SVT, sb_norm + l * 512, wu >> 9, (wu >> 6) & 7, (63 - (wu & 63)) * 32, lane, reps == REPS - 1); }
            } else {
                for (int wu = bid * 8 + wave; wu < NB * 8 * 64; wu += G * 8) sb_wave(lds_all + wave * 9216, MIXQ, PROJ2, SVT, sb_norm + l * 512, wu >> 9, (wu >> 6) & 7, (63 - (wu & 63)) * 32, lane, reps == REPS - 1);
            }
            if (G == NB * 16) {
                const int q4 = bid & 3, cnt = q4 == 0 ? 8 : (q4 == 3 ? 24 : 16), base = (bid >> 2) * 512 + (q4 == 0 ? 0 : (q4 == 1 ? 64 : (q4 == 2 ? 192 : 320))) + wave * cnt;
                table_rows_run(peer_u, peer_v, peer_norm, T8, ISC, l, base, cnt, lane);
            } else {
                for (int r = bid * 8 + wave; r < 2 * NEXP; r += G * 8) { const int tab = r >> 14, e = r & (NEXP - 1), lt = l * 2 + tab;
                    table_row_to_i8((tab ? peer_v : peer_u) + ((size_t)l * NEXP + e) * DM, tab ? nullptr : peer_norm + l * DM, T8 + (size_t)lt * 8 * NEXP * 128, ISC + (size_t)lt * NEXP, e, lane); }
            } }
        GRID_BAR(); STAMP(stamp_i); ++stamp_i;
        }
        PH(5) { PHASE_VARS  pg8::Gemm g{MIXQ, WOUT_T + (size_t)l * DM * DM, T, DM, DM}; pg8::StaticOrder S; S.init(T, DM, G, bid, tid);
            if (l == 0) { pg8::EpiResid<true> E{x, XB, SSQ}; pg8::gemm_phase<pg8::EpiResid<true>, pg8::StaticOrder, true, true>(glds, g, S, E, tid); }
            else { pg8::EpiResid<false> E{nullptr, XB, SSQ}; pg8::gemm_phase<pg8::EpiResid<false>, pg8::StaticOrder, true, true>(glds, g, S, E, tid); } }
        GRID_BAR(); STAMP(stamp_i); ++stamp_i;
        PH(6) { PHASE_VARS  pg8::Gemm g{XB, WQ_T + (size_t)l * DM * DM, T, DM, DM}; pg8::StaticOrder S; S.init(T, DM, G, bid, tid, SSQ, rbuf);
            pg8::EpiScale<false> E{Q, 1024, rbuf, 0.0625f * 1.4426950408889634f};
            pg8::gemm_phase<pg8::EpiScale<false>, pg8::StaticOrder, true, true>(glds, g, S, E, tid);
            asm volatile("s_waitcnt vmcnt(0)" ::: "memory"); __syncthreads(); __builtin_amdgcn_fence(__ATOMIC_ACQUIRE, "agent"); asm volatile("s_waitcnt vmcnt(0)" ::: "memory"); __syncthreads();
            pg8::Unit u;
            for (int rep5 = 0; rep5 < REP5; ++rep5)
            for (int i = 0; S.next(i, u); ++i) { const int b = u.pm >> 3, h = u.pn;
#pragma unroll 1
                for (int hf = 0; hf < 2; ++hf)
                    xattn_unit(lds_all, Q, KV + (size_t)l * MROWS * 2048 + (size_t)b * NMEM * 2048 + h * 256, VT + ((size_t)l * NB * 4 + b * 4 + h) * 65536, O, u.pm * 256 + hf * 128, h, tid, REP5ST || rep5 == REP5 - 1); } }
        GRID_BAR(); STAMP(stamp_i); ++stamp_i;
        PH(8) { PHASE_VARS  pg8::Gemm g{O, WO_T + (size_t)l * DM * DM, T, DM, DM}; pg8::StaticOrder S; S.init(T, DM, G, bid, tid);
            pg8::EpiResid<false> E{nullptr, XB, SSQ};
            pg8::gemm_phase<pg8::EpiResid<false>, pg8::StaticOrder, true, true>(glds, g, S, E, tid); }
        GRID_BAR(); STAMP(stamp_i); ++stamp_i;
#ifdef GPROBE
        {   PHASE_VARS  pg8::Gemm g{XB, WQ_T + (size_t)l * DM * DM, T, DM, DM}; pg8::StaticOrder S;
            if (GPROBE == 1) { S.init(T, DM, G, bid, tid, SSQ, rbuf); pg8::EpiScale<false> E{(bf16_t*)XR, 1024, rbuf, 1.0f}; pg8::gemm_phase<pg8::EpiScale<false>, pg8::StaticOrder, true, true>(glds, g, S, E, tid); }
            if (GPROBE == 2) { S.init(T, DM, G, bid, tid); pg8::EpiScale<false> E{(bf16_t*)XR, 1024, rbuf, 1.0f}; pg8::gemm_phase<pg8::EpiScale<false>, pg8::StaticOrder, true, true>(glds, g, S, E, tid); }
            if (GPROBE == 3) { S.init(T, DM, G, bid, tid); pg8::EpiMin E{(bf16_t*)XR}; pg8::gemm_phase<pg8::EpiMin, pg8::StaticOrder, true, true>(glds, g, S, E, tid); }
        }
        GRID_BAR();
#endif
        PH(9) { PHASE_VARS  pg8::Gemm g{XB, WP_T + (size_t)l * 2048 * DM, T, 2048, DM}; pg8::StaticOrder S; S.init(T, 2048, G, bid, tid, SSQ, rbuf);
            pg8::EpiScale<true> E{SCORES, 2048, rbuf, 1.0f};
            pg8::gemm_phase<pg8::EpiScale<true>, pg8::StaticOrder, true, true>(glds, g, S, E, tid);
            asm volatile("s_waitcnt vmcnt(0)" ::: "memory"); __syncthreads(); __builtin_amdgcn_fence(__ATOMIC_ACQUIRE, "agent"); asm volatile("s_waitcnt vmcnt(0)" ::: "memory"); __syncthreads();
            pg8::Unit u;
            for (int i = 0; S.next(i, u); ++i) peer_topk_fast(SCORES, IDX, GATE, u.pm * 256 + (tid >> 1), u.pn * 2 + (tid & 1)); }
        GRID_BAR(); STAMP(stamp_i); ++stamp_i;
#ifndef REP9A
#define REP9A 1
#endif
        for (int rep9a = 0; rep9a < REP9A; ++rep9a)
        PH(11) { PHASE_VARS peer_u_phase(XB, IDX, T8 + (size_t)(l * 2 + 0) * 8 * NEXP * 128, APART, bid, G, wave, lane); }
        GRID_BAR(); STAMP(stamp_i); ++stamp_i;
        for (int rep9b = 0; rep9b < REP9B; ++rep9b)
        PH(11) { PHASE_VARS for (int i = bid * 512 + tid; i < T * 32; i += G * 512) peer_combine4(APART, IDX, GATE, SSQ, ISC + (size_t)(l * 2 + 0) * NEXP, ISC + (size_t)(l * 2 + 1) * NEXP, WSC, i); }
        GRID_BAR(); STAMP(stamp_i); ++stamp_i;
        for (int rep9c = 0; rep9c < REP9C; ++rep9c)
        PH(11) { PHASE_VARS peer_v_phase(IDX, WSC, T8 + (size_t)(l * 2 + 1) * 8 * NEXP * 128, XB, SSQ, bid, G, wave, lane, rep9c == REP9C - 1); }
        GRID_BAR(); STAMP(stamp_i); ++stamp_i;
    }
    PH(12) { PHASE_VARS VB_LOOP(T / 4) d_rmsnorm_final(vb, vtid, XB, XR, final_norm); }
#ifdef PROBE_T
    STAMP(24);
    GRID_BAR();
    if (blockIdx.x == 0) {
        volatile unsigned long long* ts = (volatile unsigned long long*)(lds_all + 146432);
        const __attribute__((address_space(4))) Params* kpp = (const __attribute__((address_space(4))) Params*)__builtin_amdgcn_kernarg_segment_ptr();
        float* outp = kpp->out;
        unsigned long long d = 0;
#pragma unroll
        for (int j = 0; j < 11; ++j) if ((PROBE_MASK >> j) & 1) d += (ts[2 + j] - ts[1 + j]) + (ts[13 + j] - ts[12 + j]);
        if ((PROBE_MASK >> 11) & 1) d += ts[1] - ts[0];
        if ((PROBE_MASK >> 12) & 1) d += ts[24] - ts[0];
        if ((PROBE_MASK >> 13) & 1) d += ts[24] - ts[23];
        const float w = (float)d * 0.01f * (float)(PROBE_S);
        for (int i = wave_s * 64 + lane_id_volatile(); i < 16384; i += 512) outp[1024 + i] = w;
    }
#endif

}

extern "C" void kernel_launch(void* const* d_in, const int* in_sizes, int n_in, void* d_out, int out_size, void* d_ws, size_t ws_size, hipStream_t stream) {
    static int grid_blocks = 0;
    if (grid_blocks == 0) {
        int dev = 0, cus = 0, per_cu = 0;
        (void)hipGetDevice(&dev);
        (void)hipDeviceGetAttribute(&cus, hipDeviceAttributeMultiprocessorCount, dev);
        (void)hipFuncSetAttribute((const void*)mega, hipFuncAttributeMaxDynamicSharedMemorySize, LDS_BYTES);
        (void)hipOccupancyMaxActiveBlocksPerMultiprocessor(&per_cu, (const void*)mega, 512, LDS_BYTES);
        if (per_cu < 1) { fprintf(stderr, "occupancy query says %d blocks/CU\n", per_cu); per_cu = 1; }
        grid_blocks = cus * per_cu;
        if (ws_size < WS_END * MiB || n_in != 18) { fprintf(stderr, "bad ws_size %zu / n_in %d\n", ws_size, n_in); grid_blocks = -1; }
    }
    if (grid_blocks < 0) return;
    (void)hipMemsetAsync(d_ws, 0, 131072, stream);
    Params p{};
    for (int i = 0; i < 18; ++i) p.in[i] = (const float*)d_in[i];
    p.out = (float*)d_out; p.ws = (char*)d_ws;
    void* args[] = {&p};
    hipError_t e = hipLaunchCooperativeKernel((const void*)mega, dim3(grid_blocks), dim3(512), args, LDS_BYTES, stream);
    if (e != hipSuccess) fprintf(stderr, "cooperative launch failed: %s (grid %d)\n", hipGetErrorString(e), grid_blocks);
}
```

```cpp
#include <hip/hip_runtime.h>
#include <hip/hip_cooperative_groups.h>
#include <stdint.h>
#include <cstdio>
#include <type_traits>
namespace cg = cooperative_groups;

typedef unsigned short bf16_t;
__device__ __forceinline__ float bf2f(bf16_t v) { return __uint_as_float(((unsigned)v) << 16); }
__device__ __forceinline__ bf16_t f2bf(float f) { unsigned u = __float_as_uint(f); u = (u + 0x7fffu + ((u >> 16) & 1u)) >> 16; return (bf16_t)u; }
typedef float f32x2_cv __attribute__((ext_vector_type(2))); typedef __bf16 bf16x2_cv __attribute__((ext_vector_type(2)));
__device__ __forceinline__ unsigned pk2bf(float lo, float hi) { f32x2_cv v = {lo, hi}; bf16x2_cv b = __builtin_convertvector(v, bf16x2_cv); return __builtin_bit_cast(unsigned, b); }
typedef unsigned u32x4_nt __attribute__((ext_vector_type(4)));
__device__ __forceinline__ void nt_st16(void* p, uint4 v) { u32x4_nt t = {v.x, v.y, v.z, v.w}; __builtin_nontemporal_store(t, (u32x4_nt*)p); }
__device__ __forceinline__ float xor32_sum(float v) { auto rr = __builtin_amdgcn_permlane32_swap(__float_as_uint(v), __float_as_uint(v), false, false); return __uint_as_float(rr[0]) + __uint_as_float(rr[1]); }
__device__ __forceinline__ float xor16_sum(float v) { auto rr = __builtin_amdgcn_permlane16_swap(__float_as_uint(v), __float_as_uint(v), false, false); return __uint_as_float(rr[0]) + __uint_as_float(rr[1]); }
__device__ __forceinline__ float xor16_max(float v) { auto rr = __builtin_amdgcn_permlane16_swap(__float_as_uint(v), __float_as_uint(v), false, false); return fmaxf(__uint_as_float(rr[0]), __uint_as_float(rr[1])); }
__device__ __forceinline__ int xor16_isum(int v) { auto rr = __builtin_amdgcn_permlane16_swap((unsigned)v, (unsigned)v, false, false); return (int)(rr[0] + rr[1]); }
__device__ __forceinline__ int xor32_isum(int v) { auto rr = __builtin_amdgcn_permlane32_swap((unsigned)v, (unsigned)v, false, false); return (int)(rr[0] + rr[1]); }
__device__ __forceinline__ float xor32_max(float v) { auto rr = __builtin_amdgcn_permlane32_swap(__float_as_uint(v), __float_as_uint(v), false, false); return fmaxf(__uint_as_float(rr[0]), __uint_as_float(rr[1])); }
__device__ __forceinline__ float xor32_get(float v, int hh) { auto rr = __builtin_amdgcn_permlane32_swap(__float_as_uint(v), __float_as_uint(v), false, false); return __uint_as_float(hh ? rr[0] : rr[1]); }
__device__ __forceinline__ unsigned short f2h(float f) { _Float16 h = (_Float16)f; return __builtin_bit_cast(unsigned short, h); }
__device__ __forceinline__ float h2f(unsigned short u) { return (float)__builtin_bit_cast(_Float16, u); }

constexpr int NB = 16, SEQ = 2048, DM = 1024, T = NB * SEQ, NL = 2, NMEM = 256, INC = 3584, MROWS = NB * NMEM;
constexpr float EPS = 1e-6f;

template <int CTRL> __device__ __forceinline__ float wdpp_f(float v) { return __builtin_bit_cast(float, __builtin_amdgcn_update_dpp(0, __builtin_bit_cast(int, v), CTRL, 0xF, 0xF, false)); }
__device__ __forceinline__ float wave_sum(float v) {
    v += wdpp_f<0xB1>(v); v += wdpp_f<0x4E>(v); v += wdpp_f<0x141>(v); v += wdpp_f<0x140>(v);
    return xor32_sum(xor16_sum(v));
}
__device__ __forceinline__ float wave_max(float v) {
    v = fmaxf(v, wdpp_f<0xB1>(v)); v = fmaxf(v, wdpp_f<0x4E>(v)); v = fmaxf(v, wdpp_f<0x141>(v)); v = fmaxf(v, wdpp_f<0x140>(v));
    return xor32_max(xor16_max(v));
}
namespace pg8 {
#define PG8_LAS __attribute__((address_space(3)))
typedef unsigned short bf16_t;
typedef short bf16x8 __attribute__((ext_vector_type(8)));
typedef float f32x4 __attribute__((ext_vector_type(4)));
typedef int i32x4 __attribute__((ext_vector_type(4)));
__device__ __forceinline__ f32x4 tof(f32x4 v) { return v; }
__device__ __forceinline__ f32x4 tof(i32x4 v) { return __builtin_convertvector(v, f32x4); }
typedef unsigned u32x4 __attribute__((ext_vector_type(4)));
constexpr int BM = 256, BK = 64, HALF = 128, HTB = HALF * BK * 2  , STAGE_BYTES = 8 * HTB, NXCD = 8, WGM = 8;

__host__ __device__ __forceinline__ int lds_byte(int r, int c) { const int st = (r >> 4) * 2 + (c >> 5), rr = r & 15, cc = c & 31, ob = rr * 64 + cc * 2; return st * 1024 + (ob ^ (((ob >> 9) & 1) << 5)); }
__host__ __device__ __forceinline__ void stage_rc(int b, int& R, int& C) { const int st = b / 1024, sb = b % 1024, swz = sb ^ (((sb >> 9) & 1) << 5); R = (st >> 1) * 16 + swz / 64; C = (st & 1) * 32 + (swz % 64) / 2; }
__host__ __device__ __forceinline__ int perm32(int rho) { const int n = rho >> 4, i = rho & 15; return 8 * (i >> 2) + 4 * n + (i & 3); }

struct Unit { int pm, pn; };
struct Gemm { const bf16_t* A; const bf16_t* Bt; int M, N, K; };

struct StaticOrder {
    int nM, nN, nwg, G, c;
    __host__ __device__ __forceinline__ void init(int M, int N, int G_, int c_, int tid_in, const float* ssq = nullptr, PG8_LAS float* rb = nullptr, const float* xs = nullptr, const float* cs = nullptr) { tidm = tid_in; SSQ = ssq; rbuf = rb; XS = xs; CS = cs; nM = M / BM; nN = N / BM; nwg = nM * nN; G = G_; c = c_; }
    __host__ __device__ __forceinline__ bool next(int i, Unit& u) const {
        const long L = (long)i * G + c; if (L >= nwg) return false;
        int wgid = (int)L; { const int q = nwg / NXCD, r = nwg % NXCD, xcd = wgid % NXCD, off = wgid / NXCD; wgid = (xcd < r ? xcd * (q + 1) : r * (q + 1) + (xcd - r) * q) + off; }
        const int nig = WGM * nN, gid = wgid / nig, fm = gid * WGM, gsz = (nM - fm) < WGM ? (nM - fm) : WGM;
        u.pm = fm + ((wgid % nig) % gsz); u.pn = (wgid % nig) / gsz; return true;
    }
    const float* XS;
    const float* CS;
    int tidm; const float* SSQ; PG8_LAS float* rbuf;
    __device__ __forceinline__ void a_ready(const Unit& u, int ui) const {
        if (SSQ) { const int t = tidm; if (t < 256) { const f32x4* p = (const f32x4*)(SSQ + (size_t)(u.pm * BM + t) * 16); const f32x4 a = p[0], b = p[1], c = p[2], d = p[3];
            const float xs = XS ? XS[u.pm * BM + t] : 1.0f; const float cs = CS ? CS[u.pn * BM + t] : 0.f;
            const float q = ((a[0] + a[1]) + (a[2] + a[3])) + ((b[0] + b[1]) + (b[2] + b[3])) + ((c[0] + c[1]) + (c[2] + c[3])) + ((d[0] + d[1]) + (d[2] + d[3]));
            rbuf[(ui & 1) * 256 + t] = rsqrtf(q * (1.0f / 1024.0f) + 1e-6f) * xs; if (CS) rbuf[512 + (ui & 1) * 256 + t] = cs; } }
    }
    __device__ __forceinline__ void done(const Unit&) const {}
};

__device__ __forceinline__ unsigned cvt_pk_bf16(float lo, float hi) { unsigned r; asm volatile("v_cvt_pk_bf16_f32 %0, %1, %2" : "=v"(r) : "v"(lo), "v"(hi)); return r; }
typedef float f32x2 __attribute__((ext_vector_type(2)));
template <class Epi, class Sched, bool ALIGN_EPI = false, bool SP2 = false, bool I8 = false>
__device__ __forceinline__ void gemm_phase(PG8_LAS unsigned char* lds, const Gemm g, const Sched& S, const Epi& E, const int tid_in) {
    const int tid = tid_in, wid = __builtin_amdgcn_readfirstlane(tid >> 6), lane = tid & 63, wr = wid >> 2, wc = wid & 3, fr = lane & 15, fq = lane >> 4;
    const int K = g.K, nt = K / BK;
    unsigned voffA[2], voffB[2];
#pragma unroll
    for (int i = 0; i < 2; ++i) { int R, C; stage_rc(tid * 16 + i * 8192, R, C); const int Rb = Epi::PERM ? ((R & ~31) + perm32(R & 31)) : R;
        voffA[i] = (unsigned)(R * K + C) * 2u; voffB[i] = (unsigned)(Rb * K + C) * 2u; }
    const size_t kstep = (size_t)(BK * 2);
    const size_t hstep = (size_t)HALF * K * 2;
    const size_t tstep = 2 * hstep;
    const unsigned ldsw = (unsigned)wid * 1024u;
    const int aoff = lds_byte(wr * 64 + fr, fq * 8), boff = lds_byte(wc * 32 + fr, fq * 8);
#define PG8_SA(b, h) (((b) * 2 + (h)) * HTB)
#define PG8_SB(b, h) ((4 + (b) * 2 + (h)) * HTB)
#define PG8_STAGE(bufoff, gbase, voff) do { _Pragma("unroll") for (int _i = 0; _i < 2; ++_i) \
        __builtin_amdgcn_global_load_lds((const unsigned*)((const char*)(gbase) + (voff)[_i]), (PG8_LAS unsigned*)(lds + (bufoff) + ldsw + _i * 8192), 16, 0, 0); } while (0)
#define PG8_LDA(dst, b, h) do { _Pragma("unroll") for (int m = 0; m < 4; ++m) _Pragma("unroll") for (int k = 0; k < 2; ++k) dst[m][k] = *(const PG8_LAS bf16x8*)(lds + PG8_SA(b, h) + aoff + m * 2048 + k * 1024); } while (0)
#define PG8_LDB(dst, b, h) do { _Pragma("unroll") for (int n = 0; n < 2; ++n) _Pragma("unroll") for (int k = 0; k < 2; ++k) dst[n][k] = *(const PG8_LAS bf16x8*)(lds + PG8_SB(b, h) + boff + n * 2048 + k * 1024); } while (0)
#define PG8_MMA(ai, bj, At, Bt) do { __builtin_amdgcn_s_setprio(1); _Pragma("unroll") for (int m = 0; m < 4; ++m) _Pragma("unroll") for (int n = 0; n < 2; ++n) _Pragma("unroll") for (int k = 0; k < 2; ++k) \
        { if constexpr (I8) acc[ai][bj][m][n] = __builtin_bit_cast(acc_t, __builtin_amdgcn_mfma_i32_16x16x64_i8(__builtin_bit_cast(i32x4, Bt[n][k]), __builtin_bit_cast(i32x4, At[m][k]), __builtin_bit_cast(i32x4, acc[ai][bj][m][n]), 0, 0, 0)); \
          else acc[ai][bj][m][n] = __builtin_bit_cast(acc_t, __builtin_amdgcn_mfma_f32_16x16x32_bf16(Bt[n][k], At[m][k], __builtin_bit_cast(f32x4, acc[ai][bj][m][n]), 0, 0, 0)); } __builtin_amdgcn_s_setprio(0); } while (0)
#define PG8_WAIT_V(n) asm volatile("s_waitcnt vmcnt(" #n ")" ::: "memory")
#define PG8_WAIT_L(n) asm volatile("s_waitcnt lgkmcnt(" #n ")" ::: "memory")
#define PG8_BAR __builtin_amdgcn_s_barrier()
#define PG8_SCHED __builtin_amdgcn_sched_barrier(0)
    Unit cur, nxt; int ui = 0;
    if (!S.next(0, cur)) return;
    typedef typename std::conditional<I8, i32x4, f32x4>::type acc_t;
    acc_t acc[2][2][4][2];
#pragma unroll
    for (int a = 0; a < 2; ++a)
#pragma unroll
        for (int b = 0; b < 2; ++b)
#pragma unroll
            for (int m = 0; m < 4; ++m)
#pragma unroll
                for (int n = 0; n < 2; ++n) acc[a][b][m][n] = acc_t{};
    bf16x8 At[4][2], B0[2][2], B1[2][2];
    const char* cA = (const char*)g.A + (size_t)cur.pm * tstep; const char* cB = (const char*)g.Bt + (size_t)cur.pn * tstep;
    S.a_ready(cur, 0);
    if constexpr (SP2) {
        PG8_STAGE(PG8_SB(0, 0), cB, voffB); PG8_STAGE(PG8_SB(0, 1), cB + hstep, voffB); PG8_STAGE(PG8_SA(0, 0), cA, voffA); PG8_STAGE(PG8_SA(0, 1), cA + hstep, voffA);
        if (wr == 1) PG8_BAR;
        PG8_WAIT_V(2); PG8_BAR;
        PG8_STAGE(PG8_SB(1, 0), cB + kstep, voffB); PG8_STAGE(PG8_SA(1, 0), cA + kstep, voffA); PG8_STAGE(PG8_SB(1, 1), cB + hstep + kstep, voffB);
        PG8_WAIT_V(6); PG8_BAR;
    } else {
        PG8_STAGE(PG8_SB(0, 0), cB, voffB); PG8_STAGE(PG8_SA(0, 0), cA, voffA); PG8_STAGE(PG8_SB(0, 1), cB + hstep, voffB); PG8_STAGE(PG8_SA(0, 1), cA + hstep, voffA);
        if (wr == 1) PG8_BAR;
        PG8_WAIT_V(4); PG8_BAR;
        PG8_STAGE(PG8_SB(1, 0), cB + kstep, voffB); PG8_STAGE(PG8_SA(1, 0), cA + kstep, voffA); PG8_STAGE(PG8_SB(1, 1), cB + hstep + kstep, voffB);
        PG8_WAIT_V(6); PG8_BAR;
    }
    for (;;) {
        const bool has_next = S.next(ui + 1, nxt);
        const char* nA = has_next ? (const char*)g.A + (size_t)nxt.pm * tstep : cA; const char* nB = has_next ? (const char*)g.Bt + (size_t)nxt.pn * tstep : cB;
        for (int t = 0; t < nt; t += 2) {
            const bool last = (t == nt - 2);
            const char* a1 = cA + (size_t)(t + 1) * kstep;
            const char* a2 = last ? nA : cA + (size_t)(t + 2) * kstep; const char* b2 = last ? nB : cB + (size_t)(t + 2) * kstep;
            const char* a3 = a2 + kstep; const char* b3 = b2 + kstep;
            if (last && has_next) S.a_ready(nxt, ui + 1);
            if constexpr (SP2) {
            PG8_LDB(B0, 0, 0); PG8_LDB(B1, 0, 1); PG8_SCHED; PG8_LDA(At, 0, 0); PG8_STAGE(PG8_SA(1, 1), a1 + hstep, voffA);
            PG8_WAIT_V(8); PG8_WAIT_L(0); PG8_BAR; PG8_MMA(0, 0, At, B0); PG8_MMA(0, 1, At, B1); PG8_BAR; PG8_SCHED;
            PG8_LDA(At, 0, 1); PG8_STAGE(PG8_SB(0, 0), b2, voffB); PG8_STAGE(PG8_SB(0, 1), b2 + hstep, voffB); PG8_STAGE(PG8_SA(0, 0), a2, voffA);
            PG8_WAIT_V(8); PG8_WAIT_L(0); PG8_BAR; PG8_MMA(1, 0, At, B0); PG8_MMA(1, 1, At, B1); PG8_BAR; PG8_SCHED;
            PG8_LDB(B0, 1, 0); PG8_LDB(B1, 1, 1); PG8_SCHED; PG8_LDA(At, 1, 0); PG8_STAGE(PG8_SA(0, 1), a2 + hstep, voffA);
            PG8_WAIT_V(8); PG8_WAIT_L(0); PG8_BAR; PG8_MMA(0, 0, At, B0); PG8_MMA(0, 1, At, B1); PG8_BAR; PG8_SCHED;
            PG8_LDA(At, 1, 1); PG8_STAGE(PG8_SB(1, 0), b3, voffB); PG8_STAGE(PG8_SB(1, 1), b3 + hstep, voffB); PG8_STAGE(PG8_SA(1, 0), a3, voffA);
            PG8_WAIT_V(8); PG8_WAIT_L(0); PG8_BAR; PG8_MMA(1, 0, At, B0); PG8_MMA(1, 1, At, B1); PG8_BAR; PG8_SCHED;
            } else {
            PG8_LDB(B0, 0, 0); PG8_SCHED; PG8_LDA(At, 0, 0); PG8_STAGE(PG8_SA(1, 1), a1 + hstep, voffA);
            PG8_WAIT_L(8); PG8_BAR; PG8_WAIT_L(0); PG8_MMA(0, 0, At, B0); PG8_BAR; PG8_SCHED;
            PG8_LDB(B1, 0, 1); PG8_STAGE(PG8_SB(0, 0), b2, voffB);
            PG8_BAR; PG8_WAIT_L(0); PG8_MMA(0, 1, At, B1); PG8_BAR;
            PG8_LDA(At, 0, 1); PG8_STAGE(PG8_SA(0, 0), a2, voffA);
            PG8_BAR; PG8_WAIT_L(0); PG8_MMA(1, 0, At, B0); PG8_BAR; PG8_SCHED;
            PG8_STAGE(PG8_SB(0, 1), b2 + hstep, voffB);
            PG8_WAIT_V(6); PG8_BAR; PG8_MMA(1, 1, At, B1); PG8_BAR;
            PG8_LDB(B0, 1, 0); PG8_SCHED; PG8_LDA(At, 1, 0); PG8_STAGE(PG8_SA(0, 1), a2 + hstep, voffA);
            PG8_WAIT_L(8); PG8_BAR; PG8_WAIT_L(0); PG8_MMA(0, 0, At, B0); PG8_BAR; PG8_SCHED;
            PG8_LDB(B1, 1, 1); PG8_STAGE(PG8_SB(1, 0), b3, voffB);
            PG8_BAR; PG8_WAIT_L(0); PG8_MMA(0, 1, At, B1); PG8_BAR;
            PG8_LDA(At, 1, 1); PG8_STAGE(PG8_SA(1, 0), a3, voffA);
            PG8_BAR; PG8_WAIT_L(0); PG8_MMA(1, 0, At, B0); PG8_BAR; PG8_SCHED;
            PG8_STAGE(PG8_SB(1, 1), b3 + hstep, voffB);
            PG8_WAIT_V(6); PG8_BAR; PG8_MMA(1, 1, At, B1); PG8_BAR;
            }
        }
        if constexpr (ALIGN_EPI) { if (wr == 0) PG8_BAR; }
        if constexpr (!Epi::AFTER_DRAIN) { E(acc, cur, wr, wc, fr, fq, ui); S.done(cur); }
        if (!has_next) break;
#pragma unroll
        for (int a = 0; a < 2; ++a)
#pragma unroll
            for (int b = 0; b < 2; ++b)
#pragma unroll
                for (int m = 0; m < 4; ++m)
#pragma unroll
                    for (int n = 0; n < 2; ++n) acc[a][b][m][n] = acc_t{};
        cur = nxt; cA = nA; cB = nB; ++ui;
        if constexpr (ALIGN_EPI) { if (wr == 1) PG8_BAR; }
    }
    PG8_WAIT_V(0);
    if constexpr (!ALIGN_EPI) { if (wr == 0) PG8_BAR; }
    PG8_BAR;
    if constexpr (Epi::AFTER_DRAIN) { E.fused(acc, cur, wr, wc, fr, fq, lds, wid, lane); S.done(cur); }
#undef PG8_SA
#undef PG8_SB
#undef PG8_STAGE
#undef PG8_LDA
#undef PG8_LDB
#undef PG8_MMA
#undef PG8_WAIT_V
#undef PG8_WAIT_L
#undef PG8_BAR
#undef PG8_SCHED
}
}
namespace pg8 {
struct EpiProj {
    static constexpr bool PERM = true, AFTER_DRAIN = false;
    bf16_t* MIXQ; bf16_t* PROJ2; bf16_t* SVT; bf16_t* RKT; bf16_t* RVT; const PG8_LAS float* rbuf; const float* WMAX; PG8_LAS unsigned char* tbuf;
    template <class AccT> __device__ __forceinline__ void operator()(const AccT (&acc)[2][2][4][2], const Unit& u, int wr, int wc, int fr, int fq, int ui) const {
        int lr0 = wr * 64 + fr, cl0 = wc * 32 + 8 * fq; asm volatile("" : "+v"(lr0), "+v"(cl0));
        const int row0 = u.pm * BM + lr0; const int pn = u.pn;
        const bool rowmajor = !(pn == 4 || pn == 5 || pn == 10 || pn == 11);
        if (rowmajor) { if (pn >= 6 && pn < 10) rows<true>(acc, u, lr0, cl0, ui); else rows<false>(acc, u, lr0, cl0, ui); }
        if (pn == 8 || pn == 9) trans<true>(acc, u, wr, wc, fr, fq, ui); else if (pn == 4 || pn == 5 || pn == 10 || pn == 11) trans<false>(acc, u, wr, wc, fr, fq, ui);
    }
    template <bool ROT, class AccT> __device__ __forceinline__ void rows(const AccT (&acc)[2][2][4][2], const Unit& u, int lr0, int cl0, int ui) const {
        const int row0 = u.pm * BM + lr0; const int pn = u.pn;
        f32x4 wsc[2][2];
#pragma unroll
        for (int bj = 0; bj < 2; ++bj) { const PG8_LAS f32x4* wp = (const PG8_LAS f32x4*)(rbuf + 512 + (ui & 1) * 256 + bj * HALF + cl0); wsc[bj][0] = wp[0]; wsc[bj][1] = wp[1]; }
        const PG8_LAS float* rb = rbuf + (ui & 1) * 256 + lr0;
        float f[4] = {0.f, 0.f, 0.f, 0.f};
        if (ROT) {
#pragma unroll
            for (int jj = 0; jj < 4; ++jj) f[jj] = exp2f(-(float)(2 * ((cl0 >> 1) + jj)) * (13.287712379549449f / 128.0f)) * 0.15915494309189535f;
        }
        const float sc = pn < 2 ? 0.125f * 1.4426950408889634f : ((pn == 8 || pn == 9) ? 0.08838834764831845f : 1.0f);
        const int s0 = row0 & (SEQ - 1);
        const bool toP = (pn >= 2 && pn < 4) || pn >= 8;
        const int dcol = pn < 2 ? pn * 256 : (pn < 4 ? (pn - 2) * 256 : (pn < 8 ? 512 + (pn - 6) * 256 : (pn < 10 ? 512 + (pn - 8) * 256 : 1024 + (pn - 12) * 256)));
        const size_t dstride = toP ? 1536 * 2 : 1024 * 2;
        char* dptr = (char*)MIXQ + (toP ? ((size_t)64 << 20) : (size_t)0) + (size_t)row0 * dstride + (size_t)(dcol + cl0) * 2;
#pragma unroll
        for (int ai = 0; ai < 2; ++ai)
#pragma unroll
            for (int m = 0; m < 4; ++m) {
                const int spos = s0 + ai * HALF + m * 16; const float r = rb[ai * HALF + m * 16] * sc;
                float cs[4] = {1.f, 1.f, 1.f, 1.f}, sn[4] = {0.f, 0.f, 0.f, 0.f};
                if (ROT) {
#pragma unroll
                    for (int jj = 0; jj < 4; ++jj) { const float xr = __builtin_amdgcn_fractf((float)spos * f[jj]); cs[jj] = __builtin_amdgcn_cosf(xr); sn[jj] = __builtin_amdgcn_sinf(xr); }
                }
#pragma unroll
                for (int bj = 0; bj < 2; ++bj) {
                    const f32x4 a = tof(acc[ai][bj][m][0]) * (wsc[bj][0] * r), b = tof(acc[ai][bj][m][1]) * (wsc[bj][1] * r); f32x4 v0 = a, v1 = b;
                    if (ROT) {
                        v0[0] = a[0] * cs[0] - a[1] * sn[0]; v0[1] = a[0] * sn[0] + a[1] * cs[0]; v0[2] = a[2] * cs[1] - a[3] * sn[1]; v0[3] = a[2] * sn[1] + a[3] * cs[1];
                        v1[0] = b[0] * cs[2] - b[1] * sn[2]; v1[1] = b[0] * sn[2] + b[1] * cs[2]; v1[2] = b[2] * cs[3] - b[3] * sn[3]; v1[3] = b[2] * sn[3] + b[3] * cs[3];
                    }
                    u32x4 w; w.x = pk2bf(v0[0], v0[1]); w.y = pk2bf(v0[2], v0[3]); w.z = pk2bf(v1[0], v1[1]); w.w = pk2bf(v1[2], v1[3]);
                    __builtin_nontemporal_store(w, (u32x4*)(dptr + (size_t)(ai * HALF + m * 16) * dstride + bj * (HALF * 2)));
                }
            }
    }
    template <bool isK, class AccT> __device__ __forceinline__ void trans(const AccT (&acc)[2][2][4][2], const Unit& u, int wr, int wc, int fr, int fq, int ui) const {
        int lr0 = wr * 64 + fr, lane = fq * 16 + fr, cl0 = wc * 32 + 8 * fq; asm volatile("" : "+v"(lr0), "+v"(lane), "+v"(cl0));
        const int pn = u.pn; const bool isSV = (pn < 8); const float sc = isK ? 0.08838834764831845f : 1.0f;
        const int row0 = u.pm * BM + lr0, bb = row0 >> 11, s0 = row0 & (SEQ - 1), sw = (u.pm * BM + wr * 64) & (SEQ - 1);
        const PG8_LAS float* rb = rbuf + (ui & 1) * 256 + lr0;
        PG8_LAS unsigned char* tb = tbuf + (wr * 4 + wc) * 1152;
        PG8_LAS unsigned char* tw = tb + (2 * fq) * 144 + fr * 2;
        const PG8_LAS unsigned char* tr = tb + (lane >> 3) * 144 + (lane & 7) * 16;
        const int rr = lane >> 3;
        const PG8_LAS float* cb = rbuf + 512 + (ui & 1) * 256 + cl0;
#pragma unroll
        for (int ai = 0; ai < 2; ++ai)
#pragma unroll
            for (int bj = 0; bj < 2; ++bj) {
                const int hd = (pn & 1) * 2 + bj;
                bf16_t* M; int rowbase;
                M = (bf16_t*)((char*)SVT + (isSV ? (size_t)0 : (isK ? ((size_t)64 << 20) : ((size_t)32 << 20))));
                if (isSV) rowbase = (bb * 8 + (pn - 4) * 4 + bj * 2 + (wc >> 1)) * 64 + (wc & 1) * 32;
                else rowbase = (bb * 4 + hd) * 128 + wc * 32;
                float z[4] = {1.f, 1.f, 1.f, 1.f}, rs[4];
                const float lg = log2f(1.0f - exp2f(-5.0f - (float)hd));
#pragma unroll
                for (int m = 0; m < 4; ++m) { rs[m] = rb[ai * HALF + m * 16] * sc; if (isK) z[m] = exp2f((float)(127 - ((s0 + ai * HALF + m * 16) & 127)) * lg); }
#pragma unroll
                for (int n = 0; n < 2; ++n)
#pragma unroll
                    for (int ch = 0; ch < 2; ++ch) {
                        const f32x2 wv = *(const PG8_LAS f32x2*)(cb + bj * HALF + 4 * n + 2 * ch); const float w0 = wv[0], w1 = wv[1];
                        const float fj = isK ? exp2f(-(float)(2 * ((cl0 >> 1) + 2 * n + ch)) * (13.287712379549449f / 128.0f)) * 0.15915494309189535f : 0.f;
#pragma unroll
                        for (int m = 0; m < 4; ++m) {
                            const f32x4 av = tof(acc[ai][bj][m][n]);
                            float x0 = av[2 * ch] * w0 * rs[m], x1 = av[2 * ch + 1] * w1 * rs[m];
                            if (isK) { const float xr = __builtin_amdgcn_fractf((float)(s0 + ai * HALF + m * 16) * fj); const float cs = __builtin_amdgcn_cosf(xr), sn = __builtin_amdgcn_sinf(xr);
                                const float y0 = x0 * cs - x1 * sn, y1 = x0 * sn + x1 * cs; x0 = y0 * z[m]; x1 = y1 * z[m]; }
                            const unsigned w = pk2bf(x0, x1);
                            *(PG8_LAS unsigned short*)(tw + m * 32) = (unsigned short)w; *(PG8_LAS unsigned short*)(tw + 144 + m * 32) = (unsigned short)(w >> 16);
                        }
                        const u32x4 v = *(const PG8_LAS u32x4*)tr;
                        __builtin_nontemporal_store(v, (u32x4*)(M + (size_t)(rowbase + 8 * (rr >> 1) + 4 * n + 2 * ch + (rr & 1)) * SEQ + sw + ai * HALF + 8 * (lane & 7)));
                        asm volatile("" ::: "memory");
                    }
            }
    }
};
template <bool SRC_F32> struct EpiResid {
    static constexpr bool PERM = true, AFTER_DRAIN = false;
    const float* srcf; bf16_t* XB; float* SSQ;
    struct f32x8 { f32x4 a, b; };
    typedef typename std::conditional<SRC_F32, f32x8, u32x4>::type res_t;
    __device__ __forceinline__ res_t ld(size_t off) const { if constexpr (SRC_F32) { f32x8 r; r.a = *(const f32x4*)(srcf + off); r.b = *(const f32x4*)(srcf + off + 4); return r; } else return *(const u32x4*)(XB + off); }
    __device__ __forceinline__ void operator()(const f32x4 (&acc)[2][2][4][2], const Unit& u, int wr, int wc, int fr, int fq, int ui) const {
        const int row0 = u.pm * BM + wr * 64 + fr; const int col0 = u.pn * BM + wc * 32 + 8 * fq;
        constexpr int MB = SRC_F32 ? 2 : 4;
#pragma unroll
        for (int b0 = 0; b0 < 8; b0 += MB) {
            res_t rs[MB][2];
#pragma unroll
            for (int mm = 0; mm < MB; ++mm)
#pragma unroll
                for (int bj = 0; bj < 2; ++bj) rs[mm][bj] = ld((size_t)(row0 + ((b0 + mm) >> 2) * HALF + ((b0 + mm) & 3) * 16) * 1024 + col0 + bj * HALF);
#pragma unroll
            for (int mm = 0; mm < MB; ++mm) {
                const int ai = (b0 + mm) >> 2, m = (b0 + mm) & 3;
                const int row = row0 + ai * HALF + m * 16; float ss = 0.f;
#pragma unroll
                for (int bj = 0; bj < 2; ++bj) {
                    const size_t off = (size_t)row * 1024 + col0 + bj * HALF;
                    f32x4 o0, o1;
                    if constexpr (SRC_F32) { o0 = rs[mm][bj].a; o1 = rs[mm][bj].b; }
                    else { const u32x4 w = rs[mm][bj]; o0[0] = __uint_as_float(w.x << 16); o0[1] = __uint_as_float(w.x & 0xFFFF0000u); o0[2] = __uint_as_float(w.y << 16); o0[3] = __uint_as_float(w.y & 0xFFFF0000u);
                        o1[0] = __uint_as_float(w.z << 16); o1[1] = __uint_as_float(w.z & 0xFFFF0000u); o1[2] = __uint_as_float(w.w << 16); o1[3] = __uint_as_float(w.w & 0xFFFF0000u); }
                    o0 = o0 + acc[ai][bj][m][0]; o1 = o1 + acc[ai][bj][m][1];
                    u32x4 w; w.x = pk2bf(o0[0], o0[1]); w.y = pk2bf(o0[2], o0[3]); w.z = pk2bf(o1[0], o1[1]); w.w = pk2bf(o1[2], o1[3]); *(u32x4*)(XB + off) = w;
                    const float r0 = __uint_as_float(w.x << 16), r1 = __uint_as_float(w.x & 0xFFFF0000u), r2 = __uint_as_float(w.y << 16), r3 = __uint_as_float(w.y & 0xFFFF0000u);
                    const float r4 = __uint_as_float(w.z << 16), r5 = __uint_as_float(w.z & 0xFFFF0000u), r6 = __uint_as_float(w.w << 16), r7 = __uint_as_float(w.w & 0xFFFF0000u);
                    ss += ((r0 * r0 + r1 * r1) + (r2 * r2 + r3 * r3)) + ((r4 * r4 + r5 * r5) + (r6 * r6 + r7 * r7));
                }
                ss = xor16_sum(ss); ss = xor32_sum(ss);
                if (fq == 0) SSQ[(size_t)row * 16 + u.pn * 4 + wc] = ss;
            }
            asm volatile("" ::: "memory");
        }
    }
};
template <bool F16> struct EpiScale {
    static constexpr bool PERM = true, AFTER_DRAIN = false;
    bf16_t* O; int ldc; const PG8_LAS float* rbuf; float scale;
    __device__ __forceinline__ void operator()(const f32x4 (&acc)[2][2][4][2], const Unit& u, int wr, int wc, int fr, int fq, int ui) const {
        const int lr0 = wr * 64 + fr, row0 = u.pm * BM + lr0; const int col0 = u.pn * BM + wc * 32 + 8 * fq;
        const PG8_LAS float* rb = rbuf + (ui & 1) * 256 + lr0;
#pragma unroll
        for (int ai = 0; ai < 2; ++ai)
#pragma unroll
            for (int m = 0; m < 4; ++m) {
                const int row = row0 + ai * HALF + m * 16; const float r = rb[ai * HALF + m * 16] * scale;
#pragma unroll
                for (int bj = 0; bj < 2; ++bj) {
                    const f32x4 v0 = acc[ai][bj][m][0] * r, v1 = acc[ai][bj][m][1] * r; u32x4 w;
                    if (F16) { w.x = (unsigned)f2h(v0[0]) | ((unsigned)f2h(v0[1]) << 16); w.y = (unsigned)f2h(v0[2]) | ((unsigned)f2h(v0[3]) << 16); w.z = (unsigned)f2h(v1[0]) | ((unsigned)f2h(v1[1]) << 16); w.w = (unsigned)f2h(v1[2]) | ((unsigned)f2h(v1[3]) << 16); }
                    else { w.x = pk2bf(v0[0], v0[1]); w.y = pk2bf(v0[2], v0[3]); w.z = pk2bf(v1[0], v1[1]); w.w = pk2bf(v1[2], v1[3]); }
                    *(u32x4*)(O + (size_t)row * ldc + col0 + bj * HALF) = w;
                }
            }
    }
};
}
namespace pg8 {
struct EpiKV {
    static constexpr bool PERM = true, AFTER_DRAIN = false;
    bf16_t* KVl; bf16_t* VTl; const PG8_LAS float* rbuf;
    __device__ __forceinline__ void operator()(const f32x4 (&acc)[2][2][4][2], const Unit& u, int wr, int wc, int fr, int fq, int ui) const {
        int lr0 = wr * 64 + fr; int cl0 = wc * 32 + 8 * fq; asm volatile("" : "+v"(lr0), "+v"(cl0));
        const int row0 = u.pm * BM + lr0;
        const PG8_LAS float* rb = rbuf + (ui & 1) * 256 + lr0;
#pragma unroll
        for (int ai = 0; ai < 2; ++ai)
#pragma unroll
            for (int m = 0; m < 4; ++m) {
                const int lr = lr0 + ai * HALF + m * 16; const float r = rb[ai * HALF + m * 16];
#pragma unroll
                for (int bj = 0; bj < 2; ++bj) {
                    const f32x4 v0 = acc[ai][bj][m][0] * r, v1 = acc[ai][bj][m][1] * r;
                    if (u.pn < 4) { u32x4 w; w.x = pk2bf(v0[0], v0[1]); w.y = pk2bf(v0[2], v0[3]); w.z = pk2bf(v1[0], v1[1]); w.w = pk2bf(v1[2], v1[3]);
                        *(u32x4*)(KVl + (size_t)(row0 + ai * HALF + m * 16) * 2048 + u.pn * BM + cl0 + bj * HALF) = w; }
                    else { bf16_t* vt = VTl + ((size_t)(u.pm * 4 + (u.pn - 4)) * 256 + cl0 + bj * HALF) * 256 + lr;
                        vt[0 * 256] = f2bf(v0[0]); vt[1 * 256] = f2bf(v0[1]); vt[2 * 256] = f2bf(v0[2]); vt[3 * 256] = f2bf(v0[3]);
                        vt[4 * 256] = f2bf(v1[0]); vt[5 * 256] = f2bf(v1[1]); vt[6 * 256] = f2bf(v1[2]); vt[7 * 256] = f2bf(v1[3]); }
                }
            }
    }
};
struct EpiMin {
    static constexpr bool PERM = true, AFTER_DRAIN = false;
    bf16_t* O;
    __device__ __forceinline__ void operator()(const f32x4 (&acc)[2][2][4][2], const Unit& u, int wr, int wc, int fr, int fq, int ui) const {
        f32x4 t = acc[0][0][0][0];
#pragma unroll
        for (int ai = 0; ai < 2; ++ai)
#pragma unroll
            for (int bj = 0; bj < 2; ++bj)
#pragma unroll
                for (int m = 0; m < 4; ++m)
#pragma unroll
                    for (int n = 0; n < 2; ++n) t = t + acc[ai][bj][m][n];
        *(f32x4*)(O + ((size_t)(u.pm * BM + wr * 64 + fr) * 1024 + u.pn * BM + wc * 32 + 8 * fq)) = t;
    }
};
}
__device__ __forceinline__ int win_colmap(int n) { if (n < 1536 || n >= 2560) return n; const int hb = n & ~127, j = n & 127; return hb + (j >> 1) + 64 * (j & 1); }
__device__ __forceinline__ void tr_item(const float* __restrict__ W, int K, int N, const float* __restrict__ g, bool perm, bf16_t* __restrict__ WT, float* scr, int item, int lane) {
    const int nblk = N / 32, kb = item / nblk, nb = item % nblk, k0 = 64 * kb, n0 = 32 * nb;
    const int nn = n0 + (lane & 31); const int ns = perm ? win_colmap(nn) : nn;
#pragma unroll 8
    for (int i = 0; i < 32; ++i) { const int kk = 2 * i + (lane >> 5); const float gg = g ? g[k0 + kk] : 1.0f; scr[kk * 33 + (lane & 31)] = W[(size_t)(k0 + kk) * N + ns] * gg; }
    asm volatile("s_waitcnt lgkmcnt(0)" ::: "memory");
    const int c = lane & 7;
#pragma unroll
    for (int j = 0; j < 4; ++j) { const int n = (lane >> 3) + 8 * j; const float* s = scr + (8 * c) * 33 + n;
        uint4 o; o.x = pk2bf(s[0 * 33], s[1 * 33]); o.y = pk2bf(s[2 * 33], s[3 * 33]); o.z = pk2bf(s[4 * 33], s[5 * 33]); o.w = pk2bf(s[6 * 33], s[7 * 33]);
        *(uint4*)(WT + (size_t)(n0 + n) * K + k0 + 8 * c) = o; }
    asm volatile("s_waitcnt lgkmcnt(0)" ::: "memory");
}
__device__ __forceinline__ void wmax_item(const float* __restrict__ W, int K, int N, const float* __restrict__ g, float* WMAXl, int item, int lane) {
    const int nblk = N / 32, kb = item / nblk, nb = item % nblk, k0 = 64 * kb, n0 = 32 * nb;
    const int nn = n0 + (lane & 31); const int ns = win_colmap(nn);
    float mx = 0.f;
#pragma unroll 8
    for (int i = 0; i < 32; ++i) { const int kk = 2 * i + (lane >> 5); mx = fmaxf(mx, fabsf(W[(size_t)(k0 + kk) * N + ns] * g[k0 + kk])); }
    mx = xor32_max(mx);
    if (lane < 32) atomicMax((unsigned*)WMAXl + nn, __float_as_uint(mx));
}
__device__ __forceinline__ void tr_item_i8(const float* __restrict__ W, int K, int N, const float* __restrict__ g, unsigned char* __restrict__ WQ, const float* __restrict__ WMAXl, float* __restrict__ WS127l, float* scr, int item, int lane) {
    const int nblk = N / 32, kb = item / nblk, nb = item % nblk, k0 = 64 * kb, n0 = 32 * nb;
    const int nn = n0 + (lane & 31); const int ns = win_colmap(nn);
    const float wm = WMAXl[nn]; const float qs = wm > 0.f ? 127.0f / wm : 0.f;
    if (kb == 0 && lane < 32) WS127l[nn] = wm * (1.0f / 127.0f);
#pragma unroll 8
    for (int i = 0; i < 32; ++i) { const int kk = 2 * i + (lane >> 5); scr[kk * 33 + (lane & 31)] = W[(size_t)(k0 + kk) * N + ns] * g[k0 + kk] * qs; }
    asm volatile("s_waitcnt lgkmcnt(0)" ::: "memory");
    const int c = lane & 3;
#pragma unroll
    for (int j = 0; j < 2; ++j) { const int n = (lane >> 2) + 16 * j; const float* sp = scr + (16 * c) * 33 + n; unsigned w[4];
#pragma unroll
        for (int d = 0; d < 4; ++d) w[d] = ((unsigned)(int)rintf(sp[(4 * d) * 33]) & 0xFFu) | (((unsigned)(int)rintf(sp[(4 * d + 1) * 33]) & 0xFFu) << 8) | (((unsigned)(int)rintf(sp[(4 * d + 2) * 33]) & 0xFFu) << 16) | (((unsigned)(int)rintf(sp[(4 * d + 3) * 33]) & 0xFFu) << 24);
        uint4 o; o.x = w[0]; o.y = w[1]; o.z = w[2]; o.w = w[3];
        *(uint4*)(WQ + (size_t)(n0 + n) * K + k0 + 16 * c) = o; }
    asm volatile("s_waitcnt lgkmcnt(0)" ::: "memory");
}
__device__ __forceinline__ void row_to_i8_ssq(const float* __restrict__ xrow, unsigned char* __restrict__ qrow, float* __restrict__ xs, float* __restrict__ ssq, int lane) {
    float4 v[4]; float s = 0.f, mx = 0.f;
#pragma unroll
    for (int i = 0; i < 4; ++i) { v[i] = ((const float4*)xrow)[lane + 64 * i]; s += (v[i].x * v[i].x + v[i].y * v[i].y) + (v[i].z * v[i].z + v[i].w * v[i].w); mx = fmaxf(mx, fmaxf(fmaxf(fabsf(v[i].x), fabsf(v[i].y)), fmaxf(fabsf(v[i].z), fabsf(v[i].w)))); }
    s = wave_sum(s); mx = wave_max(mx);
    const float sc = mx > 0.f ? 127.0f / mx : 1.0f;
#pragma unroll
    for (int i = 0; i < 4; ++i) ((unsigned*)qrow)[lane + 64 * i] = ((unsigned)(int)rintf(v[i].x * sc) & 0xFFu) | (((unsigned)(int)rintf(v[i].y * sc) & 0xFFu) << 8) | (((unsigned)(int)rintf(v[i].z * sc) & 0xFFu) << 16) | (((unsigned)(int)rintf(v[i].w * sc) & 0xFFu) << 24);
    if (lane < 16) ssq[lane] = lane == 0 ? s : 0.f;
    if (lane == 0) xs[0] = mx > 0.f ? mx * (1.0f / 127.0f) : 1.0f;
}
__device__ __forceinline__ void rowbf_to_i8(const bf16_t* __restrict__ xrow, unsigned char* __restrict__ qrow, float* __restrict__ xs, int lane) {
    float4 v[4]; float mx = 0.f;
#pragma unroll
    for (int i = 0; i < 4; ++i) { const uint2 w = ((const uint2*)xrow)[lane + 64 * i]; v[i].x = __uint_as_float(w.x << 16); v[i].y = __uint_as_float(w.x & 0xFFFF0000u); v[i].z = __uint_as_float(w.y << 16); v[i].w = __uint_as_float(w.y & 0xFFFF0000u);
        mx = fmaxf(mx, fmaxf(fmaxf(fabsf(v[i].x), fabsf(v[i].y)), fmaxf(fabsf(v[i].z), fabsf(v[i].w)))); }
    mx = wave_max(mx);
    const float sc = mx > 0.f ? 127.0f / mx : 1.0f;
#pragma unroll
    for (int i = 0; i < 4; ++i) ((unsigned*)qrow)[lane + 64 * i] = ((unsigned)(int)rintf(v[i].x * sc) & 0xFFu) | (((unsigned)(int)rintf(v[i].y * sc) & 0xFFu) << 8) | (((unsigned)(int)rintf(v[i].z * sc) & 0xFFu) << 16) | (((unsigned)(int)rintf(v[i].w * sc) & 0xFFu) << 24);
    if (lane == 0) xs[0] = mx > 0.f ? mx * (1.0f / 127.0f) : 1.0f;
}
__device__ __forceinline__ void peer_fold_item(const float* __restrict__ wpq, const float* __restrict__ keys, const float* __restrict__ g, bf16_t* __restrict__ WPT, float* scr, int item, const int tid) {
    const int hp = item >> 4, k0 = (item & 15) * 64;
    float* ws_ = scr;
    float* ks_ = scr + 64 * 132;
    for (int i = tid; i < 64 * 32; i += 512) { const int kk = i >> 5, d4 = (i & 31) * 4; const float4 v = *(const float4*)(wpq + (size_t)(k0 + kk) * 2048 + hp * 128 + d4); const float gg = g[k0 + kk];
        float* o = ws_ + kk * 132 + d4; o[0] = v.x * gg; o[1] = v.y * gg; o[2] = v.z * gg; o[3] = v.w * gg; }
    for (int i = tid; i < 128 * 32; i += 512) { const int ky = i >> 5, d4 = (i & 31) * 4; const float4 v = *(const float4*)(keys + ((size_t)hp * 128 + ky) * 128 + d4);
        float* o = ks_ + ky * 132 + d4; o[0] = v.x; o[1] = v.y; o[2] = v.z; o[3] = v.w; }
    __syncthreads();
    const int key = tid & 127, kg = tid >> 7;
    float acc[16];
#pragma unroll
    for (int j = 0; j < 16; ++j) acc[j] = 0.f;
    for (int d = 0; d < 128; d += 4) {
        const float4 kv = *(const float4*)(ks_ + key * 132 + d);
#pragma unroll
        for (int j = 0; j < 16; ++j) { const float4 wv = *(const float4*)(ws_ + (kg * 16 + j) * 132 + d); acc[j] += kv.x * wv.x + kv.y * wv.y + kv.z * wv.z + kv.w * wv.w; }
    }
    uint4 o0, o1;
    o0.x = pk2bf(acc[0], acc[1]); o0.y = pk2bf(acc[2], acc[3]); o0.z = pk2bf(acc[4], acc[5]); o0.w = pk2bf(acc[6], acc[7]);
    o1.x = pk2bf(acc[8], acc[9]); o1.y = pk2bf(acc[10], acc[11]); o1.z = pk2bf(acc[12], acc[13]); o1.w = pk2bf(acc[14], acc[15]);
    uint4* dst = (uint4*)(WPT + (size_t)(hp * 128 + key) * 1024 + k0 + kg * 16);
    dst[0] = o0; dst[1] = o1;
    __syncthreads();
}
__device__ __forceinline__ void row_to_bf16_ssq(const float* __restrict__ xrow, bf16_t* __restrict__ orow, float* __restrict__ ssq, int lane) {
    const float4* xr = (const float4*)xrow; float s = 0.f;
#pragma unroll
    for (int i = 0; i < 4; ++i) { const float4 v = xr[lane + 64 * i]; s += (v.x * v.x + v.y * v.y) + (v.z * v.z + v.w * v.w);
        uint2 w; w.x = pk2bf(v.x, v.y); w.y = pk2bf(v.z, v.w); ((uint2*)orow)[lane + 64 * i] = w; }
    s = wave_sum(s);
    if (lane < 16) ssq[lane] = lane == 0 ? s : 0.f;
}
constexpr int NEXP = 16384;
__device__ __forceinline__ void table_row_from_regs(const float4 a0, const float4 a1, const float4 a2, const float4 a3, const float* __restrict__ g, unsigned char* __restrict__ T8, float* __restrict__ isc, int e, int lane) {
    const float4 av[4] = {a0, a1, a2, a3};
    float v[16]; float mx = 0.f;
#pragma unroll
    for (int i = 0; i < 4; ++i) { const float4 gg = g ? ((const float4*)g)[lane * 4 + i] : make_float4(1.f, 1.f, 1.f, 1.f);
        v[4 * i] = av[i].x * gg.x; v[4 * i + 1] = av[i].y * gg.y; v[4 * i + 2] = av[i].z * gg.z; v[4 * i + 3] = av[i].w * gg.w;
        mx = fmaxf(mx, fmaxf(fmaxf(fabsf(v[4 * i]), fabsf(v[4 * i + 1])), fmaxf(fabsf(v[4 * i + 2]), fabsf(v[4 * i + 3])))); }
    mx = wave_max(mx);
    const float sc = mx > 0.f ? 127.0f / mx : 1.0f;
    unsigned w[4];
#pragma unroll
    for (int i = 0; i < 4; ++i) w[i] = ((unsigned)(int)rintf(v[4 * i] * sc) & 0xFFu) | (((unsigned)(int)rintf(v[4 * i + 1] * sc) & 0xFFu) << 8) | (((unsigned)(int)rintf(v[4 * i + 2] * sc) & 0xFFu) << 16) | (((unsigned)(int)rintf(v[4 * i + 3] * sc) & 0xFFu) << 24);
    uint4 o; o.x = w[0]; o.y = w[1]; o.z = w[2]; o.w = w[3];
    nt_st16(T8 + ((size_t)(lane >> 3) * NEXP + e) * 128 + (lane & 7) * 16, o);
    if (lane == 0) isc[e] = mx > 0.f ? mx * (1.0f / 127.0f) : 1.0f;
}
__device__ __forceinline__ void table_rows_run(const float* __restrict__ peer_u, const float* __restrict__ peer_v, const float* __restrict__ peer_norm, unsigned char* __restrict__ T8, float* __restrict__ ISC, int l, int r0, int cnt, int lane) {
    if (cnt <= 0) return;
    float4 a0, a1, a2, a3, b0, b1, b2, b3, c0, c1, c2, c3, d0, d1, d2, d3;
#define TR_PTR(r_) (((((r_) >> 14) ? peer_v : peer_u)) + ((size_t)l * NEXP + ((r_) & (NEXP - 1))) * DM)
#define TR_LOAD(X_, r_) do { const float4* p_ = (const float4*)TR_PTR(r_) + lane * 4; X_##0 = p_[0]; X_##1 = p_[1]; X_##2 = p_[2]; X_##3 = p_[3]; } while (0)
#define TR_PROC(X_, r_) do { const int tab_ = (r_) >> 14, lt_ = l * 2 + tab_; table_row_from_regs(X_##0, X_##1, X_##2, X_##3, tab_ ? nullptr : peer_norm + l * DM, T8 + (size_t)lt_ * 8 * NEXP * 128, ISC + (size_t)lt_ * NEXP, (r_) & (NEXP - 1), lane); } while (0)
    TR_LOAD(a, r0); TR_LOAD(b, r0 + 1); TR_LOAD(c, r0 + 2); TR_LOAD(d, r0 + 3);
#pragma unroll 1
    for (int i = 0; i < cnt; i += 4) {
        const int r = r0 + i; const bool more = i + 4 < cnt;
        TR_PROC(a, r);     if (more) TR_LOAD(a, r + 4);
        TR_PROC(b, r + 1); if (more) TR_LOAD(b, r + 5);
        TR_PROC(c, r + 2); if (more) TR_LOAD(c, r + 6);
        TR_PROC(d, r + 3); if (more) TR_LOAD(d, r + 7);
    }
#undef TR_PTR
#undef TR_LOAD
#undef TR_PROC
}
__device__ __forceinline__ void d_rmsnorm_final(const int vb, const int vtid, const bf16_t* __restrict__ XB, float* __restrict__ out, const float* __restrict__ g) {
    const int row = vb * 4 + (vtid >> 6), lane = vtid & 63;
    const uint2* xr = (const uint2*)(XB + (size_t)row * DM);
    float4 v[4]; float s = 0.f;
#pragma unroll
    for (int i = 0; i < 4; ++i) { const uint2 w = xr[lane + 64 * i]; v[i].x = __uint_as_float(w.x << 16); v[i].y = __uint_as_float(w.x & 0xFFFF0000u); v[i].z = __uint_as_float(w.y << 16); v[i].w = __uint_as_float(w.y & 0xFFFF0000u);
        s += v[i].x * v[i].x + v[i].y * v[i].y + v[i].z * v[i].z + v[i].w * v[i].w; }
    s = wave_sum(s);
    const float r = rsqrtf(s * (1.0f / DM) + EPS);
#pragma unroll
    for (int i = 0; i < 4; ++i) { const float4 gg = ((const float4*)g)[lane + 64 * i];
        float4 y; y.x = v[i].x * r * gg.x; y.y = v[i].y * r * gg.y; y.z = v[i].z * r * gg.z; y.w = v[i].w * r * gg.w; { uint4 yu; yu.x = __float_as_uint(y.x); yu.y = __float_as_uint(y.y); yu.z = __float_as_uint(y.z); yu.w = __float_as_uint(y.w); nt_st16((float4*)(out + (size_t)row * DM) + lane + 64 * i, yu); } }
}
typedef float f32x2 __attribute__((ext_vector_type(2)));
template <int CTRL> __device__ __forceinline__ float dpp_f(float v) { return __builtin_bit_cast(float, __builtin_amdgcn_update_dpp(0, __builtin_bit_cast(int, v), CTRL, 0xF, 0xF, false)); }
template <int CTRL> __device__ __forceinline__ unsigned dpp_u(unsigned v) { return (unsigned)__builtin_amdgcn_update_dpp(0, (int)v, CTRL, 0xF, 0xF, false); }
typedef unsigned u32x4nt __attribute__((ext_vector_type(4))); typedef int i32x4nt __attribute__((ext_vector_type(4)));
__device__ __forceinline__ uint4 nt_ld16(const void* p) { const u32x4nt v = __builtin_nontemporal_load((const u32x4nt*)p); uint4 r; r.x = v[0]; r.y = v[1]; r.z = v[2]; r.w = v[3]; return r; }
__device__ __forceinline__ int4 nt_ld16i(const void* p) { const i32x4nt v = __builtin_nontemporal_load((const i32x4nt*)p); int4 r; r.x = v[0]; r.y = v[1]; r.z = v[2]; r.w = v[3]; return r; }
__device__ __forceinline__ void table_row_to_i8(const float* __restrict__ row, const float* __restrict__ g, unsigned char* __restrict__ T8, float* __restrict__ isc, int e, int lane) {
    float v[16]; float mx = 0.f;
#pragma unroll
    for (int i = 0; i < 4; ++i) { const float4 a = ((const float4*)row)[lane * 4 + i]; const float4 gg = g ? ((const float4*)g)[lane * 4 + i] : make_float4(1.f, 1.f, 1.f, 1.f);
        v[4 * i] = a.x * gg.x; v[4 * i + 1] = a.y * gg.y; v[4 * i + 2] = a.z * gg.z; v[4 * i + 3] = a.w * gg.w;
        mx = fmaxf(mx, fmaxf(fmaxf(fabsf(v[4 * i]), fabsf(v[4 * i + 1])), fmaxf(fabsf(v[4 * i + 2]), fabsf(v[4 * i + 3])))); }
    mx = wave_max(mx);
    const float sc = mx > 0.f ? 127.0f / mx : 1.0f;
    unsigned w[4];
#pragma unroll
    for (int i = 0; i < 4; ++i) w[i] = ((unsigned)(int)rintf(v[4 * i] * sc) & 0xFFu) | (((unsigned)(int)rintf(v[4 * i + 1] * sc) & 0xFFu) << 8) | (((unsigned)(int)rintf(v[4 * i + 2] * sc) & 0xFFu) << 16) | (((unsigned)(int)rintf(v[4 * i + 3] * sc) & 0xFFu) << 24);
    uint4 o; o.x = w[0]; o.y = w[1]; o.z = w[2]; o.w = w[3];
    nt_st16(T8 + ((size_t)(lane >> 3) * NEXP + e) * 128 + (lane & 7) * 16, o);
    if (lane == 0) isc[e] = mx > 0.f ? mx * (1.0f / 127.0f) : 1.0f;
}
__device__ __forceinline__ void table_row_to_fp8(const float* __restrict__ row, const float* __restrict__ g, unsigned char* __restrict__ T8, float* __restrict__ isc, int e, int lane) {
    float v[16]; float mx = 0.f;
#pragma unroll
    for (int i = 0; i < 4; ++i) { const float4 a = ((const float4*)row)[lane * 4 + i]; float4 gg = make_float4(1.f, 1.f, 1.f, 1.f); if (g) gg = ((const float4*)g)[lane * 4 + i];
        v[4 * i] = a.x * gg.x; v[4 * i + 1] = a.y * gg.y; v[4 * i + 2] = a.z * gg.z; v[4 * i + 3] = a.w * gg.w;
        mx = fmaxf(mx, fmaxf(fmaxf(fabsf(v[4 * i]), fabsf(v[4 * i + 1])), fmaxf(fabsf(v[4 * i + 2]), fabsf(v[4 * i + 3])))); }
    mx = wave_max(mx);
    const float sc = mx > 0.f ? 224.0f / mx : 1.0f;
    uint4 o; unsigned w[4];
#pragma unroll
    for (int i = 0; i < 4; ++i) { int p = __builtin_amdgcn_cvt_pk_fp8_f32(v[4 * i] * sc, v[4 * i + 1] * sc, 0, false); p = __builtin_amdgcn_cvt_pk_fp8_f32(v[4 * i + 2] * sc, v[4 * i + 3] * sc, p, true); w[i] = (unsigned)p; }
    o.x = w[0]; o.y = w[1]; o.z = w[2]; o.w = w[3];
    nt_st16(T8 + ((size_t)(lane >> 3) * NEXP + e) * 128 + (lane & 7) * 16, o);
    if (lane == 0) isc[e] = mx > 0.f ? mx * (1.0f / 224.0f) : 1.0f;
}

#define PK_CE(a, b) { const unsigned t_ = (a) > (b) ? (a) : (b); b = (a) > (b) ? (b) : (a); a = t_; }
__device__ __forceinline__ void sort16_desc(unsigned (&v)[16]) {
    PK_CE(v[0], v[13]) PK_CE(v[1], v[12]) PK_CE(v[2], v[15]) PK_CE(v[3], v[14]) PK_CE(v[4], v[8]) PK_CE(v[5], v[6]) PK_CE(v[7], v[11]) PK_CE(v[9], v[10])
    PK_CE(v[0], v[5]) PK_CE(v[1], v[7]) PK_CE(v[2], v[9]) PK_CE(v[3], v[4]) PK_CE(v[6], v[13]) PK_CE(v[8], v[14]) PK_CE(v[10], v[15]) PK_CE(v[11], v[12])
    PK_CE(v[0], v[1]) PK_CE(v[2], v[3]) PK_CE(v[4], v[5]) PK_CE(v[6], v[8]) PK_CE(v[7], v[9]) PK_CE(v[10], v[11]) PK_CE(v[12], v[13]) PK_CE(v[14], v[15])
    PK_CE(v[0], v[2]) PK_CE(v[1], v[3]) PK_CE(v[4], v[10]) PK_CE(v[5], v[11]) PK_CE(v[6], v[7]) PK_CE(v[8], v[9]) PK_CE(v[12], v[14]) PK_CE(v[13], v[15])
    PK_CE(v[1], v[2]) PK_CE(v[3], v[12]) PK_CE(v[4], v[6]) PK_CE(v[5], v[7]) PK_CE(v[8], v[10]) PK_CE(v[9], v[11]) PK_CE(v[13], v[14])
    PK_CE(v[1], v[4]) PK_CE(v[2], v[6]) PK_CE(v[5], v[8]) PK_CE(v[7], v[10]) PK_CE(v[9], v[13]) PK_CE(v[11], v[14])
    PK_CE(v[2], v[4]) PK_CE(v[3], v[6]) PK_CE(v[9], v[12]) PK_CE(v[11], v[13])
    PK_CE(v[3], v[5]) PK_CE(v[6], v[8]) PK_CE(v[7], v[9]) PK_CE(v[10], v[12])
    PK_CE(v[3], v[4]) PK_CE(v[5], v[6]) PK_CE(v[7], v[8]) PK_CE(v[9], v[10]) PK_CE(v[11], v[12])
    PK_CE(v[6], v[7]) PK_CE(v[8], v[9])
}
__device__ __forceinline__ void merge16_desc(unsigned (&R)[16], const unsigned (&N)[16]) {
#pragma unroll
    for (int i = 0; i < 16; ++i) R[i] = R[i] > N[15 - i] ? R[i] : N[15 - i];
#pragma unroll
    for (int j = 8; j > 0; j >>= 1)
#pragma unroll
        for (int i = 0; i < 16; ++i) { const int l = i ^ j; if (l > i) PK_CE(R[i], R[l]) }
}
__device__ __forceinline__ void peer_topk_fast(const bf16_t* __restrict__ SC, int* __restrict__ IDX, float* __restrict__ GATE, int t, int hp) {
    const uint4* src = (const uint4*)(SC + (size_t)t * 2048 + hp * 128);
    unsigned R[16];
#pragma unroll
    for (int g = 0; g < 8; ++g) {
        const uint4 a = src[2 * g], b = src[2 * g + 1]; const unsigned dw[8] = {a.x, a.y, a.z, a.w, b.x, b.y, b.z, b.w};
        unsigned N[16];
#pragma unroll
        for (int k = 0; k < 8; ++k) { const unsigned w = dw[k]; const unsigned m = ((w >> 15) & 0x00010001u) * 0x7FFFu; const unsigned u = w ^ (m | 0x80008000u);
            N[2 * k] = (u << 16) | (unsigned)(127 - (g * 16 + 2 * k)); N[2 * k + 1] = (u & 0xFFFF0000u) | (unsigned)(127 - (g * 16 + 2 * k + 1)); }
        sort16_desc(N);
        if (g == 0) {
#pragma unroll
            for (int i = 0; i < 16; ++i) R[i] = N[i];
        } else merge16_desc(R, N);
    }
    const int p = hp & 1;
    unsigned F[16];
#pragma unroll
    for (int r = 0; r < 16; ++r) {
        const unsigned u = R[r] >> 16; const unsigned hb = (u & 0x8000u) ? (u & 0x7FFFu) : (~u & 0xFFFFu);
        const float s = h2f((unsigned short)hb); const int id = 127 - (int)(R[r] & 127u);
        int f = (int)rintf(s * 4096.0f); f = f < -65535 ? -65535 : (f > 65535 ? 65535 : f);
        F[r] = p ? (unsigned)(f * 16384 + id) : (((unsigned)(f + 131072) << 14) + ((unsigned)id << 7));
    }
    unsigned F0[16], F1[16];
#pragma unroll
    for (int r = 0; r < 16; ++r) { const unsigned o = dpp_u<0xB1>(F[r]); F0[r] = p ? o : F[r]; F1[r] = p ? F[r] : o; }
    unsigned A[16], B[16];
#pragma unroll
    for (int j = 0; j < 16; ++j) A[j] = F0[0] + F1[j];
#pragma unroll
    for (int j = 0; j < 8; ++j) B[j] = F0[1] + F1[j];
#pragma unroll
    for (int j = 0; j < 5; ++j) B[8 + j] = F0[2] + F1[j];
#pragma unroll
    for (int j = 0; j < 3; ++j) B[13 + j] = F0[4] + F1[j];
    sort16_desc(B); merge16_desc(A, B);
#pragma unroll
    for (int j = 0; j < 4; ++j) B[j] = F0[3] + F1[j];
#pragma unroll
    for (int i = 0; i < 3; ++i) { B[4 + 2 * i] = F0[5 + i] + F1[0]; B[5 + 2 * i] = F0[5 + i] + F1[1]; }
#pragma unroll
    for (int i = 0; i < 6; ++i) B[10 + i] = F0[8 + i] + F1[0];
    sort16_desc(B); merge16_desc(A, B);
#pragma unroll
    for (int i = 14; i < 16; ++i) { unsigned xk = F0[i] + F1[0];
#pragma unroll
        for (int k = 0; k < 16; ++k) PK_CE(A[k], xk) }
    float ex[16]; float sum = 0.f; const float s0 = (float)((int)(A[0] >> 14) - 131072);
#pragma unroll
    for (int r = 0; r < 16; ++r) { const float s = (float)((int)(A[r] >> 14) - 131072); ex[r] = __expf((s - s0) * (1.0f / 4096.0f)); sum += ex[r]; }
    const float inv = 1.0f / sum;
    int4 i0, i1; float4 g0, g1;
    i0.x = (int)((p ? A[8] : A[0]) & 0x3FFFu); i0.y = (int)((p ? A[9] : A[1]) & 0x3FFFu); i0.z = (int)((p ? A[10] : A[2]) & 0x3FFFu); i0.w = (int)((p ? A[11] : A[3]) & 0x3FFFu);
    i1.x = (int)((p ? A[12] : A[4]) & 0x3FFFu); i1.y = (int)((p ? A[13] : A[5]) & 0x3FFFu); i1.z = (int)((p ? A[14] : A[6]) & 0x3FFFu); i1.w = (int)((p ? A[15] : A[7]) & 0x3FFFu);
    g0.x = (p ? ex[8] : ex[0]) * inv; g0.y = (p ? ex[9] : ex[1]) * inv; g0.z = (p ? ex[10] : ex[2]) * inv; g0.w = (p ? ex[11] : ex[3]) * inv;
    g1.x = (p ? ex[12] : ex[4]) * inv; g1.y = (p ? ex[13] : ex[5]) * inv; g1.z = (p ? ex[14] : ex[6]) * inv; g1.w = (p ? ex[15] : ex[7]) * inv;
    const size_t o = (size_t)t * 128 + (hp >> 1) * 16 + p * 8;
    *(int4*)(IDX + o) = i0; *(int4*)(IDX + o + 4) = i1; *(float4*)(GATE + o) = g0; *(float4*)(GATE + o + 4) = g1;
}

struct PeerStep { int t, s; bool ok; };
__device__ __forceinline__ PeerStep peer_step(int k, int bid, int G, int wave) { PeerStep r; const int i = bid + (k >> 3) * G; r.ok = i < 8 * (T / 64);
#ifdef XTEST
    r.s = (i >> 3) & 7; r.t = ((((i >> 6) << 3) | (i & 7))) * 64 + wave * 8 + (k & 7);
#else
    r.s = i & 7; r.t = (i >> 3) * 64 + wave * 8 + (k & 7);
#endif
    return r; }
#define PEER_LD_IDX(ID, ST) do { const int* ip_ = IDX + (size_t)(ST).t * 128 + g * 16; const int4 a_ = *(const int4*)ip_, b_ = *(const int4*)(ip_ + 4), c_ = *(const int4*)(ip_ + 8), d_ = *(const int4*)(ip_ + 12); \
    ID[0] = a_.x; ID[1] = a_.y; ID[2] = a_.z; ID[3] = a_.w; ID[4] = b_.x; ID[5] = b_.y; ID[6] = b_.z; ID[7] = b_.w; ID[8] = c_.x; ID[9] = c_.y; ID[10] = c_.z; ID[11] = c_.w; ID[12] = d_.x; ID[13] = d_.y; ID[14] = d_.z; ID[15] = d_.w; } while (0)
#define PEER_LD_TAB(D, ID, TAB, ST) do { const unsigned char* tb_ = (TAB) + (size_t)(ST).s * NEXP * 128 + j * 16; _Pragma("unroll") for (int q_ = 0; q_ < 16; ++q_) D[q_] = *(const uint4*)(tb_ + (size_t)((ID[q_]) & 0x3FFF) * 128); } while (0)
__device__ __forceinline__ unsigned perm_b(unsigned hi, unsigned lo, unsigned sel) { return __builtin_amdgcn_perm(hi, lo, sel); }
__device__ __forceinline__ void peer_u_compute(const uint4 (&d)[16], const uint4& xa, const uint4& xb, bf16_t* __restrict__ Arow, int g, int j) {
    const unsigned xw[8] = {xa.x, xa.y, xa.z, xa.w, xb.x, xb.y, xb.z, xb.w};
    f32x2 xf[8]; float mx = 0.f;
#pragma unroll
    for (int k = 0; k < 8; ++k) { xf[k][0] = __uint_as_float(xw[k] << 16); xf[k][1] = __uint_as_float(xw[k] & 0xFFFF0000u); mx = fmaxf(mx, fmaxf(fabsf(xf[k][0]), fabsf(xf[k][1]))); }
    mx = fmaxf(mx, dpp_f<0xB1>(mx)); mx = fmaxf(mx, dpp_f<0x4E>(mx)); mx = fmaxf(mx, dpp_f<0x141>(mx));
    const float sx = mx > 0.f ? 127.0f / mx : 1.0f, inv = mx > 0.f ? mx * (1.0f / 127.0f) : 1.0f;
    const f32x2 sx2 = {sx, sx}, magic = {12582912.0f, 12582912.0f};
    unsigned yb[16];
#pragma unroll
    for (int k = 0; k < 8; ++k) { const f32x2 y = __builtin_elementwise_fma(xf[k], sx2, magic); yb[2 * k] = __float_as_uint(y[0]); yb[2 * k + 1] = __float_as_uint(y[1]); }
    int xq[4];
#pragma unroll
    for (int k = 0; k < 4; ++k) xq[k] = (int)perm_b(perm_b(yb[4 * k + 3], yb[4 * k + 2], 0x0c0c0400u), perm_b(yb[4 * k + 1], yb[4 * k], 0x0c0c0400u), 0x05040100u);
    unsigned sacc[16];
#pragma unroll
    for (int q = 0; q < 16; ++q) {
        int acc = __builtin_amdgcn_sdot4((int)d[q].x, xq[0], 0, false); acc = __builtin_amdgcn_sdot4((int)d[q].y, xq[1], acc, false); acc = __builtin_amdgcn_sdot4((int)d[q].z, xq[2], acc, false); acc = __builtin_amdgcn_sdot4((int)d[q].w, xq[3], acc, false);
        sacc[q] = (unsigned)acc;
    }
    const bool b2 = (j & 4) != 0, b0 = (j & 1) != 0, b1 = (j & 2) != 0;
    unsigned s8[8], s4[4], s2[2];
#pragma unroll
    for (int i = 0; i < 8; ++i) { const int q = (i & 3) + 8 * (i >> 2); s8[i] = (b2 ? sacc[q + 4] : sacc[q]) + dpp_u<0x141>(b2 ? sacc[q] : sacc[q + 4]); }
#pragma unroll
    for (int i = 0; i < 4; ++i) { const int p = 2 * (i & 1) + 4 * (i >> 1); s4[i] = (b0 ? s8[p + 1] : s8[p]) + dpp_u<0xB1>(b0 ? s8[p] : s8[p + 1]); }
#pragma unroll
    for (int i = 0; i < 2; ++i) { const int p = 2 * i; s2[i] = (b1 ? s4[p + 1] : s4[p]) + dpp_u<0x4E>(b1 ? s4[p] : s4[p + 1]); }
    Arow[g * 16 + j] = f2bf((float)(int)s2[0] * inv); Arow[g * 16 + 8 + j] = f2bf((float)(int)s2[1] * inv);
}
__device__ __forceinline__ void peer_u_phase(const bf16_t* __restrict__ XB, const int* __restrict__ IDX, const unsigned char* __restrict__ U8, bf16_t* __restrict__ APART, int bid, int G, int wave, int lane) {
    const int g = lane >> 3, j = lane & 7;
    const int nk = ((8 * (T / 64) - bid + G - 1) / G) * 8;
    if (nk <= 0) return;
    int idA[16], idB[16]; uint4 dA[16], dB[16]; uint4 xA0, xA1, xB0, xB1;
    PeerStep sA = peer_step(0, bid, G, wave), sB = peer_step(1, bid, G, wave);
    PEER_LD_IDX(idA, sA); { const bf16_t* xs = XB + (size_t)sA.t * DM + sA.s * 128 + 16 * j; xA0 = *(const uint4*)xs; xA1 = *(const uint4*)(xs + 8); }
    PEER_LD_TAB(dA, idA, U8, sA);
    PEER_LD_IDX(idB, sB); { const bf16_t* xs = XB + (size_t)sB.t * DM + sB.s * 128 + 16 * j; xB0 = *(const uint4*)xs; xB1 = *(const uint4*)(xs + 8); }
#pragma unroll 1
    for (int k = 0; k < nk; k += 2) {
        PEER_LD_TAB(dB, idB, U8, sB);
        const PeerStep nA = peer_step(k + 2 < nk ? k + 2 : k, bid, G, wave), nB = peer_step(k + 3 < nk ? k + 3 : k + 1, bid, G, wave);
        PEER_LD_IDX(idA, nA);
        peer_u_compute(dA, xA0, xA1, APART + ((size_t)sA.s * T + sA.t) * 128, g, j);
        { const bf16_t* xs = XB + (size_t)nA.t * DM + nA.s * 128 + 16 * j; xA0 = *(const uint4*)xs; xA1 = *(const uint4*)(xs + 8); }
        PEER_LD_TAB(dA, idA, U8, nA);
        PEER_LD_IDX(idB, nB);
        peer_u_compute(dB, xB0, xB1, APART + ((size_t)sB.s * T + sB.t) * 128, g, j);
        { const bf16_t* xs = XB + (size_t)nB.t * DM + nB.s * 128 + 16 * j; xB0 = *(const uint4*)xs; xB1 = *(const uint4*)(xs + 8); }
        sA = nA; sB = nB;
    }
}
__device__ __forceinline__ void peer_combine4(const bf16_t* __restrict__ A, int* IDX, const float* __restrict__ GATE, const float* __restrict__ SSQ, const float* __restrict__ iscu, const float* __restrict__ iscv, float* __restrict__ WSC, int i4) {
    const int i = i4 * 4, t = i >> 7, p = i & 127;
    const float4* sp = (const float4*)(SSQ + (size_t)t * 16); const float4 s0 = sp[0], s1 = sp[1], s2 = sp[2], s3 = sp[3];
    const float q = ((s0.x + s0.y) + (s0.z + s0.w)) + ((s1.x + s1.y) + (s1.z + s1.w)) + ((s2.x + s2.y) + (s2.z + s2.w)) + ((s3.x + s3.y) + (s3.z + s3.w));
    const float rstd = rsqrtf(q * (1.0f / DM) + EPS);
    float4 a = make_float4(0.f, 0.f, 0.f, 0.f);
#pragma unroll
    for (int s = 0; s < 8; ++s) { const uint2 v = *(const uint2*)(A + ((size_t)s * T + t) * 128 + p); a.x += __uint_as_float(v.x << 16); a.y += __uint_as_float(v.x & 0xFFFF0000u); a.z += __uint_as_float(v.y << 16); a.w += __uint_as_float(v.y & 0xFFFF0000u); }
    const int4 ev = *(const int4*)(IDX + i); const float4 gv = *(const float4*)(GATE + i);
    const int e[4] = {ev.x & 0x3FFF, ev.y & 0x3FFF, ev.z & 0x3FFF, ev.w & 0x3FFF}; const float av[4] = {a.x, a.y, a.z, a.w}; const float gg[4] = {gv.x, gv.y, gv.z, gv.w};
    float w[4]; float mx = 0.f;
#pragma unroll
    for (int k = 0; k < 4; ++k) { const float x = av[k] * rstd * iscu[e[k]]; w[k] = gg[k] * 0.5f * x * (1.f + erff(x * 0.7071067811865476f)) * iscv[e[k]]; mx = fmaxf(mx, fabsf(w[k])); }
    mx = fmaxf(mx, dpp_f<0xB1>(mx)); mx = fmaxf(mx, dpp_f<0x4E>(mx)); mx = fmaxf(mx, dpp_f<0x141>(mx)); mx = fmaxf(mx, dpp_f<0x140>(mx)); mx = xor16_max(mx);
    const float sw = mx > 0.f ? 127.0f / mx : 1.0f;
    int o[4];
#pragma unroll
    for (int k = 0; k < 4; ++k) o[k] = (int)((((unsigned)(int)rintf(w[k] * sw) & 0xFFu) << 16) | (unsigned)e[k]);
    int4 ov; ov.x = o[0]; ov.y = o[1]; ov.z = o[2]; ov.w = o[3];
    *(int4*)(IDX + i) = ov;
    if (p == 0) WSC[t] = mx > 0.f ? mx * (1.0f / 127.0f) : 1.0f;
}
__device__ __forceinline__ void peer_v_compute(const uint4 (&d)[16], const int (&pw)[16], const float wsc, bf16_t* xb, float* ssq2, int g, int j, const bool do_store) {
    int acc[16];
#pragma unroll
    for (int c = 0; c < 16; ++c) acc[c] = 0;
#pragma unroll
    for (int m = 0; m < 4; ++m) {
        const unsigned wlo = perm_b((unsigned)pw[4 * m + 1], (unsigned)pw[4 * m], 0x0c0c0602u), whi = perm_b((unsigned)pw[4 * m + 3], (unsigned)pw[4 * m + 2], 0x0c0c0602u);
        const int wb = (int)perm_b(whi, wlo, 0x05040100u);
        const unsigned r0[4] = {d[4 * m].x, d[4 * m].y, d[4 * m].z, d[4 * m].w}, r1[4] = {d[4 * m + 1].x, d[4 * m + 1].y, d[4 * m + 1].z, d[4 * m + 1].w};
        const unsigned r2[4] = {d[4 * m + 2].x, d[4 * m + 2].y, d[4 * m + 2].z, d[4 * m + 2].w}, r3[4] = {d[4 * m + 3].x, d[4 * m + 3].y, d[4 * m + 3].z, d[4 * m + 3].w};
#pragma unroll
        for (int k = 0; k < 4; ++k) {
            const unsigned t0 = perm_b(r1[k], r0[k], 0x05010400u), t1 = perm_b(r1[k], r0[k], 0x07030602u), t2 = perm_b(r3[k], r2[k], 0x05010400u), t3 = perm_b(r3[k], r2[k], 0x07030602u);
            const unsigned c0 = perm_b(t2, t0, 0x05040100u), c1 = perm_b(t2, t0, 0x07060302u), c2 = perm_b(t3, t1, 0x05040100u), c3 = perm_b(t3, t1, 0x07060302u);
            acc[4 * k] = __builtin_amdgcn_sdot4((int)c0, wb, acc[4 * k], false); acc[4 * k + 1] = __builtin_amdgcn_sdot4((int)c1, wb, acc[4 * k + 1], false);
            acc[4 * k + 2] = __builtin_amdgcn_sdot4((int)c2, wb, acc[4 * k + 2], false); acc[4 * k + 3] = __builtin_amdgcn_sdot4((int)c3, wb, acc[4 * k + 3], false);
        }
    }
    int r8[8], r4[4];
#pragma unroll
    for (int i = 0; i < 8; ++i) { auto rr = __builtin_amdgcn_permlane32_swap((unsigned)acc[i], (unsigned)acc[i + 8], false, false); r8[i] = (int)(rr[0] + rr[1]); }
#pragma unroll
    for (int i = 0; i < 4; ++i) { auto rr = __builtin_amdgcn_permlane16_swap((unsigned)r8[i], (unsigned)r8[i + 4], false, false); r4[i] = (int)(rr[0] + rr[1]); }
    const bool e = (g & 1) != 0;
    const int t0 = (e ? r4[2] : r4[0]) + (int)dpp_u<0x128>((unsigned)(e ? r4[0] : r4[2])), t1 = (e ? r4[3] : r4[1]) + (int)dpp_u<0x128>((unsigned)(e ? r4[1] : r4[3]));
    if (do_store) {
        unsigned* xp = (unsigned*)(xb + 16 * j + 2 * g);
        const unsigned xw = *xp;
        const float lo = __uint_as_float(xw << 16) + (float)t0 * wsc, hi = __uint_as_float(xw & 0xFFFF0000u) + (float)t1 * wsc;
        const unsigned ow = pk2bf(lo, hi);
        *xp = ow;
        const float rl = __uint_as_float(ow << 16), rh = __uint_as_float(ow & 0xFFFF0000u);
        const float ss = wave_sum(rl * rl + rh * rh);
        if (g == 0 && j == 0) { ssq2[0] = ss; ssq2[1] = 0.f; }
    }
}
__device__ __forceinline__ void peer_v_phase(const int* __restrict__ IDX, const float* __restrict__ WSC, const unsigned char* __restrict__ V8, bf16_t* XB, float* SSQ, int bid, int G, int wave, int lane, const bool do_store = true) {
    const int g = lane >> 3, j = lane & 7;
    const int nk = ((8 * (T / 64) - bid + G - 1) / G) * 8;
    if (nk <= 0) return;
    int idA[16], idB[16]; uint4 dA[16], dB[16];
    PeerStep sA = peer_step(0, bid, G, wave), sB = peer_step(1, bid, G, wave);
    PEER_LD_IDX(idA, sA); PEER_LD_TAB(dA, idA, V8, sA); PEER_LD_IDX(idB, sB);
#pragma unroll 1
    for (int k = 0; k < nk; k += 2) {
        PEER_LD_TAB(dB, idB, V8, sB);
        const PeerStep nA = peer_step(k + 2 < nk ? k + 2 : k, bid, G, wave), nB = peer_step(k + 3 < nk ? k + 3 : k + 1, bid, G, wave);
        peer_v_compute(dA, idA, WSC[sA.t], XB + (size_t)sA.t * DM + sA.s * 128, SSQ + (size_t)sA.t * 16 + 2 * sA.s, g, j, do_store);
        PEER_LD_IDX(idA, nA); PEER_LD_TAB(dA, idA, V8, nA);
        peer_v_compute(dB, idB, WSC[sB.t], XB + (size_t)sB.t * DM + sB.s * 128, SSQ + (size_t)sB.t * 16 + 2 * sB.s, g, j, do_store);
        PEER_LD_IDX(idB, nB);
        sA = nA; sB = nB;
    }
}
typedef short bf16x8_t __attribute__((ext_vector_type(8)));
typedef float f32x16_t __attribute__((ext_vector_type(16)));
__device__ __forceinline__ bf16x8_t mk_bf16x8(uint2 a, uint2 b) { uint4 v; v.x = a.x; v.y = a.y; v.z = b.x; v.w = b.y; return __builtin_bit_cast(bf16x8_t, v); }
__device__ __forceinline__ void xattn_unit(char* lds, const bf16_t* __restrict__ Q, const bf16_t* __restrict__ Kb, const bf16_t* __restrict__ VTb, bf16_t* __restrict__ O, int t0, int h, int tid_in, const bool do_store = true) {
    int tid = tid_in; asm volatile("" : "+v"(tid));
    const int lane = tid & 63, wave = __builtin_amdgcn_readfirstlane(tid >> 6), r = lane & 31, hh = lane >> 5, tq = wave & 3, dh = wave >> 2;
    char* Il = lds;
    uint4 kr0, kr1, kr2, kr3, kr4, kr5, kr6, kr7, kr8, kr9, kr10, kr11, kr12, kr13, kr14, kr15;
#define XA_LDK(i_) do { const int c = tid + 512 * (i_); kr##i_ = *(const uint4*)(Kb + (size_t)(c >> 5) * 2048 + (c & 31) * 8); } while (0)
    XA_LDK(0); XA_LDK(1); XA_LDK(2); XA_LDK(3); XA_LDK(4); XA_LDK(5); XA_LDK(6); XA_LDK(7); XA_LDK(8); XA_LDK(9); XA_LDK(10); XA_LDK(11); XA_LDK(12); XA_LDK(13); XA_LDK(14); XA_LDK(15);
#undef XA_LDK
#pragma unroll
    for (int i = 0; i < 8; ++i) { const int c = tid + 512 * i; *(uint4*)(Il + (c >> 5) * 528 + (c & 31) * 16) = *(const uint4*)(Q + (size_t)(t0 + (c >> 5)) * DM + h * 256 + (c & 31) * 8); }
    __syncthreads();
    bf16x8_t qf[16];
#pragma unroll
    for (int ks = 0; ks < 16; ++ks) qf[ks] = *(const bf16x8_t*)(Il + (tq * 32 + r) * 528 + (16 * ks + 8 * hh) * 2);
    __syncthreads();
#define XA_STK(i_) do { const int c = tid + 512 * (i_); *(uint4*)(Il + (c >> 5) * 528 + (c & 31) * 16) = kr##i_; } while (0)
    XA_STK(0); XA_STK(1); XA_STK(2); XA_STK(3); XA_STK(4); XA_STK(5); XA_STK(6); XA_STK(7); XA_STK(8); XA_STK(9); XA_STK(10); XA_STK(11); XA_STK(12); XA_STK(13); XA_STK(14); XA_STK(15);
#undef XA_STK
    __syncthreads();
    f32x16_t sc0, sc1, sc2, sc3, sc4, sc5, sc6, sc7;
#define XA_S(S_, mb_) do { _Pragma("unroll") for (int i = 0; i < 16; ++i) S_[i] = 0.f; \
        _Pragma("unroll") for (int ks = 0; ks < 16; ++ks) { const bf16x8_t kf = *(const bf16x8_t*)(Il + ((mb_) * 32 + r) * 528 + (16 * ks + 8 * hh) * 2); S_ = __builtin_amdgcn_mfma_f32_32x32x16_bf16(kf, qf[ks], S_, 0, 0, 0); } } while (0)
    XA_S(sc0, 0); XA_S(sc1, 1); XA_S(sc2, 2); XA_S(sc3, 3); XA_S(sc4, 4); XA_S(sc5, 5); XA_S(sc6, 6); XA_S(sc7, 7);
#undef XA_S
    float mx = sc0[0];
#define XA_MAX(S_) do { _Pragma("unroll") for (int i = 0; i < 16; ++i) mx = fmaxf(mx, S_[i]); } while (0)
    XA_MAX(sc0); XA_MAX(sc1); XA_MAX(sc2); XA_MAX(sc3); XA_MAX(sc4); XA_MAX(sc5); XA_MAX(sc6); XA_MAX(sc7);
#undef XA_MAX
    mx = xor32_max(mx);
    float ps = 0.f;
    bf16x8_t pf00, pf01, pf10, pf11, pf20, pf21, pf30, pf31, pf40, pf41, pf50, pf51, pf60, pf61, pf70, pf71;
#define XA_P(S_, P0_, P1_) do { _Pragma("unroll") for (int i = 0; i < 16; ++i) { S_[i] = __builtin_amdgcn_exp2f(S_[i] - mx); ps += S_[i]; } \
        { uint4 w; w.x = pk2bf(S_[0], S_[1]); w.y = pk2bf(S_[2], S_[3]); w.z = pk2bf(S_[4], S_[5]); w.w = pk2bf(S_[6], S_[7]); P0_ = __builtin_bit_cast(bf16x8_t, w); } \
        { uint4 w; w.x = pk2bf(S_[8], S_[9]); w.y = pk2bf(S_[10], S_[11]); w.z = pk2bf(S_[12], S_[13]); w.w = pk2bf(S_[14], S_[15]); P1_ = __builtin_bit_cast(bf16x8_t, w); } } while (0)
    XA_P(sc0, pf00, pf01); XA_P(sc1, pf10, pf11); XA_P(sc2, pf20, pf21); XA_P(sc3, pf30, pf31); XA_P(sc4, pf40, pf41); XA_P(sc5, pf50, pf51); XA_P(sc6, pf60, pf61); XA_P(sc7, pf70, pf71);
#undef XA_P
    ps = xor32_sum(ps);
    const float inv = 1.0f / ps;
    uint4 vr0, vr1, vr2, vr3, vr4, vr5, vr6, vr7, vr8, vr9, vr10, vr11, vr12, vr13, vr14, vr15;
    int tv = tid; asm volatile("" : "+v"(tv));
#define XA_LDV(i_) do { const int c = tv + 512 * (i_); vr##i_ = *(const uint4*)(VTb + (size_t)(c >> 5) * 256 + (c & 31) * 8); } while (0)
    XA_LDV(0); XA_LDV(1); XA_LDV(2); XA_LDV(3); XA_LDV(4); XA_LDV(5); XA_LDV(6); XA_LDV(7); XA_LDV(8); XA_LDV(9); XA_LDV(10); XA_LDV(11); XA_LDV(12); XA_LDV(13); XA_LDV(14); XA_LDV(15);
#undef XA_LDV
    __syncthreads();
#define XA_STV(i_) do { const int c = tv + 512 * (i_); *(uint4*)(Il + (c >> 5) * 528 + (c & 31) * 16) = vr##i_; } while (0)
    XA_STV(0); XA_STV(1); XA_STV(2); XA_STV(3); XA_STV(4); XA_STV(5); XA_STV(6); XA_STV(7); XA_STV(8); XA_STV(9); XA_STV(10); XA_STV(11); XA_STV(12); XA_STV(13); XA_STV(14); XA_STV(15);
#undef XA_STV
    __syncthreads();
    f32x16_t o[4];
#define XA_PV(db_, mb_, P0_, P1_) do { const char* vp = Il + (dh * 128 + (db_) * 32 + r) * 528 + ((mb_) * 32 + 4 * hh) * 2; \
        o[db_] = __builtin_amdgcn_mfma_f32_32x32x16_bf16(mk_bf16x8(*(const uint2*)vp, *(const uint2*)(vp + 16)), P0_, o[db_], 0, 0, 0); \
        o[db_] = __builtin_amdgcn_mfma_f32_32x32x16_bf16(mk_bf16x8(*(const uint2*)(vp + 32), *(const uint2*)(vp + 48)), P1_, o[db_], 0, 0, 0); } while (0)
#pragma unroll
    for (int db = 0; db < 4; ++db) {
#pragma unroll
        for (int i = 0; i < 16; ++i) o[db][i] = 0.f;
        XA_PV(db, 0, pf00, pf01); XA_PV(db, 1, pf10, pf11); XA_PV(db, 2, pf20, pf21); XA_PV(db, 3, pf30, pf31); XA_PV(db, 4, pf40, pf41); XA_PV(db, 5, pf50, pf51); XA_PV(db, 6, pf60, pf61); XA_PV(db, 7, pf70, pf71);
    }
#undef XA_PV
    __syncthreads();
    char* Ost = Il + wave * 8704;
#pragma unroll
    for (int db = 0; db < 4; ++db)
#pragma unroll
        for (int g = 0; g < 4; ++g) { uint2 w; w.x = pk2bf(o[db][4 * g] * inv, o[db][4 * g + 1] * inv); w.y = pk2bf(o[db][4 * g + 2] * inv, o[db][4 * g + 3] * inv); *(uint2*)(Ost + r * 272 + (db * 32 + 8 * g + 4 * hh) * 2) = w; }
    bf16_t* obase = O + (size_t)(t0 + tq * 32) * DM + h * 256 + dh * 128;
#pragma unroll
    for (int i = 0; i < 8; ++i) { const int c = lane + 64 * i, row = c >> 4, ch = c & 15; const uint4 v = *(const uint4*)(Ost + row * 272 + ch * 16); if (do_store) nt_st16(obase + (size_t)row * DM + ch * 8, v); }
    __syncthreads();
}
__device__ __forceinline__ void sb_wave(char* ldsw, bf16_t* MIXQ, const bf16_t* __restrict__ PROJ2, const bf16_t* __restrict__ SVT, const float* __restrict__ sbn, int b, int h, int t0, int lane, const bool do_store = true) {
    const int r = lane & 31, hh = lane >> 5;
    char* Kw = ldsw; char* Vw = ldsw + 4608;
    bf16_t* qrow = MIXQ + ((size_t)b * SEQ + t0 + r) * DM + h * 64;
    bf16x8_t qf[4];
#pragma unroll
    for (int ks = 0; ks < 4; ++ks) qf[ks] = *(const bf16x8_t*)(qrow + 16 * ks + 8 * hh);
    const bf16_t* Kg = PROJ2 + ((size_t)b * SEQ + (lane >> 3)) * 1536 + h * 64 + (lane & 7) * 8;
    const bf16_t* Vg = SVT + ((size_t)(b * 8 + h) * 64 + (lane >> 2)) * SEQ + (lane & 3) * 8;
    char* Kst = Kw + (lane >> 3) * 144 + (lane & 7) * 16; char* Vst = Vw + (lane >> 2) * 72 + (lane & 3) * 16;
    const char* Kfr = Kw + r * 144 + 16 * hh; const char* Vfr = Vw + r * 72 + 8 * hh;
    f32x16_t o0, o1;
#pragma unroll
    for (int i = 0; i < 16; ++i) { o0[i] = 0.f; o1[i] = 0.f; }
    float carry = 0.f;
    uint4 gk0, gk1, gk2, gk3, gv0, gv1, gv2, gv3;
#define SB_GLOAD(k0_) do { const bf16_t* kp_ = Kg + (size_t)(k0_) * 1536; gk0 = *(const uint4*)kp_; gk1 = *(const uint4*)(kp_ + 8 * 1536); gk2 = *(const uint4*)(kp_ + 16 * 1536); gk3 = *(const uint4*)(kp_ + 24 * 1536); \
        const bf16_t* vp_ = Vg + (k0_); gv0 = *(const uint4*)vp_; gv1 = *(const uint4*)(vp_ + 16 * SEQ); gv2 = *(const uint4*)(vp_ + 32 * SEQ); gv3 = *(const uint4*)(vp_ + 48 * SEQ); } while (0)
#define SB_VST(p_, v_) do { uint2 lo_, hi_; lo_.x = (v_).x; lo_.y = (v_).y; hi_.x = (v_).z; hi_.y = (v_).w; *(uint2*)(p_) = lo_; *(uint2*)((p_) + 8) = hi_; } while (0)
    SB_GLOAD(t0);
#pragma unroll 1
    for (int k0 = t0; k0 >= 0; k0 -= 32) {
        *(uint4*)Kst = gk0; *(uint4*)(Kst + 8 * 144) = gk1; *(uint4*)(Kst + 16 * 144) = gk2; *(uint4*)(Kst + 24 * 144) = gk3;
        SB_VST(Vst, gv0); SB_VST(Vst + 16 * 72, gv1); SB_VST(Vst + 32 * 72, gv2); SB_VST(Vst + 48 * 72, gv3);
        if (k0 >= 32) SB_GLOAD(k0 - 32);
        bf16x8_t kf[4], vf[4];
#pragma unroll
        for (int ks = 0; ks < 4; ++ks) kf[ks] = *(const bf16x8_t*)(Kfr + 32 * ks);
#pragma unroll
        for (int db = 0; db < 2; ++db)
#pragma unroll
            for (int s2 = 0; s2 < 2; ++s2) { const char* vp = Vfr + db * 32 * 72 + 32 * s2; vf[db * 2 + s2] = mk_bf16x8(*(const uint2*)vp, *(const uint2*)(vp + 16)); }
        f32x16_t s;
#pragma unroll
        for (int i = 0; i < 16; ++i) s[i] = 0.f;
#pragma unroll
        for (int ks = 0; ks < 4; ++ks) s = __builtin_amdgcn_mfma_f32_32x32x16_bf16(kf[ks], qf[ks], s, 0, 0, 0);
        const bool diag = (k0 == t0);
        float lb[16];
#pragma unroll
        for (int i = 0; i < 16; ++i) {
            const float z = s[i]; const float e = __builtin_amdgcn_exp2f(-fabsf(z));
            float v = -(fmaxf(z, 0.f) + __builtin_amdgcn_logf(1.0f + e));
            if (diag && ((i & 3) + 8 * (i >> 2) + 4 * hh >= r)) v = 0.f;
            lb[i] = v;
        }
        float gs[4], pg[4], off[4];
#pragma unroll
        for (int g = 0; g < 4; ++g) { lb[4 * g + 2] += lb[4 * g + 3]; lb[4 * g + 1] += lb[4 * g + 2]; lb[4 * g] += lb[4 * g + 1]; gs[g] = lb[4 * g]; }
#pragma unroll
        for (int g = 0; g < 4; ++g) pg[g] = xor32_get(gs[g], hh);
        float run = 0.f;
#pragma unroll
        for (int g = 3; g >= 0; --g) { off[g] = run + (hh == 0 ? pg[g] : 0.f); run += gs[g] + pg[g]; }
#pragma unroll
        for (int i = 0; i < 16; ++i) {
            float p = __builtin_amdgcn_exp2f(s[i] + lb[i] + off[i >> 2] + carry);
            if (diag && ((i & 3) + 8 * (i >> 2) + 4 * hh >= r)) p = 0.f;
            s[i] = p;
        }
        carry += run;
        bf16x8_t pf[2];
#pragma unroll
        for (int s2 = 0; s2 < 2; ++s2) { uint4 w; w.x = pk2bf(s[8 * s2], s[8 * s2 + 1]); w.y = pk2bf(s[8 * s2 + 2], s[8 * s2 + 3]); w.z = pk2bf(s[8 * s2 + 4], s[8 * s2 + 5]); w.w = pk2bf(s[8 * s2 + 6], s[8 * s2 + 7]); pf[s2] = __builtin_bit_cast(bf16x8_t, w); }
#pragma unroll
        for (int s2 = 0; s2 < 2; ++s2) { o0 = __builtin_amdgcn_mfma_f32_32x32x16_bf16(vf[s2], pf[s2], o0, 0, 0, 0); o1 = __builtin_amdgcn_mfma_f32_32x32x16_bf16(vf[2 + s2], pf[s2], o1, 0, 0, 0); }
        if (__all(carry < -64.f)) break;
    }
#undef SB_GLOAD
#undef SB_VST
    float ss = 0.f;
#pragma unroll
    for (int i = 0; i < 16; ++i) ss += o0[i] * o0[i] + o1[i] * o1[i];
    ss = xor32_sum(ss);
    const float rstd = rsqrtf(ss * (1.0f / 64.0f) + EPS);
#pragma unroll
    for (int g = 0; g < 4; ++g) {
        const int d = 8 * g + 4 * hh;
        const float4 g0 = *(const float4*)(sbn + h * 64 + d), g1 = *(const float4*)(sbn + h * 64 + 32 + d);
        uint2 w0, w1;
        w0.x = pk2bf(o0[4 * g] * rstd * g0.x, o0[4 * g + 1] * rstd * g0.y); w0.y = pk2bf(o0[4 * g + 2] * rstd * g0.z, o0[4 * g + 3] * rstd * g0.w);
        w1.x = pk2bf(o1[4 * g] * rstd * g1.x, o1[4 * g + 1] * rstd * g1.y); w1.y = pk2bf(o1[4 * g + 2] * rstd * g1.z, o1[4 * g + 3] * rstd * g1.w);
        if (do_store) { *(uint2*)(qrow + d) = w0; *(uint2*)(qrow + 32 + d) = w1; }
    }
}

__device__ __forceinline__ void ret_unit(char* lds, bf16_t* MIXQ, const bf16_t* __restrict__ PROJ2, const bf16_t* __restrict__ RKT, const bf16_t* __restrict__ RVT, const float* __restrict__ rn, int b, int h, int j, int tid, const bool do_store = true) {
    const int lane = tid & 63, wave = __builtin_amdgcn_readfirstlane(tid >> 6), r = lane & 31, hh = lane >> 5;
    const int eh = wave >> 2, cq = eh ? 3 - (wave & 3) : (wave & 3);
    const int eb4 = wave & 3, dp = wave >> 2;
    char* Kl = lds; char* KzT = lds + 34816; char* VTl = lds + 69632; char* stT = lds + 104448; float* xch = (float*)(lds + 139264);
    const float lg2 = log2f(1.0f - exp2f(-5.0f - (float)h));
    const float g128 = exp2f(128.0f * lg2);
    f32x16_t st0, st1;
#pragma unroll
    for (int i = 0; i < 16; ++i) { st0[i] = 0.f; st1[i] = 0.f; }
    const size_t bh = (size_t)b * 4 + h;
#pragma unroll 1
    for (int n = 0; n < 4 * j + 4; ++n) {
        const bool full = n >= 4 * j;
        const size_t row0 = (size_t)b * SEQ + n * 128;
        bf16x8_t qf[8]; uint2 gA0, gA1, gA2, gA3, gB0, gB1, gB2, gB3;
        if (full) {
            const bf16_t* qrow = MIXQ + (row0 + cq * 32 + r) * DM + 512 + h * 128 + 8 * hh;
#pragma unroll
            for (int ks = 0; ks < 8; ++ks) qf[ks] = *(const bf16x8_t*)(qrow + 16 * ks);
            const bf16_t* grow = PROJ2 + (row0 + cq * 32 + r) * 1536 + 1024 + h * 128 + eh * 64 + 4 * hh;
            gA0 = *(const uint2*)(grow); gA1 = *(const uint2*)(grow + 8); gA2 = *(const uint2*)(grow + 16); gA3 = *(const uint2*)(grow + 24);
            gB0 = *(const uint2*)(grow + 32); gB1 = *(const uint2*)(grow + 40); gB2 = *(const uint2*)(grow + 48); gB3 = *(const uint2*)(grow + 56);
        }
        __syncthreads();
#pragma unroll
        for (int i = 0; i < 4; ++i) { const int c = tid + 512 * i, rw = c >> 4, ch = c & 15;
            *(uint4*)(KzT + rw * 272 + ch * 16) = *(const uint4*)(RKT + (bh * 128 + rw) * SEQ + n * 128 + ch * 8);
            *(uint4*)(VTl + rw * 272 + ch * 16) = *(const uint4*)(RVT + (bh * 128 + rw) * SEQ + n * 128 + ch * 8);
            if (full) *(uint4*)(Kl + rw * 272 + ch * 16) = *(const uint4*)(PROJ2 + (row0 + rw) * 1536 + 512 + h * 128 + ch * 8); }
        if (full) {
#pragma unroll
            for (int g = 0; g < 4; ++g) { uint2 w0, w1; w0.x = pk2bf(st0[4 * g], st0[4 * g + 1]); w0.y = pk2bf(st0[4 * g + 2], st0[4 * g + 3]); w1.x = pk2bf(st1[4 * g], st1[4 * g + 1]); w1.y = pk2bf(st1[4 * g + 2], st1[4 * g + 3]);
                *(uint2*)(stT + (eb4 * 32 + r) * 272 + ((2 * dp) * 32 + 8 * g + 4 * hh) * 2) = w0; *(uint2*)(stT + (eb4 * 32 + r) * 272 + ((2 * dp + 1) * 32 + 8 * g + 4 * hh) * 2) = w1; }
        }
        __syncthreads();
        f32x16_t ot0, ot1;
        if (full) {
#pragma unroll
            for (int i = 0; i < 16; ++i) { ot0[i] = 0.f; ot1[i] = 0.f; }
#pragma unroll
            for (int ks = 0; ks < 8; ++ks) {
                const bf16x8_t a0 = *(const bf16x8_t*)(stT + (eh * 64 + r) * 272 + (16 * ks + 8 * hh) * 2), a1 = *(const bf16x8_t*)(stT + (eh * 64 + 32 + r) * 272 + (16 * ks + 8 * hh) * 2);
                ot0 = __builtin_amdgcn_mfma_f32_32x32x16_bf16(a0, qf[ks], ot0, 0, 0, 0); ot1 = __builtin_amdgcn_mfma_f32_32x32x16_bf16(a1, qf[ks], ot1, 0, 0, 0); }
            const float xi = exp2f((float)(cq * 32 + r + 1) * lg2);
#pragma unroll
            for (int i = 0; i < 16; ++i) { ot0[i] *= xi; ot1[i] *= xi; }
#pragma unroll 1
            for (int mb = 0; mb <= cq; ++mb) {
                f32x16_t s;
#pragma unroll
                for (int i = 0; i < 16; ++i) s[i] = 0.f;
#pragma unroll
                for (int ks = 0; ks < 8; ++ks) { const bf16x8_t a = *(const bf16x8_t*)(Kl + (mb * 32 + r) * 272 + (16 * ks + 8 * hh) * 2); s = __builtin_amdgcn_mfma_f32_32x32x16_bf16(a, qf[ks], s, 0, 0, 0); }
                const int cm = (cq - mb) * 32 + r - 4 * hh;
#pragma unroll
                for (int i = 0; i < 16; ++i) { const int dl = cm - ((i & 3) + 8 * (i >> 2)); s[i] = dl >= 0 ? s[i] * exp2f((float)dl * lg2) : 0.f; }
                bf16x8_t pf[2];
#pragma unroll
                for (int s2 = 0; s2 < 2; ++s2) { uint4 w; w.x = pk2bf(s[8 * s2], s[8 * s2 + 1]); w.y = pk2bf(s[8 * s2 + 2], s[8 * s2 + 3]); w.z = pk2bf(s[8 * s2 + 4], s[8 * s2 + 5]); w.w = pk2bf(s[8 * s2 + 6], s[8 * s2 + 7]); pf[s2] = __builtin_bit_cast(bf16x8_t, w); }
#pragma unroll
                for (int s2 = 0; s2 < 2; ++s2) {
                    const char* vp0 = VTl + (eh * 64 + r) * 272 + (mb * 32 + 16 * s2 + 4 * hh) * 2; const char* vp1 = vp0 + 32 * 272;
                    ot0 = __builtin_amdgcn_mfma_f32_32x32x16_bf16(mk_bf16x8(*(const uint2*)vp0, *(const uint2*)(vp0 + 16)), pf[s2], ot0, 0, 0, 0);
                    ot1 = __builtin_amdgcn_mfma_f32_32x32x16_bf16(mk_bf16x8(*(const uint2*)vp1, *(const uint2*)(vp1 + 16)), pf[s2], ot1, 0, 0, 0); }
            }
            float s1 = 0.f, s2v = 0.f;
#pragma unroll
            for (int i = 0; i < 16; ++i) { s1 += ot0[i] + ot1[i]; s2v += ot0[i] * ot0[i] + ot1[i] * ot1[i]; }
            s1 = xor32_sum(s1); s2v = xor32_sum(s2v);
            if (hh == 0) { xch[(eh * 128 + cq * 32 + r) * 2] = s1; xch[(eh * 128 + cq * 32 + r) * 2 + 1] = s2v; }
        }
#pragma unroll
        for (int i = 0; i < 16; ++i) { st0[i] *= g128; st1[i] *= g128; }
#pragma unroll
        for (int ks = 0; ks < 8; ++ks) {
            const bf16x8_t bv = *(const bf16x8_t*)(VTl + (eb4 * 32 + r) * 272 + (16 * ks + 8 * hh) * 2);
            const bf16x8_t a0 = *(const bf16x8_t*)(KzT + ((2 * dp) * 32 + r) * 272 + (16 * ks + 8 * hh) * 2), a1 = *(const bf16x8_t*)(KzT + ((2 * dp + 1) * 32 + r) * 272 + (16 * ks + 8 * hh) * 2);
            st0 = __builtin_amdgcn_mfma_f32_32x32x16_bf16(a0, bv, st0, 0, 0, 0); st1 = __builtin_amdgcn_mfma_f32_32x32x16_bf16(a1, bv, st1, 0, 0, 0); }
        if (full) {
            __syncthreads();
            const int c = cq * 32 + r;
            const float t1 = xch[c * 2] + xch[(128 + c) * 2], t2 = xch[c * 2 + 1] + xch[(128 + c) * 2 + 1];
            const float mu = t1 * (1.0f / 128.0f); const float var = fmaxf(t2 * (1.0f / 128.0f) - mu * mu, 0.f); const float rstd = rsqrtf(var + EPS);
            bf16_t* orow = MIXQ + (row0 + c) * DM + 512 + h * 128 + eh * 64 + 4 * hh;
            const float* gn = rn + h * 128 + eh * 64 + 4 * hh;
#pragma unroll
            for (int g = 0; g < 4; ++g) {
                const uint2 ga = g == 0 ? gA0 : (g == 1 ? gA1 : (g == 2 ? gA2 : gA3)), gb = g == 0 ? gB0 : (g == 1 ? gB1 : (g == 2 ? gB2 : gB3));
                const float4 na = *(const float4*)(gn + 8 * g), nb = *(const float4*)(gn + 32 + 8 * g);
                const float gav[4] = {__uint_as_float(ga.x << 16), __uint_as_float(ga.x & 0xFFFF0000u), __uint_as_float(ga.y << 16), __uint_as_float(ga.y & 0xFFFF0000u)};
                const float gbv[4] = {__uint_as_float(gb.x << 16), __uint_as_float(gb.x & 0xFFFF0000u), __uint_as_float(gb.y << 16), __uint_as_float(gb.y & 0xFFFF0000u)};
                const float nav[4] = {na.x, na.y, na.z, na.w}, nbv[4] = {nb.x, nb.y, nb.z, nb.w};
                float ya[4], yb[4];
#pragma unroll
                for (int k = 0; k < 4; ++k) { ya[k] = (ot0[4 * g + k] - mu) * rstd * nav[k] * (gav[k] / (1.0f + __expf(-gav[k]))); yb[k] = (ot1[4 * g + k] - mu) * rstd * nbv[k] * (gbv[k] / (1.0f + __expf(-gbv[k]))); }
                uint2 w0, w1; w0.x = pk2bf(ya[0], ya[1]); w0.y = pk2bf(ya[2], ya[3]); w1.x = pk2bf(yb[0], yb[1]); w1.y = pk2bf(yb[2], yb[3]);
                if (do_store) { *(uint2*)(orow + 8 * g) = w0; *(uint2*)(orow + 32 + 8 * g) = w1; }
            }
        }
    }
    __syncthreads();
}
#define XB_TMO      128
#define XB_XCNT(j)  (256  + 64 * (j))
#define XB_XSUB(j)  (1280 + 64 * (j))
#define XB_XGEN(j)  (2304 + 64 * (j))
#define XB_TOP      3328
#define XB_TOPGEN   3392
#define XB_SPIN_CAP (1u << 20)
typedef __attribute__((address_space(3))) unsigned lds_u32;
__device__ __forceinline__ unsigned xb_ld(unsigned* p)              { return __hip_atomic_load(p, __ATOMIC_RELAXED, __HIP_MEMORY_SCOPE_AGENT); }
__device__ __forceinline__ unsigned xb_add(unsigned* p, unsigned v) { return __hip_atomic_fetch_add(p, v, __ATOMIC_RELAXED, __HIP_MEMORY_SCOPE_AGENT); }
__device__ __forceinline__ unsigned xb_xcc_id() { return (unsigned)__builtin_amdgcn_s_getreg((3 << 11) | 20) & 0xFu; }
#define XB_SPIN(cond, bar) do { unsigned _sp = 0; while (cond) { __builtin_amdgcn_s_sleep(1); \
    if ((++_sp & 255u) == 0u) { if (xb_ld(&(bar)[XB_TMO])) break; if (_sp > XB_SPIN_CAP) { atomicAdd(&(bar)[XB_TMO], 1u); break; } } } } while (0)
__device__ __forceinline__ void xcd_barrier_post(unsigned* bar) { if (threadIdx.x == 0) (void)xb_add(&bar[XB_XCNT(xb_xcc_id())], 1u); }
__device__ __forceinline__ void xcd_barrier_complete(unsigned* bar, unsigned x, unsigned& nloc, unsigned& nx) {
    const unsigned G = gridDim.x * gridDim.y * gridDim.z;
    unsigned sum, cnt, mine, sp = 0u;
    for (;;) {
        sum = 0u; cnt = 0u; mine = 0u;
#pragma unroll
        for (unsigned j = 0; j < 16; ++j) { const unsigned c = xb_ld(&bar[XB_XCNT(j)]); sum += c; cnt += (c > 0u) ? 1u : 0u; mine = (j == x) ? c : mine; }
        if (sum == G) break;
        __builtin_amdgcn_s_sleep(1);
        if ((++sp & 255u) == 0u) { if (xb_ld(&bar[XB_TMO])) break; if (sp > XB_SPIN_CAP) { atomicAdd(&bar[XB_TMO], 1u); break; } }
    }
    nloc = mine > 0u ? mine : 1u; nx = cnt > 0u ? cnt : 1u;
}
__device__ __forceinline__ void xcd_barrier(unsigned* bar, volatile lds_u32* st, const bool thread0) {
    asm volatile("s_waitcnt vmcnt(0)" ::: "memory");
    __syncthreads();
    if (thread0) {
        __builtin_amdgcn_s_waitcnt(0);
        const unsigned x = xb_xcc_id();
        unsigned nloc = st[0], nx = st[1];
        if (nloc == 0u) { xcd_barrier_complete(bar, x, nloc, nx); st[0] = nloc; st[1] = nx; }
        const unsigned old = xb_add(&bar[XB_XSUB(x)], 1u);
        const unsigned gen = old / nloc;
        if (old + 1u == (gen + 1u) * nloc) {
            __builtin_amdgcn_fence(__ATOMIC_RELEASE, "agent");
            asm volatile("s_waitcnt vmcnt(0)" ::: "memory");
            const unsigned og = xb_add(&bar[XB_TOP], 1u);
            const unsigned tg = og / nx;
            if (og + 1u == (tg + 1u) * nx) xb_add(&bar[XB_TOPGEN], 1u);
            else XB_SPIN(xb_ld(&bar[XB_TOPGEN]) == tg, bar);
            __builtin_amdgcn_fence(__ATOMIC_ACQUIRE, "agent");
            xb_add(&bar[XB_XGEN(x)], 1u);
            asm volatile("s_waitcnt vmcnt(0)" ::: "memory");
        } else {
            XB_SPIN(xb_ld(&bar[XB_XGEN(x)]) == gen, bar);
            __builtin_amdgcn_fence(__ATOMIC_ACQUIRE, "agent");
            asm volatile("s_waitcnt vmcnt(0)" ::: "memory");
        }
    }
    __syncthreads();
}
__device__ __forceinline__ int lane_id_volatile() { int l; asm volatile("v_mbcnt_lo_u32_b32 %0, -1, 0\n\tv_mbcnt_hi_u32_b32 %0, -1, %0" : "=v"(l)); return l; }
struct Params { const float* in[18]; float* out; char* ws; };
constexpr int LDS_BYTES = 147456, BARW_OFF = 147392;
#define GRID_BAR() do { const __attribute__((address_space(4))) Params* kpb = (const __attribute__((address_space(4))) Params*)__builtin_amdgcn_kernarg_segment_ptr(); asm volatile("" : "+s"(kpb)); xcd_barrier((unsigned*)kpb->ws + 4096, (volatile lds_u32*)(lds_all + BARW_OFF), wave_s == 0 && lane_id_volatile() == 0); } while (0)
constexpr size_t MiB = 1u << 20;
constexpr size_t WS_ROT = 1, WS_SSQ = 2, WS_MEMSSQ = 4, WS_MEMB = 8, WS_KV = 16, WS_WIN = 48, WS_WOUT = 62, WS_WQ = 66, WS_WKV = 70, WS_WO = 78, WS_WP = 82,
                 WS_XB = 96, WS_MIXQ = 160, WS_PROJ2 = 224, WS_SVT = 320, WS_RVT = 352, WS_RKT = 384, WS_Q = 224, WS_O = 288, WS_SCORES = 224, WS_IDX = 384, WS_GATE = 400, WS_T8 = 416, WS_ISC = 5, WS_A = 224, WS_VT = 480, WS_END = 496;
#ifndef PHMASK
#define PHMASK 0xFFFFF
#endif
#define PH(k) if constexpr ((PHMASK >> (k)) & 1)
#ifndef REP0
#define REP0 1
#endif
#ifndef REP1
#define REP1 1
#endif
#ifndef REP12
#define REP12 1
#endif
#ifndef REP9B
#define REP9B 1
#endif
#ifndef REP9C
#define REP9C 1
#endif
#ifndef REP4
#define REP4 1
#endif
#ifndef REPR
#define REPR 1
#endif
#ifndef REPS
#define REPS 1
#endif
#ifndef REP5ST
#define REP5ST 1
#endif
#ifndef REP5
#define REP5 1
#endif
#ifndef REP8
#define REP8 1
#endif
#ifndef REP89
#define REP89 1
#endif
#ifdef PROBE_T
#define STAMP(i) do { if (blockIdx.x == 0 && wave_s == 0 && lane_id_volatile() == 0) ((volatile unsigned long long*)(lds_all + 146432))[i] = __builtin_amdgcn_s_memrealtime(); } while (0)
#else
#define STAMP(i) do {} while (0)
#endif
#define VB_LOOP(nvb) for (int vb = bid * 2 + (tid >> 8); vb < (nvb); vb += G * 2)

#define PHASE_VARS \
    const __attribute__((address_space(4))) Params* kp = (const __attribute__((address_space(4))) Params*)__builtin_amdgcn_kernarg_segment_ptr(); asm volatile("" : "+s"(kp)); \
    int tid; asm volatile("v_mbcnt_lo_u32_b32 %0, -1, 0\n\tv_mbcnt_hi_u32_b32 %0, -1, %0" : "=v"(tid)); tid += wave_s * 64; \
    const int lane = tid & 63, wave = __builtin_amdgcn_readfirstlane(tid >> 6), vtid = tid & 255; char* lds = lds_all + (tid >> 8) * 32768; \
    PG8_LAS unsigned char* glds = (PG8_LAS unsigned char*)lds_all; PG8_LAS float* rbuf = (PG8_LAS float*)(glds + 132096); \
    const int G = gridDim.x, bid = blockIdx.x; \
    const float* x = kp->in[0]; const float* mem = kp->in[1]; const float* mix_norm = kp->in[2]; const float* w_in = kp->in[3]; const float* sb_norm = kp->in[4]; const float* ret_norm = kp->in[5]; \
    const float* w_out = kp->in[6]; const float* xa_norm = kp->in[7]; const float* mem_norm = kp->in[8]; const float* xa_wq = kp->in[9]; const float* xa_wkv = kp->in[10]; const float* xa_wo = kp->in[11]; \
    const float* peer_norm = kp->in[12]; const float* peer_wq = kp->in[13]; const float* peer_keys = kp->in[14]; const float* peer_u = kp->in[15]; const float* peer_v = kp->in[16]; const float* final_norm = kp->in[17]; \
    float* XR = kp->out; char* ws = kp->ws; \
    float* SSQ = (float*)(ws + WS_SSQ * MiB); float* MEMSSQ = (float*)(ws + WS_MEMSSQ * MiB); \
    bf16_t* MEMB = (bf16_t*)(ws + WS_MEMB * MiB); bf16_t* KV = (bf16_t*)(ws + WS_KV * MiB); \
    bf16_t* WIN_T = (bf16_t*)(ws + WS_WIN * MiB); bf16_t* WOUT_T = (bf16_t*)(ws + WS_WOUT * MiB); bf16_t* WQ_T = (bf16_t*)(ws + WS_WQ * MiB); \
    bf16_t* WKV_T = (bf16_t*)(ws + WS_WKV * MiB); bf16_t* WO_T = (bf16_t*)(ws + WS_WO * MiB); bf16_t* WP_T = (bf16_t*)(ws + WS_WP * MiB); \
    bf16_t* XB = (bf16_t*)(ws + WS_XB * MiB); bf16_t* MIXQ = (bf16_t*)(ws + WS_MIXQ * MiB); bf16_t* PROJ2 = (bf16_t*)(ws + WS_PROJ2 * MiB); \
    bf16_t* Q = (bf16_t*)(ws + WS_Q * MiB); bf16_t* O = (bf16_t*)(ws + WS_O * MiB); bf16_t* SCORES = (bf16_t*)(ws + WS_SCORES * MiB); \
    int* IDX = (int*)(ws + WS_IDX * MiB); float* GATE = (float*)(ws + WS_GATE * MiB); unsigned char* T8 = (unsigned char*)(ws + WS_T8 * MiB); float* ISC = (float*)(ws + WS_ISC * MiB); float* WSC = (float*)(ws + WS_ISC * MiB + 524288); float* WMAX = (float*)(ws + 65536); unsigned char* WINQ = (unsigned char*)(ws + WS_WIN * MiB); unsigned char* XQ = (unsigned char*)XR; float* XS = (float*)((char*)XR + 64 * MiB); bf16_t* APART = (bf16_t*)(ws + WS_A * MiB); bf16_t* VT = (bf16_t*)(ws + WS_VT * MiB); bf16_t* SVT = (bf16_t*)(ws + WS_SVT * MiB); bf16_t* RVT = (bf16_t*)(ws + WS_RVT * MiB); bf16_t* RKT = (bf16_t*)(ws + WS_RKT * MiB); \
    (void)lane; (void)wave; (void)vtid; (void)lds; (void)glds; (void)rbuf; (void)G; (void)bid; (void)x; (void)mem; (void)mix_norm; (void)w_in; (void)sb_norm; (void)ret_norm; (void)w_out; (void)xa_norm; (void)mem_norm; \
    (void)xa_wq; (void)xa_wkv; (void)xa_wo; (void)peer_norm; (void)peer_wq; (void)peer_keys; (void)peer_u; (void)peer_v; (void)final_norm; (void)XR; (void)SSQ; (void)MEMSSQ; (void)MEMB; (void)KV; (void)WIN_T; \
    (void)WOUT_T; (void)WQ_T; (void)WKV_T; (void)WO_T; (void)WP_T; (void)XB; (void)MIXQ; (void)PROJ2; (void)Q; (void)O; (void)SCORES; (void)IDX; (void)GATE; (void)T8; (void)ISC; (void)WSC; (void)WMAX; (void)WINQ; (void)XQ; (void)XS; (void)APART; (void)VT; (void)SVT; (void)RVT; (void)RKT;

__global__ void __launch_bounds__(512, 2) mega(Params p_unused) {
    extern __shared__ __attribute__((aligned(16))) char lds_all[];
    cg::grid_group grid = cg::this_grid();
    const int wave_s = __builtin_amdgcn_readfirstlane((int)(threadIdx.x >> 6));
    if (threadIdx.x < 2) ((volatile lds_u32*)(lds_all + BARW_OFF))[threadIdx.x] = 0u;
    __syncthreads();
    { const __attribute__((address_space(4))) Params* kp0 = (const __attribute__((address_space(4))) Params*)__builtin_amdgcn_kernarg_segment_ptr(); xcd_barrier_post((unsigned*)kp0->ws + 4096); }
    STAMP(0);
    for (int rep0 = 0; rep0 < REP0; ++rep0)
    PH(0) { PHASE_VARS
        const int gw = bid * 8 + wave, NGW = G * 8;
        for (int it = gw; it < NL * 1792; it += NGW) { const int l = it / 1792; wmax_item(w_in + (size_t)l * DM * INC, DM, INC, mix_norm + l * DM, WMAX + l * INC, it % 1792, lane); }
    }
    GRID_BAR();
    PH(0) { PHASE_VARS
        const int gw = bid * 8 + wave, NGW = G * 8;
        float* scr = (float*)(lds_all + wave * 8448);
        for (int it = gw; it < 2 * 4352; it += NGW) {
            const int l = it / 4352; int r = it % 4352;
            if (r < 1792) { tr_item_i8(w_in + (size_t)l * DM * INC, DM, INC, mix_norm + l * DM, WINQ + (size_t)l * INC * DM, WMAX + l * INC, WMAX + 8192 + l * INC, scr, r, lane); continue; } r -= 1792;
            if (r < 512) { tr_item(w_out + (size_t)l * DM * DM, DM, DM, nullptr, false, WOUT_T + (size_t)l * DM * DM, scr, r, lane); continue; } r -= 512;
            if (r < 512) { tr_item(xa_wq + (size_t)l * DM * DM, DM, DM, xa_norm + l * DM, false, WQ_T + (size_t)l * DM * DM, scr, r, lane); continue; } r -= 512;
            if (r < 1024) { tr_item(xa_wkv + (size_t)l * DM * 2048, DM, 2048, mem_norm + l * DM, false, WKV_T + (size_t)l * 2048 * DM, scr, r, lane); continue; } r -= 1024;
            tr_item(xa_wo + (size_t)l * DM * DM, DM, DM, nullptr, false, WO_T + (size_t)l * DM * DM, scr, r, lane);
        }
        for (int m = gw; m < T; m += NGW) row_to_i8_ssq(x + (size_t)m * DM, XQ + (size_t)m * DM, XS + m, SSQ + (size_t)m * 16, lane);
        for (int m = gw; m < MROWS; m += NGW) row_to_bf16_ssq(mem + (size_t)m * DM, MEMB + (size_t)m * DM, MEMSSQ + (size_t)m * 16, lane);
        __syncthreads();
        for (int it = bid; it < NL * 256; it += G) { const int l = it >> 8;
            peer_fold_item(peer_wq + (size_t)l * DM * 2048, peer_keys + (size_t)l * 8 * 2 * 128 * 128, peer_norm + l * DM, WP_T + (size_t)l * 2048 * DM, (float*)lds_all, it & 255, tid); }
    }
    grid.sync();
    STAMP(1);
    for (int l = 0; l < NL; ++l) {
        int stamp_i = 2 + l * 11; (void)stamp_i;
        if (l > 0) {
            PH(1) { PHASE_VARS const int gw = bid * 8 + wave, NGW = G * 8; for (int m = gw; m < T; m += NGW) rowbf_to_i8(XB + (size_t)m * DM, XQ + (size_t)m * DM, XS + m, lane); }
            GRID_BAR();
        }
        for (int rep12 = 0; rep12 < REP12; ++rep12) {
        for (int rep1 = 0; rep1 < REP1; ++rep1) {
        PH(1) { PHASE_VARS  pg8::Gemm g{(const bf16_t*)XQ, (const bf16_t*)(WINQ + (size_t)l * INC * DM), T, INC, DM / 2}; pg8::StaticOrder S; S.init(T, INC, G, bid, tid, SSQ, rbuf, XS, WMAX + 8192 + l * INC);
            pg8::EpiProj E{MIXQ, PROJ2, SVT, RKT, RVT, rbuf, WMAX + 8192 + l * INC, glds + 136192};
            pg8::gemm_phase<pg8::EpiProj, pg8::StaticOrder, true, true, true>(glds, g, S, E, tid); }
        PH(2) if (l == 0) { PHASE_VARS
#pragma unroll 1
            for (int ll = 0; ll < NL; ++ll) {
                pg8::Gemm g{MEMB, WKV_T + (size_t)ll * 2048 * DM, MROWS, 2048, DM}; pg8::StaticOrder S; S.init(MROWS, 2048, G, (bid + ll * (G / 2)) % G, tid, MEMSSQ, rbuf);
                pg8::EpiKV E{KV + (size_t)ll * MROWS * 2048, VT + (size_t)ll * NB * 4 * 256 * 256, rbuf};
                pg8::gemm_phase<pg8::EpiKV, pg8::StaticOrder, true, true>(glds, g, S, E, tid); }
        }
        GRID_BAR(); STAMP(stamp_i); ++stamp_i;
        }
        for (int repr = 0; repr < REPR; ++repr)
        PH(3) { PHASE_VARS for (int u = bid; u < NB * 4 * 4; u += G) ret_unit(lds_all, MIXQ, PROJ2, RKT, RVT, ret_norm + l * 512, u >> 4, (u >> 2) & 3, 3 - (u & 3), tid, repr == REPR - 1); }
        for (int reps = 0; reps < REPS; ++reps)
        PH(4) { PHASE_VARS
            if (G == NB * 16) {
                const int q4 = bid & 3, base = (bid >> 2) * 128 + (q4 == 0 ? 0 : (q4 == 1 ? 24 : (q4 == 2 ? 56 : 88))), cnt = q4 == 0 ? 24 : (q4 == 3 ? 40 : 32);
                for (int i = wave; i < cnt; i += 8) { const int wu = base + i; sb_wave(lds_all + wave * 9216, MIXQ, PROJ2, SVT, sb_norm + l * 512, wu >> 9, (wu >> 6) & 7, (63 - (wu & 63)) * 32, lane, reps == REPS - 1); }
            } else {
                for (int wu = bid * 8 + wave; wu < NB * 8 * 64; wu += G * 8) sb_wave(lds_all + wave * 9216, MIXQ, PROJ2, SVT, sb_norm + l * 512, wu >> 9, (wu >> 6) & 7, (63 - (wu & 63)) * 32, lane, reps == REPS - 1);
            }
            if (G == NB * 16) {
                const int q4 = bid & 3, cnt = q4 == 0 ? 8 : (q4 == 3 ? 24 : 16), base = (bid >> 2) * 512 + (q4 == 0 ? 0 : (q4 == 1 ? 64 : (q4 == 2 ? 192 : 320))) + wave * cnt;
                table_rows_run(peer_u, peer_v, peer_norm, T8, ISC, l, base, cnt, lane);
            } else {
                for (int r = bid * 8 + wave; r < 2 * NEXP; r += G * 8) { const int tab = r >> 14, e = r & (NEXP - 1), lt = l * 2 + tab;
                    table_row_to_i8((tab ? peer_v : peer_u) + ((size_t)l * NEXP + e) * DM, tab ? nullptr : peer_norm + l * DM, T8 + (size_t)lt * 8 * NEXP * 128, ISC + (size_t)lt * NEXP, e, lane); }
            } }
        GRID_BAR(); STAMP(stamp_i); ++stamp_i;
        }
        PH(5) { PHASE_VARS  pg8::Gemm g{MIXQ, WOUT_T + (size_t)l * DM * DM, T, DM, DM}; pg8::StaticOrder S; S.init(T, DM, G, bid, tid);
            if (l == 0) { pg8::EpiResid<true> E{x, XB, SSQ}; pg8::gemm_phase<pg8::EpiResid<true>, pg8::StaticOrder, true, true>(glds, g, S, E, tid); }
            else { pg8::EpiResid<false> E{nullptr, XB, SSQ}; pg8::gemm_phase<pg8::EpiResid<false>, pg8::StaticOrder, true, true>(glds, g, S, E, tid); } }
        GRID_BAR(); STAMP(stamp_i); ++stamp_i;
        PH(6) { PHASE_VARS  pg8::Gemm g{XB, WQ_T + (size_t)l * DM * DM, T, DM, DM}; pg8::StaticOrder S; S.init(T, DM, G, bid, tid, SSQ, rbuf);
            pg8::EpiScale<false> E{Q, 1024, rbuf, 0.0625f * 1.4426950408889634f};
            pg8::gemm_phase<pg8::EpiScale<false>, pg8::StaticOrder, true, true>(glds, g, S, E, tid);
            asm volatile("s_waitcnt vmcnt(0)" ::: "memory"); __syncthreads(); __builtin_amdgcn_fence(__ATOMIC_ACQUIRE, "agent"); asm volatile("s_waitcnt vmcnt(0)" ::: "memory"); __syncthreads();
            pg8::Unit u;
            for (int rep5 = 0; rep5 < REP5; ++rep5)
            for (int i = 0; S.next(i, u); ++i) { const int b = u.pm >> 3, h = u.pn;
#pragma unroll 1
                for (int hf = 0; hf < 2; ++hf)
                    xattn_unit(lds_all, Q, KV + (size_t)l * MROWS * 2048 + (size_t)b * NMEM * 2048 + h * 256, VT + ((size_t)l * NB * 4 + b * 4 + h) * 65536, O, u.pm * 256 + hf * 128, h, tid, REP5ST || rep5 == REP5 - 1); } }
        GRID_BAR(); STAMP(stamp_i); ++stamp_i;
        PH(8) { PHASE_VARS  pg8::Gemm g{O, WO_T + (size_t)l * DM * DM, T, DM, DM}; pg8::StaticOrder S; S.init(T, DM, G, bid, tid);
            pg8::EpiResid<false> E{nullptr, XB, SSQ};
            pg8::gemm_phase<pg8::EpiResid<false>, pg8::StaticOrder, true, true>(glds, g, S, E, tid); }
        GRID_BAR(); STAMP(stamp_i); ++stamp_i;
#ifdef GPROBE
        {   PHASE_VARS  pg8::Gemm g{XB, WQ_T + (size_t)l * DM * DM, T, DM, DM}; pg8::StaticOrder S;
            if (GPROBE == 1) { S.init(T, DM, G, bid, tid, SSQ, rbuf); pg8::EpiScale<false> E{(bf16_t*)XR, 1024, rbuf, 1.0f}; pg8::gemm_phase<pg8::EpiScale<false>, pg8::StaticOrder, true, true>(glds, g, S, E, tid); }
            if (GPROBE == 2) { S.init(T, DM, G, bid, tid); pg8::EpiScale<false> E{(bf16_t*)XR, 1024, rbuf, 1.0f}; pg8::gemm_phase<pg8::EpiScale<false>, pg8::StaticOrder, true, true>(glds, g, S, E, tid); }
            if (GPROBE == 3) { S.init(T, DM, G, bid, tid); pg8::EpiMin E{(bf16_t*)XR}; pg8::gemm_phase<pg8::EpiMin, pg8::StaticOrder, true, true>(glds, g, S, E, tid); }
        }
        GRID_BAR();
#endif
        PH(9) { PHASE_VARS  pg8::Gemm g{XB, WP_T + (size_t)l * 2048 * DM, T, 2048, DM}; pg8::StaticOrder S; S.init(T, 2048, G, bid, tid, SSQ, rbuf);
            pg8::EpiScale<true> E{SCORES, 2048, rbuf, 1.0f};
            pg8::gemm_phase<pg8::EpiScale<true>, pg8::StaticOrder, true, true>(glds, g, S, E, tid);
            asm volatile("s_waitcnt vmcnt(0)" ::: "memory"); __syncthreads(); __builtin_amdgcn_fence(__ATOMIC_ACQUIRE, "agent"); asm volatile("s_waitcnt vmcnt(0)" ::: "memory"); __syncthreads();
            pg8::Unit u;
            for (int i = 0; S.next(i, u); ++i) peer_topk_fast(SCORES, IDX, GATE, u.pm * 256 + (tid >> 1), u.pn * 2 + (tid & 1)); }
        GRID_BAR(); STAMP(stamp_i); ++stamp_i;
#ifndef REP9A
#define REP9A 1
#endif
        for (int rep9a = 0; rep9a < REP9A; ++rep9a)
        PH(11) { PHASE_VARS peer_u_phase(XB, IDX, T8 + (size_t)(l * 2 + 0) * 8 * NEXP * 128, APART, bid, G, wave, lane); }
        GRID_BAR(); STAMP(stamp_i); ++stamp_i;
        for (int rep9b = 0; rep9b < REP9B; ++rep9b)
        PH(11) { PHASE_VARS for (int i = bid * 512 + tid; i < T * 32; i += G * 512) peer_combine4(APART, IDX, GATE, SSQ, ISC + (size_t)(l * 2 + 0) * NEXP, ISC + (size_t)(l * 2 + 1) * NEXP, WSC, i); }
        GRID_BAR(); STAMP(stamp_i); ++stamp_i;
        for (int rep9c = 0; rep9c < REP9C; ++rep9c)
        PH(11) { PHASE_VARS peer_v_phase(IDX, WSC, T8 + (size_t)(l * 2 + 1) * 8 * NEXP * 128, XB, SSQ, bid, G, wave, lane, rep9c == REP9C - 1); }
        GRID_BAR(); STAMP(stamp_i); ++stamp_i;
    }
    PH(12) { PHASE_VARS VB_LOOP(T / 4) d_rmsnorm_final(vb, vtid, XB, XR, final_norm); }
#ifdef PROBE_T
    STAMP(24);
    GRID_BAR();
    if (blockIdx.x == 0) {
        volatile unsigned long long* ts = (volatile unsigned long long*)(lds_all + 146432);
        const __attribute__((address_space(4))) Params* kpp = (const __attribute__((address_space(4))) Params*)__builtin_amdgcn_kernarg_segment_ptr();
        float* outp = kpp->out;
        unsigned long long d = 0;
#pragma unroll
        for (int j = 0; j < 11; ++j) if ((PROBE_MASK >> j) & 1) d += (ts[2 + j] - ts[1 + j]) + (ts[13 + j] - ts[12 + j]);
        if ((PROBE_MASK >> 11) & 1) d += ts[1] - ts[0];
        if ((PROBE_MASK >> 12) & 1) d += ts[24] - ts[0];
        if ((PROBE_MASK >> 13) & 1) d += ts[24] - ts[23];
        const float w = (float)d * 0.01f * (float)(PROBE_S);
        for (int i = wave_s * 64 + lane_id_volatile(); i < 16384; i += 512) outp[1024 + i] = w;
    }
#endif

}

extern "C" void kernel_launch(void* const* d_in, const int* in_sizes, int n_in, void* d_out, int out_size, void* d_ws, size_t ws_size, hipStream_t stream) {
    static int grid_blocks = 0;
    if (grid_blocks == 0) {
        int dev = 0, cus = 0, per_cu = 0;
        (void)hipGetDevice(&dev);
        (void)hipDeviceGetAttribute(&cus, hipDeviceAttributeMultiprocessorCount, dev);
        (void)hipFuncSetAttribute((const void*)mega, hipFuncAttributeMaxDynamicSharedMemorySize, LDS_BYTES);
        (void)hipOccupancyMaxActiveBlocksPerMultiprocessor(&per_cu, (const void*)mega, 512, LDS_BYTES);
        if (per_cu < 1) { fprintf(stderr, "occupancy query says %d blocks/CU\n", per_cu); per_cu = 1; }
        grid_blocks = cus * per_cu;
        if (ws_size < WS_END * MiB || n_in != 18) { fprintf(stderr, "bad ws_size %zu / n_in %d\n", ws_size, n_in); grid_blocks = -1; }
    }
    if (grid_blocks < 0) return;
    (void)hipMemsetAsync(d_ws, 0, 131072, stream);
    Params p{};
    for (int i = 0; i < 18; ++i) p.in[i] = (const float*)d_in[i];
    p.out = (float*)d_out; p.ws = (char*)d_ws;
    void* args[] = {&p};
    hipError_t e = hipLaunchCooperativeKernel((const void*)mega, dim3(grid_blocks), dim3(512), args, LDS_BYTES, stream);
    if (e != hipSuccess) fprintf(stderr, "cooperative launch failed: %s (grid %d)\n", hipGetErrorString(e), grid_blocks);
}
```

```cpp
#include <hip/hip_runtime.h>
#include <hip/hip_cooperative_groups.h>
#include <stdint.h>
#include <cstdio>
#include <type_traits>
namespace cg = cooperative_groups;

typedef unsigned short bf16_t;
__device__ __forceinline__ float bf2f(bf16_t v) { return __uint_as_float(((unsigned)v) << 16); }
__device__ __forceinline__ bf16_t f2bf(float f) { unsigned u = __float_as_uint(f); u = (u + 0x7fffu + ((u >> 16) & 1u)) >> 16; return (bf16_t)u; }
typedef float f32x2_cv __attribute__((ext_vector_type(2))); typedef __bf16 bf16x2_cv __attribute__((ext_vector_type(2)));
__device__ __forceinline__ unsigned pk2bf(float lo, float hi) { f32x2_cv v = {lo, hi}; bf16x2_cv b = __builtin_convertvector(v, bf16x2_cv); return __builtin_bit_cast(unsigned, b); }
typedef unsigned u32x4_nt __attribute__((ext_vector_type(4)));
__device__ __forceinline__ void nt_st16(void* p, uint4 v) { u32x4_nt t = {v.x, v.y, v.z, v.w}; __builtin_nontemporal_store(t, (u32x4_nt*)p); }
__device__ __forceinline__ float xor32_sum(float v) { auto rr = __builtin_amdgcn_permlane32_swap(__float_as_uint(v), __float_as_uint(v), false, false); return __uint_as_float(rr[0]) + __uint_as_float(rr[1]); }
__device__ __forceinline__ float xor16_sum(float v) { auto rr = __builtin_amdgcn_permlane16_swap(__float_as_uint(v), __float_as_uint(v), false, false); return __uint_as_float(rr[0]) + __uint_as_float(rr[1]); }
__device__ __forceinline__ float xor16_max(float v) { auto rr = __builtin_amdgcn_permlane16_swap(__float_as_uint(v), __float_as_uint(v), false, false); return fmaxf(__uint_as_float(rr[0]), __uint_as_float(rr[1])); }
__device__ __forceinline__ int xor16_isum(int v) { auto rr = __builtin_amdgcn_permlane16_swap((unsigned)v, (unsigned)v, false, false); return (int)(rr[0] + rr[1]); }
__device__ __forceinline__ int xor32_isum(int v) { auto rr = __builtin_amdgcn_permlane32_swap((unsigned)v, (unsigned)v, false, false); return (int)(rr[0] + rr[1]); }
__device__ __forceinline__ float xor32_max(float v) { auto rr = __builtin_amdgcn_permlane32_swap(__float_as_uint(v), __float_as_uint(v), false, false); return fmaxf(__uint_as_float(rr[0]), __uint_as_float(rr[1])); }
__device__ __forceinline__ float xor32_get(float v, int hh) { auto rr = __builtin_amdgcn_permlane32_swap(__float_as_uint(v), __float_as_uint(v), false, false); return __uint_as_float(hh ? rr[0] : rr[1]); }
__device__ __forceinline__ unsigned short f2h(float f) { _Float16 h = (_Float16)f; return __builtin_bit_cast(unsigned short, h); }
__device__ __forceinline__ float h2f(unsigned short u) { return (float)__builtin_bit_cast(_Float16, u); }

constexpr int NB = 16, SEQ = 2048, DM = 1024, T = NB * SEQ, NL = 2, NMEM = 256, INC = 3584, MROWS = NB * NMEM;
constexpr float EPS = 1e-6f;

template <int CTRL> __device__ __forceinline__ float wdpp_f(float v) { return __builtin_bit_cast(float, __builtin_amdgcn_update_dpp(0, __builtin_bit_cast(int, v), CTRL, 0xF, 0xF, false)); }
__device__ __forceinline__ float wave_sum(float v) {
    v += wdpp_f<0xB1>(v); v += wdpp_f<0x4E>(v); v += wdpp_f<0x141>(v); v += wdpp_f<0x140>(v);
    return xor32_sum(xor16_sum(v));
}
__device__ __forceinline__ float wave_max(float v) {
    v = fmaxf(v, wdpp_f<0xB1>(v)); v = fmaxf(v, wdpp_f<0x4E>(v)); v = fmaxf(v, wdpp_f<0x141>(v)); v = fmaxf(v, wdpp_f<0x140>(v));
    return xor32_max(xor16_max(v));
}
namespace pg8 {
#define PG8_LAS __attribute__((address_space(3)))
typedef unsigned short bf16_t;
typedef short bf16x8 __attribute__((ext_vector_type(8)));
typedef float f32x4 __attribute__((ext_vector_type(4)));
typedef int i32x4 __attribute__((ext_vector_type(4)));
__device__ __forceinline__ f32x4 tof(f32x4 v) { return v; }
__device__ __forceinline__ f32x4 tof(i32x4 v) { return __builtin_convertvector(v, f32x4); }
typedef unsigned u32x4 __attribute__((ext_vector_type(4)));
constexpr int BM = 256, BK = 64, HALF = 128, HTB = HALF * BK * 2  , STAGE_BYTES = 8 * HTB, NXCD = 8, WGM = 8;

__host__ __device__ __forceinline__ int lds_byte(int r, int c) { const int st = (r >> 4) * 2 + (c >> 5), rr = r & 15, cc = c & 31, ob = rr * 64 + cc * 2; return st * 1024 + (ob ^ (((ob >> 9) & 1) << 5)); }
__host__ __device__ __forceinline__ void stage_rc(int b, int& R, int& C) { const int st = b / 1024, sb = b % 1024, swz = sb ^ (((sb >> 9) & 1) << 5); R = (st >> 1) * 16 + swz / 64; C = (st & 1) * 32 + (swz % 64) / 2; }
__host__ __device__ __forceinline__ int perm32(int rho) { const int n = rho >> 4, i = rho & 15; return 8 * (i >> 2) + 4 * n + (i & 3); }

struct Unit { int pm, pn; };
struct Gemm { const bf16_t* A; const bf16_t* Bt; int M, N, K; };

struct StaticOrder {
    int nM, nN, nwg, G, c;
    __host__ __device__ __forceinline__ void init(int M, int N, int G_, int c_, int tid_in, const float* ssq = nullptr, PG8_LAS float* rb = nullptr, const float* xs = nullptr, const float* cs = nullptr) { tidm = tid_in; SSQ = ssq; rbuf = rb; XS = xs; CS = cs; nM = M / BM; nN = N / BM; nwg = nM * nN; G = G_; c = c_; }
    __host__ __device__ __forceinline__ bool next(int i, Unit& u) const {
        const long L = (long)i * G + c; if (L >= nwg) return false;
        int wgid = (int)L; { const int q = nwg / NXCD, r = nwg % NXCD, xcd = wgid % NXCD, off = wgid / NXCD; wgid = (xcd < r ? xcd * (q + 1) : r * (q + 1) + (xcd - r) * q) + off; }
        const int nig = WGM * nN, gid = wgid / nig, fm = gid * WGM, gsz = (nM - fm) < WGM ? (nM - fm) : WGM;
        u.pm = fm + ((wgid % nig) % gsz); u.pn = (wgid % nig) / gsz; return true;
    }
    const float* XS;
    const float* CS;
    int tidm; const float* SSQ; PG8_LAS float* rbuf;
    __device__ __forceinline__ void a_ready(const Unit& u, int ui) const {
        if (SSQ) { const int t = tidm; if (t < 256) { const f32x4* p = (const f32x4*)(SSQ + (size_t)(u.pm * BM + t) * 16); const f32x4 a = p[0], b = p[1], c = p[2], d = p[3];
            const float xs = XS ? XS[u.pm * BM + t] : 1.0f; const float cs = CS ? CS[u.pn * BM + t] : 0.f;
            const float q = ((a[0] + a[1]) + (a[2] + a[3])) + ((b[0] + b[1]) + (b[2] + b[3])) + ((c[0] + c[1]) + (c[2] + c[3])) + ((d[0] + d[1]) + (d[2] + d[3]));
            rbuf[(ui & 1) * 256 + t] = rsqrtf(q * (1.0f / 1024.0f) + 1e-6f) * xs; if (CS) rbuf[512 + (ui & 1) * 256 + t] = cs; } }
    }
    __device__ __forceinline__ void done(const Unit&) const {}
};

__device__ __forceinline__ unsigned cvt_pk_bf16(float lo, float hi) { unsigned r; asm volatile("v_cvt_pk_bf16_f32 %0, %1, %2" : "=v"(r) : "v"(lo), "v"(hi)); return r; }
typedef float f32x2 __attribute__((ext_vector_type(2)));
template <class Epi, class Sched, bool ALIGN_EPI = false, bool SP2 = false, bool I8 = false>
__device__ __forceinline__ void gemm_phase(PG8_LAS unsigned char* lds, const Gemm g, const Sched& S, const Epi& E, const int tid_in) {
    int tid_l = tid_in; asm volatile("" : "+v"(tid_l));
    const int tid = tid_l, wid = __builtin_amdgcn_readfirstlane(tid >> 6), lane = tid & 63, wr = wid >> 2, wc = wid & 3, fr = lane & 15, fq = lane >> 4;
    const int K = g.K, nt = K / BK;
    unsigned voffA[2], voffB[2];
#pragma unroll
    for (int i = 0; i < 2; ++i) { int R, C; stage_rc(tid * 16 + i * 8192, R, C); const int Rb = Epi::PERM ? ((R & ~31) + perm32(R & 31)) : R;
        voffA[i] = (unsigned)(R * K + C) * 2u; voffB[i] = (unsigned)(Rb * K + C) * 2u; }
    const size_t kstep = (size_t)(BK * 2);
    const size_t hstep = (size_t)HALF * K * 2;
    const size_t tstep = 2 * hstep;
    const unsigned ldsw = (unsigned)wid * 1024u;
    const int aoff = lds_byte(wr * 64 + fr, fq * 8), boff = lds_byte(wc * 32 + fr, fq * 8);
#define PG8_SA(b, h) (((b) * 2 + (h)) * HTB)
#define PG8_SB(b, h) ((4 + (b) * 2 + (h)) * HTB)
#define PG8_STAGE(bufoff, gbase, voff) do { _Pragma("unroll") for (int _i = 0; _i < 2; ++_i) \
        __builtin_amdgcn_global_load_lds((const unsigned*)((const char*)(gbase) + (voff)[_i]), (PG8_LAS unsigned*)(lds + (bufoff) + ldsw + _i * 8192), 16, 0, 0); } while (0)
#define PG8_LDA(dst, b, h) do { _Pragma("unroll") for (int m = 0; m < 4; ++m) _Pragma("unroll") for (int k = 0; k < 2; ++k) dst[m][k] = *(const PG8_LAS bf16x8*)(lds + PG8_SA(b, h) + aoff + m * 2048 + k * 1024); } while (0)
#define PG8_LDB(dst, b, h) do { _Pragma("unroll") for (int n = 0; n < 2; ++n) _Pragma("unroll") for (int k = 0; k < 2; ++k) dst[n][k] = *(const PG8_LAS bf16x8*)(lds + PG8_SB(b, h) + boff + n * 2048 + k * 1024); } while (0)
#define PG8_MMA(ai, bj, At, Bt) do { __builtin_amdgcn_s_setprio(1); _Pragma("unroll") for (int m = 0; m < 4; ++m) _Pragma("unroll") for (int n = 0; n < 2; ++n) _Pragma("unroll") for (int k = 0; k < 2; ++k) \
        { if constexpr (I8) acc[ai][bj][m][n] = __builtin_bit_cast(acc_t, __builtin_amdgcn_mfma_i32_16x16x64_i8(__builtin_bit_cast(i32x4, Bt[n][k]), __builtin_bit_cast(i32x4, At[m][k]), __builtin_bit_cast(i32x4, acc[ai][bj][m][n]), 0, 0, 0)); \
          else acc[ai][bj][m][n] = __builtin_bit_cast(acc_t, __builtin_amdgcn_mfma_f32_16x16x32_bf16(Bt[n][k], At[m][k], __builtin_bit_cast(f32x4, acc[ai][bj][m][n]), 0, 0, 0)); } __builtin_amdgcn_s_setprio(0); } while (0)
#define PG8_WAIT_V(n) asm volatile("s_waitcnt vmcnt(" #n ")" ::: "memory")
#define PG8_WAIT_L(n) asm volatile("s_waitcnt lgkmcnt(" #n ")" ::: "memory")
#define PG8_BAR __builtin_amdgcn_s_barrier()
#define PG8_SCHED __builtin_amdgcn_sched_barrier(0)
    Unit cur, nxt; int ui = 0;
    if (!S.next(0, cur)) return;
    typedef typename std::conditional<I8, i32x4, f32x4>::type acc_t;
    acc_t acc[2][2][4][2];
#pragma unroll
    for (int a = 0; a < 2; ++a)
#pragma unroll
        for (int b = 0; b < 2; ++b)
#pragma unroll
            for (int m = 0; m < 4; ++m)
#pragma unroll
                for (int n = 0; n < 2; ++n) acc[a][b][m][n] = acc_t{};
    bf16x8 At[4][2], B0[2][2], B1[2][2];
    const char* cA = (const char*)g.A + (size_t)cur.pm * tstep; const char* cB = (const char*)g.Bt + (size_t)cur.pn * tstep;
    S.a_ready(cur, 0);
    if constexpr (SP2) {
        PG8_STAGE(PG8_SB(0, 0), cB, voffB); PG8_STAGE(PG8_SB(0, 1), cB + hstep, voffB); PG8_STAGE(PG8_SA(0, 0), cA, voffA); PG8_STAGE(PG8_SA(0, 1), cA + hstep, voffA);
        if (wr == 1) PG8_BAR;
        PG8_WAIT_V(2); PG8_BAR;
        PG8_STAGE(PG8_SB(1, 0), cB + kstep, voffB); PG8_STAGE(PG8_SA(1, 0), cA + kstep, voffA); PG8_STAGE(PG8_SB(1, 1), cB + hstep + kstep, voffB);
        PG8_WAIT_V(6); PG8_BAR;
    } else {
        PG8_STAGE(PG8_SB(0, 0), cB, voffB); PG8_STAGE(PG8_SA(0, 0), cA, voffA); PG8_STAGE(PG8_SB(0, 1), cB + hstep, voffB); PG8_STAGE(PG8_SA(0, 1), cA + hstep, voffA);
        if (wr == 1) PG8_BAR;
        PG8_WAIT_V(4); PG8_BAR;
        PG8_STAGE(PG8_SB(1, 0), cB + kstep, voffB); PG8_STAGE(PG8_SA(1, 0), cA + kstep, voffA); PG8_STAGE(PG8_SB(1, 1), cB + hstep + kstep, voffB);
        PG8_WAIT_V(6); PG8_BAR;
    }
    for (;;) {
        const bool has_next = S.next(ui + 1, nxt);
        const char* nA = has_next ? (const char*)g.A + (size_t)nxt.pm * tstep : cA; const char* nB = has_next ? (const char*)g.Bt + (size_t)nxt.pn * tstep : cB;
        for (int t = 0; t < nt; t += 2) {
            const bool last = (t == nt - 2);
            const char* a1 = cA + (size_t)(t + 1) * kstep;
            const char* a2 = last ? nA : cA + (size_t)(t + 2) * kstep; const char* b2 = last ? nB : cB + (size_t)(t + 2) * kstep;
            const char* a3 = a2 + kstep; const char* b3 = b2 + kstep;
            if (last && has_next) S.a_ready(nxt, ui + 1);
            if constexpr (SP2) {
            PG8_LDB(B0, 0, 0); PG8_LDB(B1, 0, 1); PG8_SCHED; PG8_LDA(At, 0, 0); PG8_STAGE(PG8_SA(1, 1), a1 + hstep, voffA);
            PG8_WAIT_V(8); PG8_WAIT_L(0); PG8_BAR; PG8_MMA(0, 0, At, B0); PG8_MMA(0, 1, At, B1); PG8_BAR; PG8_SCHED;
            PG8_LDA(At, 0, 1); PG8_STAGE(PG8_SB(0, 0), b2, voffB); PG8_STAGE(PG8_SB(0, 1), b2 + hstep, voffB); PG8_STAGE(PG8_SA(0, 0), a2, voffA);
            PG8_WAIT_V(8); PG8_WAIT_L(0); PG8_BAR; PG8_MMA(1, 0, At, B0); PG8_MMA(1, 1, At, B1); PG8_BAR; PG8_SCHED;
            PG8_LDB(B0, 1, 0); PG8_LDB(B1, 1, 1); PG8_SCHED; PG8_LDA(At, 1, 0); PG8_STAGE(PG8_SA(0, 1), a2 + hstep, voffA);
            PG8_WAIT_V(8); PG8_WAIT_L(0); PG8_BAR; PG8_MMA(0, 0, At, B0); PG8_MMA(0, 1, At, B1); PG8_BAR; PG8_SCHED;
            PG8_LDA(At, 1, 1); PG8_STAGE(PG8_SB(1, 0), b3, voffB); PG8_STAGE(PG8_SB(1, 1), b3 + hstep, voffB); PG8_STAGE(PG8_SA(1, 0), a3, voffA);
            PG8_WAIT_V(8); PG8_WAIT_L(0); PG8_BAR; PG8_MMA(1, 0, At, B0); PG8_MMA(1, 1, At, B1); PG8_BAR; PG8_SCHED;
            } else {
            PG8_LDB(B0, 0, 0); PG8_SCHED; PG8_LDA(At, 0, 0); PG8_STAGE(PG8_SA(1, 1), a1 + hstep, voffA);
            PG8_WAIT_L(8); PG8_BAR; PG8_WAIT_L(0); PG8_MMA(0, 0, At, B0); PG8_BAR; PG8_SCHED;
            PG8_LDB(B1, 0, 1); PG8_STAGE(PG8_SB(0, 0), b2, voffB);
            PG8_BAR; PG8_WAIT_L(0); PG8_MMA(0, 1, At, B1); PG8_BAR;
            PG8_LDA(At, 0, 1); PG8_STAGE(PG8_SA(0, 0), a2, voffA);
            PG8_BAR; PG8_WAIT_L(0); PG8_MMA(1, 0, At, B0); PG8_BAR; PG8_SCHED;
            PG8_STAGE(PG8_SB(0, 1), b2 + hstep, voffB);
            PG8_WAIT_V(6); PG8_BAR; PG8_MMA(1, 1, At, B1); PG8_BAR;
            PG8_LDB(B0, 1, 0); PG8_SCHED; PG8_LDA(At, 1, 0); PG8_STAGE(PG8_SA(0, 1), a2 + hstep, voffA);
            PG8_WAIT_L(8); PG8_BAR; PG8_WAIT_L(0); PG8_MMA(0, 0, At, B0); PG8_BAR; PG8_SCHED;
            PG8_LDB(B1, 1, 1); PG8_STAGE(PG8_SB(1, 0), b3, voffB);
            PG8_BAR; PG8_WAIT_L(0); PG8_MMA(0, 1, At, B1); PG8_BAR;
            PG8_LDA(At, 1, 1); PG8_STAGE(PG8_SA(1, 0), a3, voffA);
            PG8_BAR; PG8_WAIT_L(0); PG8_MMA(1, 0, At, B0); PG8_BAR; PG8_SCHED;
            PG8_STAGE(PG8_SB(1, 1), b3 + hstep, voffB);
            PG8_WAIT_V(6); PG8_BAR; PG8_MMA(1, 1, At, B1); PG8_BAR;
            }
        }
        if constexpr (ALIGN_EPI) { if (wr == 0) PG8_BAR; }
        if constexpr (!Epi::AFTER_DRAIN) { E(acc, cur, wr, wc, fr, fq, ui); S.done(cur); }
        if (!has_next) break;
#pragma unroll
        for (int a = 0; a < 2; ++a)
#pragma unroll
            for (int b = 0; b < 2; ++b)
#pragma unroll
                for (int m = 0; m < 4; ++m)
#pragma unroll
                    for (int n = 0; n < 2; ++n) acc[a][b][m][n] = acc_t{};
        cur = nxt; cA = nA; cB = nB; ++ui;
        if constexpr (ALIGN_EPI) { if (wr == 1) PG8_BAR; }
    }
    PG8_WAIT_V(0);
    if constexpr (!ALIGN_EPI) { if (wr == 0) PG8_BAR; }
    PG8_BAR;
    if constexpr (Epi::AFTER_DRAIN) { E.fused(acc, cur, wr, wc, fr, fq, lds, wid, lane); S.done(cur); }
#undef PG8_SA
#undef PG8_SB
#undef PG8_STAGE
#undef PG8_LDA
#undef PG8_LDB
#undef PG8_MMA
#undef PG8_WAIT_V
#undef PG8_WAIT_L
#undef PG8_BAR
#undef PG8_SCHED
}
}
namespace pg8 {
struct EpiProj {
    static constexpr bool PERM = true, AFTER_DRAIN = false;
    bf16_t* MIXQ; bf16_t* PROJ2; bf16_t* SVT; bf16_t* RKT; bf16_t* RVT; const PG8_LAS float* rbuf; const float* WMAX; PG8_LAS unsigned char* tbuf;
    template <class AccT> __device__ __forceinline__ void operator()(const AccT (&acc)[2][2][4][2], const Unit& u, int wr, int wc, int fr, int fq, int ui) const {
        int lr0 = wr * 64 + fr, cl0 = wc * 32 + 8 * fq; asm volatile("" : "+v"(lr0), "+v"(cl0));
        const int row0 = u.pm * BM + lr0; const int pn = u.pn;
        const bool rowmajor = !(pn == 4 || pn == 5 || pn == 10 || pn == 11);
        if (rowmajor) { if (pn >= 6 && pn < 10) rows<true>(acc, u, lr0, cl0, ui); else rows<false>(acc, u, lr0, cl0, ui); }
        if (pn == 8 || pn == 9) trans<true>(acc, u, wr, wc, fr, fq, ui); else if (pn == 4 || pn == 5 || pn == 10 || pn == 11) trans<false>(acc, u, wr, wc, fr, fq, ui);
    }
    template <bool ROT, class AccT> __device__ __forceinline__ void rows(const AccT (&acc)[2][2][4][2], const Unit& u, int lr0, int cl0, int ui) const {
        const int row0 = u.pm * BM + lr0; const int pn = u.pn;
        f32x4 wsc[2][2];
#pragma unroll
        for (int bj = 0; bj < 2; ++bj) { const PG8_LAS f32x4* wp = (const PG8_LAS f32x4*)(rbuf + 512 + (ui & 1) * 256 + bj * HALF + cl0); wsc[bj][0] = wp[0]; wsc[bj][1] = wp[1]; }
        const PG8_LAS float* rb = rbuf + (ui & 1) * 256 + lr0;
        float f[4] = {0.f, 0.f, 0.f, 0.f};
        if (ROT) {
#pragma unroll
            for (int jj = 0; jj < 4; ++jj) f[jj] = exp2f(-(float)(2 * ((cl0 >> 1) + jj)) * (13.287712379549449f / 128.0f)) * 0.15915494309189535f;
        }
        const float sc = pn < 2 ? 0.125f * 1.4426950408889634f : ((pn == 8 || pn == 9) ? 0.08838834764831845f : 1.0f);
        const int s0 = row0 & (SEQ - 1);
        const bool toP = (pn >= 2 && pn < 4) || pn >= 8;
        const int dcol = pn < 2 ? pn * 256 : (pn < 4 ? (pn - 2) * 256 : (pn < 8 ? 512 + (pn - 6) * 256 : (pn < 10 ? 512 + (pn - 8) * 256 : 1024 + (pn - 12) * 256)));
        const size_t dstride = toP ? 1536 * 2 : 1024 * 2;
        char* dptr = (char*)MIXQ + (toP ? ((size_t)64 << 20) : (size_t)0) + (size_t)row0 * dstride + (size_t)(dcol + cl0) * 2;
#pragma unroll
        for (int ai = 0; ai < 2; ++ai)
#pragma unroll
            for (int m = 0; m < 4; ++m) {
                const int spos = s0 + ai * HALF + m * 16; const float r = rb[ai * HALF + m * 16] * sc;
                float cs[4] = {1.f, 1.f, 1.f, 1.f}, sn[4] = {0.f, 0.f, 0.f, 0.f};
                if (ROT) {
#pragma unroll
                    for (int jj = 0; jj < 4; ++jj) { const float xr = __builtin_amdgcn_fractf((float)spos * f[jj]); cs[jj] = __builtin_amdgcn_cosf(xr); sn[jj] = __builtin_amdgcn_sinf(xr); }
                }
#pragma unroll
                for (int bj = 0; bj < 2; ++bj) {
                    const f32x4 a = tof(acc[ai][bj][m][0]) * (wsc[bj][0] * r), b = tof(acc[ai][bj][m][1]) * (wsc[bj][1] * r); f32x4 v0 = a, v1 = b;
                    if (ROT) {
                        v0[0] = a[0] * cs[0] - a[1] * sn[0]; v0[1] = a[0] * sn[0] + a[1] * cs[0]; v0[2] = a[2] * cs[1] - a[3] * sn[1]; v0[3] = a[2] * sn[1] + a[3] * cs[1];
                        v1[0] = b[0] * cs[2] - b[1] * sn[2]; v1[1] = b[0] * sn[2] + b[1] * cs[2]; v1[2] = b[2] * cs[3] - b[3] * sn[3]; v1[3] = b[2] * sn[3] + b[3] * cs[3];
                    }
                    u32x4 w; w.x = pk2bf(v0[0], v0[1]); w.y = pk2bf(v0[2], v0[3]); w.z = pk2bf(v1[0], v1[1]); w.w = pk2bf(v1[2], v1[3]);
                    __builtin_nontemporal_store(w, (u32x4*)(dptr + (size_t)(ai * HALF + m * 16) * dstride + bj * (HALF * 2)));
                }
            }
    }
    template <bool isK, class AccT> __device__ __forceinline__ void trans(const AccT (&acc)[2][2][4][2], const Unit& u, int wr, int wc, int fr, int fq, int ui) const {
        int lr0 = wr * 64 + fr, lane = fq * 16 + fr, cl0 = wc * 32 + 8 * fq; asm volatile("" : "+v"(lr0), "+v"(lane), "+v"(cl0));
        const int pn = u.pn; const bool isSV = (pn < 8); const float sc = isK ? 0.08838834764831845f : 1.0f;
        const int row0 = u.pm * BM + lr0, bb = row0 >> 11, s0 = row0 & (SEQ - 1), sw = (u.pm * BM + wr * 64) & (SEQ - 1);
        const PG8_LAS float* rb = rbuf + (ui & 1) * 256 + lr0;
        PG8_LAS unsigned char* tb = tbuf + (wr * 4 + wc) * 1152;
        PG8_LAS unsigned char* tw = tb + (2 * fq) * 144 + fr * 2;
        const PG8_LAS unsigned char* tr = tb + (lane >> 3) * 144 + (lane & 7) * 16;
        const int rr = lane >> 3;
        const PG8_LAS float* cb = rbuf + 512 + (ui & 1) * 256 + cl0;
#pragma unroll
        for (int ai = 0; ai < 2; ++ai)
#pragma unroll
            for (int bj = 0; bj < 2; ++bj) {
                const int hd = (pn & 1) * 2 + bj;
                bf16_t* M; int rowbase;
                M = (bf16_t*)((char*)SVT + (isSV ? (size_t)0 : (isK ? ((size_t)64 << 20) : ((size_t)32 << 20))));
                if (isSV) rowbase = (bb * 8 + (pn - 4) * 4 + bj * 2 + (wc >> 1)) * 64 + (wc & 1) * 32;
                else rowbase = (bb * 4 + hd) * 128 + wc * 32;
                float z[4] = {1.f, 1.f, 1.f, 1.f}, rs[4];
                const float lg = log2f(1.0f - exp2f(-5.0f - (float)hd));
#pragma unroll
                for (int m = 0; m < 4; ++m) { rs[m] = rb[ai * HALF + m * 16] * sc; if (isK) z[m] = exp2f((float)(127 - ((s0 + ai * HALF + m * 16) & 127)) * lg); }
#pragma unroll
                for (int n = 0; n < 2; ++n)
#pragma unroll
                    for (int ch = 0; ch < 2; ++ch) {
                        const f32x2 wv = *(const PG8_LAS f32x2*)(cb + bj * HALF + 4 * n + 2 * ch); const float w0 = wv[0], w1 = wv[1];
                        const float fj = isK ? exp2f(-(float)(2 * ((cl0 >> 1) + 2 * n + ch)) * (13.287712379549449f / 128.0f)) * 0.15915494309189535f : 0.f;
#pragma unroll
                        for (int m = 0; m < 4; ++m) {
                            const f32x4 av = tof(acc[ai][bj][m][n]);
                            float x0 = av[2 * ch] * w0 * rs[m], x1 = av[2 * ch + 1] * w1 * rs[m];
                            if (isK) { const float xr = __builtin_amdgcn_fractf((float)(s0 + ai * HALF + m * 16) * fj); const float cs = __builtin_amdgcn_cosf(xr), sn = __builtin_amdgcn_sinf(xr);
                                const float y0 = x0 * cs - x1 * sn, y1 = x0 * sn + x1 * cs; x0 = y0 * z[m]; x1 = y1 * z[m]; }
                            const unsigned w = pk2bf(x0, x1);
                            *(PG8_LAS unsigned short*)(tw + m * 32) = (unsigned short)w; *(PG8_LAS unsigned short*)(tw + 144 + m * 32) = (unsigned short)(w >> 16);
                        }
                        const u32x4 v = *(const PG8_LAS u32x4*)tr;
                        __builtin_nontemporal_store(v, (u32x4*)(M + (size_t)(rowbase + 8 * (rr >> 1) + 4 * n + 2 * ch + (rr & 1)) * SEQ + sw + ai * HALF + 8 * (lane & 7)));
                        asm volatile("" ::: "memory");
                    }
            }
    }
};
template <bool SRC_F32> struct EpiResid {
    static constexpr bool PERM = true, AFTER_DRAIN = false;
    const float* srcf; bf16_t* XB; float* SSQ;
    struct f32x8 { f32x4 a, b; };
    typedef typename std::conditional<SRC_F32, f32x8, u32x4>::type res_t;
    __device__ __forceinline__ res_t ld(size_t off) const { if constexpr (SRC_F32) { f32x8 r; r.a = *(const f32x4*)(srcf + off); r.b = *(const f32x4*)(srcf + off + 4); return r; } else return *(const u32x4*)(XB + off); }
    __device__ __forceinline__ void operator()(const f32x4 (&acc)[2][2][4][2], const Unit& u, int wr, int wc, int fr, int fq, int ui) const {
        int lr0 = wr * 64 + fr, cl0 = wc * 32 + 8 * fq; asm volatile("" : "+v"(lr0), "+v"(cl0));
        const int row0 = u.pm * BM + lr0; const int col0 = u.pn * BM + cl0;
        constexpr int MB = SRC_F32 ? 4 : 8;
#pragma unroll
        for (int b0 = 0; b0 < 8; b0 += MB) {
            res_t rs[MB][2];
#pragma unroll
            for (int mm = 0; mm < MB; ++mm)
#pragma unroll
                for (int bj = 0; bj < 2; ++bj) rs[mm][bj] = ld((size_t)(row0 + ((b0 + mm) >> 2) * HALF + ((b0 + mm) & 3) * 16) * 1024 + col0 + bj * HALF);
#pragma unroll
            for (int mm = 0; mm < MB; ++mm) {
                const int ai = (b0 + mm) >> 2, m = (b0 + mm) & 3;
                const int row = row0 + ai * HALF + m * 16; float ss = 0.f;
#pragma unroll
                for (int bj = 0; bj < 2; ++bj) {
                    const size_t off = (size_t)row * 1024 + col0 + bj * HALF;
                    f32x4 o0, o1;
                    if constexpr (SRC_F32) { o0 = rs[mm][bj].a; o1 = rs[mm][bj].b; }
                    else { const u32x4 w = rs[mm][bj]; o0[0] = __uint_as_float(w.x << 16); o0[1] = __uint_as_float(w.x & 0xFFFF0000u); o0[2] = __uint_as_float(w.y << 16); o0[3] = __uint_as_float(w.y & 0xFFFF0000u);
                        o1[0] = __uint_as_float(w.z << 16); o1[1] = __uint_as_float(w.z & 0xFFFF0000u); o1[2] = __uint_as_float(w.w << 16); o1[3] = __uint_as_float(w.w & 0xFFFF0000u); }
                    o0 = o0 + acc[ai][bj][m][0]; o1 = o1 + acc[ai][bj][m][1];
                    u32x4 w; w.x = pk2bf(o0[0], o0[1]); w.y = pk2bf(o0[2], o0[3]); w.z = pk2bf(o1[0], o1[1]); w.w = pk2bf(o1[2], o1[3]); *(u32x4*)(XB + off) = w;
                    const float r0 = __uint_as_float(w.x << 16), r1 = __uint_as_float(w.x & 0xFFFF0000u), r2 = __uint_as_float(w.y << 16), r3 = __uint_as_float(w.y & 0xFFFF0000u);
                    const float r4 = __uint_as_float(w.z << 16), r5 = __uint_as_float(w.z & 0xFFFF0000u), r6 = __uint_as_float(w.w << 16), r7 = __uint_as_float(w.w & 0xFFFF0000u);
                    ss += ((r0 * r0 + r1 * r1) + (r2 * r2 + r3 * r3)) + ((r4 * r4 + r5 * r5) + (r6 * r6 + r7 * r7));
                }
                ss = xor16_sum(ss); ss = xor32_sum(ss);
                if (fq == 0) SSQ[(size_t)row * 16 + u.pn * 4 + wc] = ss;
                asm volatile("" ::: "memory");
            }
            asm volatile("" ::: "memory");
        }
    }
};
template <bool F16> struct EpiScale {
    static constexpr bool PERM = true, AFTER_DRAIN = false;
    bf16_t* O; int ldc; const PG8_LAS float* rbuf; float scale;
    __device__ __forceinline__ void operator()(const f32x4 (&acc)[2][2][4][2], const Unit& u, int wr, int wc, int fr, int fq, int ui) const {
        int lr0 = wr * 64 + fr, cl0 = wc * 32 + 8 * fq; asm volatile("" : "+v"(lr0), "+v"(cl0));
        const int row0 = u.pm * BM + lr0; const int col0 = u.pn * BM + cl0;
        const PG8_LAS float* rb = rbuf + (ui & 1) * 256 + lr0;
#pragma unroll
        for (int ai = 0; ai < 2; ++ai)
#pragma unroll
            for (int m = 0; m < 4; ++m) {
                const int row = row0 + ai * HALF + m * 16; const float r = rb[ai * HALF + m * 16] * scale;
#pragma unroll
                for (int bj = 0; bj < 2; ++bj) {
                    const f32x4 v0 = acc[ai][bj][m][0] * r, v1 = acc[ai][bj][m][1] * r; u32x4 w;
                    if (F16) { w.x = (unsigned)f2h(v0[0]) | ((unsigned)f2h(v0[1]) << 16); w.y = (unsigned)f2h(v0[2]) | ((unsigned)f2h(v0[3]) << 16); w.z = (unsigned)f2h(v1[0]) | ((unsigned)f2h(v1[1]) << 16); w.w = (unsigned)f2h(v1[2]) | ((unsigned)f2h(v1[3]) << 16); }
                    else { w.x = pk2bf(v0[0], v0[1]); w.y = pk2bf(v0[2], v0[3]); w.z = pk2bf(v1[0], v1[1]); w.w = pk2bf(v1[2], v1[3]); }
                    *(u32x4*)(O + (size_t)row * ldc + col0 + bj * HALF) = w;
                }
            }
    }
};
}
namespace pg8 {
struct EpiKV {
    static constexpr bool PERM = true, AFTER_DRAIN = false;
    bf16_t* KVl; bf16_t* VTl; const PG8_LAS float* rbuf;
    __device__ __forceinline__ void operator()(const f32x4 (&acc)[2][2][4][2], const Unit& u, int wr, int wc, int fr, int fq, int ui) const {
        int lr0 = wr * 64 + fr; int cl0 = wc * 32 + 8 * fq; asm volatile("" : "+v"(lr0), "+v"(cl0));
        const int row0 = u.pm * BM + lr0;
        const PG8_LAS float* rb = rbuf + (ui & 1) * 256 + lr0;
#pragma unroll
        for (int ai = 0; ai < 2; ++ai)
#pragma unroll
            for (int m = 0; m < 4; ++m) {
                const int lr = lr0 + ai * HALF + m * 16; const float r = rb[ai * HALF + m * 16];
#pragma unroll
                for (int bj = 0; bj < 2; ++bj) {
                    const f32x4 v0 = acc[ai][bj][m][0] * r, v1 = acc[ai][bj][m][1] * r;
                    if (u.pn < 4) { u32x4 w; w.x = pk2bf(v0[0], v0[1]); w.y = pk2bf(v0[2], v0[3]); w.z = pk2bf(v1[0], v1[1]); w.w = pk2bf(v1[2], v1[3]);
                        *(u32x4*)(KVl + (size_t)(row0 + ai * HALF + m * 16) * 2048 + u.pn * BM + cl0 + bj * HALF) = w; }
                    else { bf16_t* vt = VTl + ((size_t)(u.pm * 4 + (u.pn - 4)) * 256 + cl0 + bj * HALF) * 256 + lr;
                        vt[0 * 256] = f2bf(v0[0]); vt[1 * 256] = f2bf(v0[1]); vt[2 * 256] = f2bf(v0[2]); vt[3 * 256] = f2bf(v0[3]);
                        vt[4 * 256] = f2bf(v1[0]); vt[5 * 256] = f2bf(v1[1]); vt[6 * 256] = f2bf(v1[2]); vt[7 * 256] = f2bf(v1[3]); }
                }
            }
    }
};
struct EpiMin {
    static constexpr bool PERM = true, AFTER_DRAIN = false;
    bf16_t* O;
    __device__ __forceinline__ void operator()(const f32x4 (&acc)[2][2][4][2], const Unit& u, int wr, int wc, int fr, int fq, int ui) const {
        f32x4 t = acc[0][0][0][0];
#pragma unroll
        for (int ai = 0; ai < 2; ++ai)
#pragma unroll
            for (int bj = 0; bj < 2; ++bj)
#pragma unroll
                for (int m = 0; m < 4; ++m)
#pragma unroll
                    for (int n = 0; n < 2; ++n) t = t + acc[ai][bj][m][n];
        *(f32x4*)(O + ((size_t)(u.pm * BM + wr * 64 + fr) * 1024 + u.pn * BM + wc * 32 + 8 * fq)) = t;
    }
};
}
__device__ __forceinline__ int win_colmap(int n) { if (n < 1536 || n >= 2560) return n; const int hb = n & ~127, j = n & 127; return hb + (j >> 1) + 64 * (j & 1); }
__device__ __forceinline__ void tr_item(const float* __restrict__ W, int K, int N, const float* __restrict__ g, bool perm, bf16_t* __restrict__ WT, float* scr, int item, int lane) {
    const int nblk = N / 32, kb = item / nblk, nb = item % nblk, k0 = 64 * kb, n0 = 32 * nb;
    const int k8 = lane >> 3, q = lane & 7;
    float4 v[8]; float gg[8];
#pragma unroll
    for (int i = 0; i < 8; ++i) { const int kk = 8 * i + k8; v[i] = *(const float4*)(W + (size_t)(k0 + kk) * N + n0 + 4 * q); gg[i] = g ? g[k0 + kk] : 1.0f; }
#pragma unroll
    for (int i = 0; i < 8; ++i) { float* d = scr + (8 * i + k8) * 33 + 4 * q; d[0] = v[i].x * gg[i]; d[1] = v[i].y * gg[i]; d[2] = v[i].z * gg[i]; d[3] = v[i].w * gg[i]; }
    asm volatile("s_waitcnt lgkmcnt(0)" ::: "memory");
    const int c = lane & 7;
#pragma unroll
    for (int j = 0; j < 4; ++j) { const int n = (lane >> 3) + 8 * j; const float* s = scr + (8 * c) * 33 + n;
        uint4 o; o.x = pk2bf(s[0 * 33], s[1 * 33]); o.y = pk2bf(s[2 * 33], s[3 * 33]); o.z = pk2bf(s[4 * 33], s[5 * 33]); o.w = pk2bf(s[6 * 33], s[7 * 33]);
        *(uint4*)(WT + (size_t)(n0 + n) * K + k0 + 8 * c) = o; }
    asm volatile("s_waitcnt lgkmcnt(0)" ::: "memory");
}
__device__ __forceinline__ int win_colmap_inv(int ns) { if (ns < 1536 || ns >= 2560) return ns; const int hb = ns & ~127, sj = ns & 127; return hb + (sj < 64 ? 2 * sj : 2 * (sj - 64) + 1); }
__device__ __forceinline__ void wmax_item(const float* __restrict__ W, int K, int N, const float* __restrict__ g, float* WMAXl, int item, int lane) {
    const int nblk = N / 256, kb = item / nblk, nb = item % nblk, k0 = 16 * kb, ns = 256 * nb + 4 * lane;
    float4 v[16];
#pragma unroll
    for (int i = 0; i < 16; ++i) v[i] = *(const float4*)(W + (size_t)(k0 + i) * N + ns);
    float m0 = 0.f, m1 = 0.f, m2 = 0.f, m3 = 0.f;
#pragma unroll
    for (int i = 0; i < 16; ++i) { const float gk = g[k0 + i]; m0 = fmaxf(m0, fabsf(v[i].x * gk)); m1 = fmaxf(m1, fabsf(v[i].y * gk)); m2 = fmaxf(m2, fabsf(v[i].z * gk)); m3 = fmaxf(m3, fabsf(v[i].w * gk)); }
    atomicMax((unsigned*)WMAXl + win_colmap_inv(ns), __float_as_uint(m0)); atomicMax((unsigned*)WMAXl + win_colmap_inv(ns + 1), __float_as_uint(m1));
    atomicMax((unsigned*)WMAXl + win_colmap_inv(ns + 2), __float_as_uint(m2)); atomicMax((unsigned*)WMAXl + win_colmap_inv(ns + 3), __float_as_uint(m3));
}
__device__ __forceinline__ void tr_item_i8(const float* __restrict__ W, int K, int N, const float* __restrict__ g, unsigned char* __restrict__ WQ, const float* __restrict__ WMAXl, float* __restrict__ WS127l, float* scr, int item, int lane) {
    const int nblk = N / 32, kb = item / nblk, nb = item % nblk, k0 = 64 * kb, n0 = 32 * nb;
    { const int nn = n0 + (lane & 31); const float wm = WMAXl[nn]; if (kb == 0 && lane < 32) WS127l[nn] = wm * (1.0f / 127.0f); }
    const int k8 = lane >> 3, q = lane & 7;
    const bool rotr = (n0 >= 1536 && n0 < 2560);
    const int h = q >> 2, f = q & 3;
    const int src = rotr ? (n0 & ~127) + ((n0 & 127) >> 1) + 64 * h + 4 * f : n0 + 4 * q;
    int lc[4]; float qs[4];
#pragma unroll
    for (int e = 0; e < 4; ++e) { lc[e] = rotr ? 2 * (4 * f + e) + h : 4 * q + e; const float wm = WMAXl[n0 + lc[e]]; qs[e] = wm > 0.f ? 127.0f / wm : 0.f; }
    float4 v[8]; float gg[8];
#pragma unroll
    for (int i = 0; i < 8; ++i) { const int kk = 8 * i + k8; v[i] = *(const float4*)(W + (size_t)(k0 + kk) * N + src); gg[i] = g[k0 + kk]; }
#pragma unroll
    for (int i = 0; i < 8; ++i) { float* d = scr + (8 * i + k8) * 33; d[lc[0]] = v[i].x * gg[i] * qs[0]; d[lc[1]] = v[i].y * gg[i] * qs[1]; d[lc[2]] = v[i].z * gg[i] * qs[2]; d[lc[3]] = v[i].w * gg[i] * qs[3]; }
    asm volatile("s_waitcnt lgkmcnt(0)" ::: "memory");
    const int c = lane & 3;
#pragma unroll
    for (int j = 0; j < 2; ++j) { const int n = (lane >> 2) + 16 * j; const float* sp = scr + (16 * c) * 33 + n; unsigned w[4];
#pragma unroll
        for (int d = 0; d < 4; ++d) w[d] = ((unsigned)(int)rintf(sp[(4 * d) * 33]) & 0xFFu) | (((unsigned)(int)rintf(sp[(4 * d + 1) * 33]) & 0xFFu) << 8) | (((unsigned)(int)rintf(sp[(4 * d + 2) * 33]) & 0xFFu) << 16) | (((unsigned)(int)rintf(sp[(4 * d + 3) * 33]) & 0xFFu) << 24);
        uint4 o; o.x = w[0]; o.y = w[1]; o.z = w[2]; o.w = w[3];
        *(uint4*)(WQ + (size_t)(n0 + n) * K + k0 + 16 * c) = o; }
    asm volatile("s_waitcnt lgkmcnt(0)" ::: "memory");
}
__device__ __forceinline__ void row_to_i8_ssq(const float* __restrict__ xrow, unsigned char* __restrict__ qrow, float* __restrict__ xs, float* __restrict__ ssq, int lane) {
    float4 v[4]; float s = 0.f, mx = 0.f;
#pragma unroll
    for (int i = 0; i < 4; ++i) { v[i] = ((const float4*)xrow)[lane + 64 * i]; s += (v[i].x * v[i].x + v[i].y * v[i].y) + (v[i].z * v[i].z + v[i].w * v[i].w); mx = fmaxf(mx, fmaxf(fmaxf(fabsf(v[i].x), fabsf(v[i].y)), fmaxf(fabsf(v[i].z), fabsf(v[i].w)))); }
    s = wave_sum(s); mx = wave_max(mx);
    const float sc = mx > 0.f ? 127.0f / mx : 1.0f;
#pragma unroll
    for (int i = 0; i < 4; ++i) ((unsigned*)qrow)[lane + 64 * i] = ((unsigned)(int)rintf(v[i].x * sc) & 0xFFu) | (((unsigned)(int)rintf(v[i].y * sc) & 0xFFu) << 8) | (((unsigned)(int)rintf(v[i].z * sc) & 0xFFu) << 16) | (((unsigned)(int)rintf(v[i].w * sc) & 0xFFu) << 24);
    if (lane < 16) ssq[lane] = lane == 0 ? s : 0.f;
    if (lane == 0) xs[0] = mx > 0.f ? mx * (1.0f / 127.0f) : 1.0f;
}
__device__ __forceinline__ void rowbf_to_i8(const bf16_t* __restrict__ xrow, unsigned char* __restrict__ qrow, float* __restrict__ xs, int lane) {
    float4 v[4]; float mx = 0.f;
#pragma unroll
    for (int i = 0; i < 4; ++i) { const uint2 w = ((const uint2*)xrow)[lane + 64 * i]; v[i].x = __uint_as_float(w.x << 16); v[i].y = __uint_as_float(w.x & 0xFFFF0000u); v[i].z = __uint_as_float(w.y << 16); v[i].w = __uint_as_float(w.y & 0xFFFF0000u);
        mx = fmaxf(mx, fmaxf(fmaxf(fabsf(v[i].x), fabsf(v[i].y)), fmaxf(fabsf(v[i].z), fabsf(v[i].w)))); }
    mx = wave_max(mx);
    const float sc = mx > 0.f ? 127.0f / mx : 1.0f;
#pragma unroll
    for (int i = 0; i < 4; ++i) ((unsigned*)qrow)[lane + 64 * i] = ((unsigned)(int)rintf(v[i].x * sc) & 0xFFu) | (((unsigned)(int)rintf(v[i].y * sc) & 0xFFu) << 8) | (((unsigned)(int)rintf(v[i].z * sc) & 0xFFu) << 16) | (((unsigned)(int)rintf(v[i].w * sc) & 0xFFu) << 24);
    if (lane == 0) xs[0] = mx > 0.f ? mx * (1.0f / 127.0f) : 1.0f;
}
__device__ __forceinline__ void peer_fold_item(const float* __restrict__ wpq, const float* __restrict__ keys, const float* __restrict__ g, bf16_t* __restrict__ WPT, float* scr, int item, const int tid) {
    typedef short pf_bf16x8 __attribute__((ext_vector_type(8))); typedef float pf_f32x16 __attribute__((ext_vector_type(16)));
    const int hp = item >> 4, k0 = (item & 15) * 64;
    char* Wl = (char*)scr; char* Kl = (char*)scr + 64 * 272;
#pragma unroll
    for (int j = 0; j < 4; ++j) { const int i = tid + 512 * j, kk = i >> 5, d4 = (i & 31) * 4; const float4 v = *(const float4*)(wpq + (size_t)(k0 + kk) * 2048 + hp * 128 + d4); const float gg = g[k0 + kk];
        uint2 w; w.x = pk2bf(v.x * gg, v.y * gg); w.y = pk2bf(v.z * gg, v.w * gg); *(uint2*)(Wl + kk * 272 + d4 * 2) = w; }
#pragma unroll
    for (int j = 0; j < 8; ++j) { const int i = tid + 512 * j, ky = i >> 5, d4 = (i & 31) * 4; const float4 v = *(const float4*)(keys + ((size_t)hp * 128 + ky) * 128 + d4);
        uint2 w; w.x = pk2bf(v.x, v.y); w.y = pk2bf(v.z, v.w); *(uint2*)(Kl + ky * 272 + d4 * 2) = w; }
    __syncthreads();
    const int lane = tid & 63, wave = tid >> 6, r = lane & 31, hh = lane >> 5, kblk = wave & 1, yblk = wave >> 1;
    pf_f32x16 o;
#pragma unroll
    for (int i = 0; i < 16; ++i) o[i] = 0.f;
#pragma unroll
    for (int ks = 0; ks < 8; ++ks) {
        const pf_bf16x8 af = *(const pf_bf16x8*)(Wl + (kblk * 32 + r) * 272 + (16 * ks + 8 * hh) * 2), bf = *(const pf_bf16x8*)(Kl + (yblk * 32 + r) * 272 + (16 * ks + 8 * hh) * 2);
        o = __builtin_amdgcn_mfma_f32_32x32x16_bf16(af, bf, o, 0, 0, 0);
    }
    bf16_t* dst = WPT + (size_t)(hp * 128 + yblk * 32 + r) * 1024 + k0 + kblk * 32 + 4 * hh;
#pragma unroll
    for (int q = 0; q < 4; ++q) { uint2 w; w.x = pk2bf(o[4 * q], o[4 * q + 1]); w.y = pk2bf(o[4 * q + 2], o[4 * q + 3]); *(uint2*)(dst + 8 * q) = w; }
    __syncthreads();
}
__device__ __forceinline__ void row_to_bf16_ssq(const float* __restrict__ xrow, bf16_t* __restrict__ orow, float* __restrict__ ssq, int lane) {
    const float4* xr = (const float4*)xrow; float s = 0.f;
#pragma unroll
    for (int i = 0; i < 4; ++i) { const float4 v = xr[lane + 64 * i]; s += (v.x * v.x + v.y * v.y) + (v.z * v.z + v.w * v.w);
        uint2 w; w.x = pk2bf(v.x, v.y); w.y = pk2bf(v.z, v.w); ((uint2*)orow)[lane + 64 * i] = w; }
    s = wave_sum(s);
    if (lane < 16) ssq[lane] = lane == 0 ? s : 0.f;
}
constexpr int NEXP = 16384;
__device__ __forceinline__ void table_row_from_regs(const float4 a0, const float4 a1, const float4 a2, const float4 a3, const float* __restrict__ g, unsigned char* __restrict__ T8, float* __restrict__ isc, int e, int lane) {
    const float4 av[4] = {a0, a1, a2, a3};
    float v[16]; float mx = 0.f;
#pragma unroll
    for (int i = 0; i < 4; ++i) { const float4 gg = g ? ((const float4*)g)[lane * 4 + i] : make_float4(1.f, 1.f, 1.f, 1.f);
        v[4 * i] = av[i].x * gg.x; v[4 * i + 1] = av[i].y * gg.y; v[4 * i + 2] = av[i].z * gg.z; v[4 * i + 3] = av[i].w * gg.w;
        mx = fmaxf(mx, fmaxf(fmaxf(fabsf(v[4 * i]), fabsf(v[4 * i + 1])), fmaxf(fabsf(v[4 * i + 2]), fabsf(v[4 * i + 3])))); }
    mx = wave_max(mx);
    const float sc = mx > 0.f ? 127.0f / mx : 1.0f;
    unsigned w[4];
#pragma unroll
    for (int i = 0; i < 4; ++i) w[i] = ((unsigned)(int)rintf(v[4 * i] * sc) & 0xFFu) | (((unsigned)(int)rintf(v[4 * i + 1] * sc) & 0xFFu) << 8) | (((unsigned)(int)rintf(v[4 * i + 2] * sc) & 0xFFu) << 16) | (((unsigned)(int)rintf(v[4 * i + 3] * sc) & 0xFFu) << 24);
    uint4 o; o.x = w[0]; o.y = w[1]; o.z = w[2]; o.w = w[3];
    nt_st16(T8 + ((size_t)(lane >> 3) * NEXP + e) * 128 + (lane & 7) * 16, o);
    if (lane == 0) isc[e] = mx > 0.f ? mx * (1.0f / 127.0f) : 1.0f;
}
__device__ __forceinline__ void table_rows_run(const float* __restrict__ peer_u, const float* __restrict__ peer_v, const float* __restrict__ peer_norm, unsigned char* __restrict__ T8, float* __restrict__ ISC, int l, int r0, int cnt, int lane) {
    if (cnt <= 0) return;
    float4 a0, a1, a2, a3, b0, b1, b2, b3, c0, c1, c2, c3, d0, d1, d2, d3;
#define TR_PTR(r_) (((((r_) >> 14) ? peer_v : peer_u)) + ((size_t)l * NEXP + ((r_) & (NEXP - 1))) * DM)
#define TR_LOAD(X_, r_) do { const float4* p_ = (const float4*)TR_PTR(r_) + lane * 4; X_##0 = p_[0]; X_##1 = p_[1]; X_##2 = p_[2]; X_##3 = p_[3]; } while (0)
#define TR_PROC(X_, r_) do { const int tab_ = (r_) >> 14, lt_ = l * 2 + tab_; table_row_from_regs(X_##0, X_##1, X_##2, X_##3, tab_ ? nullptr : peer_norm + l * DM, T8 + (size_t)lt_ * 8 * NEXP * 128, ISC + (size_t)lt_ * NEXP, (r_) & (NEXP - 1), lane); } while (0)
    TR_LOAD(a, r0); TR_LOAD(b, r0 + 1); TR_LOAD(c, r0 + 2); TR_LOAD(d, r0 + 3);
#pragma unroll 1
    for (int i = 0; i < cnt; i += 4) {
        const int r = r0 + i; const bool more = i + 4 < cnt;
        TR_PROC(a, r);     if (more) TR_LOAD(a, r + 4);
        TR_PROC(b, r + 1); if (more) TR_LOAD(b, r + 5);
        TR_PROC(c, r + 2); if (more) TR_LOAD(c, r + 6);
        TR_PROC(d, r + 3); if (more) TR_LOAD(d, r + 7);
    }
#undef TR_PTR
#undef TR_LOAD
#undef TR_PROC
}
__device__ __forceinline__ void xb_row_from_regs(const uint2 w0, const uint2 w1, const uint2 w2, const uint2 w3, unsigned char* __restrict__ qrow, float* __restrict__ xs, int lane) {
    const uint2 w[4] = {w0, w1, w2, w3}; float4 v[4]; float mx = 0.f;
#pragma unroll
    for (int i = 0; i < 4; ++i) { v[i].x = __uint_as_float(w[i].x << 16); v[i].y = __uint_as_float(w[i].x & 0xFFFF0000u); v[i].z = __uint_as_float(w[i].y << 16); v[i].w = __uint_as_float(w[i].y & 0xFFFF0000u);
        mx = fmaxf(mx, fmaxf(fmaxf(fabsf(v[i].x), fabsf(v[i].y)), fmaxf(fabsf(v[i].z), fabsf(v[i].w)))); }
    mx = wave_max(mx);
    const float sc = mx > 0.f ? 127.0f / mx : 1.0f;
#pragma unroll
    for (int i = 0; i < 4; ++i) ((unsigned*)qrow)[lane + 64 * i] = ((unsigned)(int)rintf(v[i].x * sc) & 0xFFu) | (((unsigned)(int)rintf(v[i].y * sc) & 0xFFu) << 8) | (((unsigned)(int)rintf(v[i].z * sc) & 0xFFu) << 16) | (((unsigned)(int)rintf(v[i].w * sc) & 0xFFu) << 24);
    if (lane == 0) xs[0] = mx > 0.f ? mx * (1.0f / 127.0f) : 1.0f;
}
__device__ __forceinline__ void xb_rows_run(const bf16_t* __restrict__ XB, unsigned char* __restrict__ XQ, float* __restrict__ XS, int gw, int NGW, int lane) {
    uint2 a0, a1, a2, a3, b0, b1, b2, b3, c0, c1, c2, c3, d0, d1, d2, d3;
    a0 = a1 = a2 = a3 = b0 = b1 = b2 = b3 = c0 = c1 = c2 = c3 = d0 = d1 = d2 = d3 = make_uint2(0u, 0u);
#define XBR_LOAD(X_, m_) do { if ((m_) < T) { const uint2* p_ = (const uint2*)(XB + (size_t)(m_) * DM) + lane; X_##0 = p_[0]; X_##1 = p_[64]; X_##2 = p_[128]; X_##3 = p_[192]; } } while (0)
#define XBR_PROC(X_, m_) do { if ((m_) < T) xb_row_from_regs(X_##0, X_##1, X_##2, X_##3, XQ + (size_t)(m_) * DM, XS + (m_), lane); } while (0)
    XBR_LOAD(a, gw); XBR_LOAD(b, gw + NGW); XBR_LOAD(c, gw + 2 * NGW); XBR_LOAD(d, gw + 3 * NGW);
#pragma unroll 1
    for (int m = gw; m < T; m += 4 * NGW) {
        XBR_PROC(a, m);           XBR_LOAD(a, m + 4 * NGW);
        XBR_PROC(b, m + NGW);     XBR_LOAD(b, m + 5 * NGW);
        XBR_PROC(c, m + 2 * NGW); XBR_LOAD(c, m + 6 * NGW);
        XBR_PROC(d, m + 3 * NGW); XBR_LOAD(d, m + 7 * NGW);
    }
#undef XBR_LOAD
#undef XBR_PROC
}
__device__ __forceinline__ void d_rmsnorm_final(const int vb, const int vtid, const bf16_t* __restrict__ XB, float* __restrict__ out, const float* __restrict__ g) {
    const int row = vb * 4 + (vtid >> 6), lane = vtid & 63;
    const uint2* xr = (const uint2*)(XB + (size_t)row * DM);
    float4 v[4]; float s = 0.f;
#pragma unroll
    for (int i = 0; i < 4; ++i) { const uint2 w = xr[lane + 64 * i]; v[i].x = __uint_as_float(w.x << 16); v[i].y = __uint_as_float(w.x & 0xFFFF0000u); v[i].z = __uint_as_float(w.y << 16); v[i].w = __uint_as_float(w.y & 0xFFFF0000u);
        s += v[i].x * v[i].x + v[i].y * v[i].y + v[i].z * v[i].z + v[i].w * v[i].w; }
    s = wave_sum(s);
    const float r = rsqrtf(s * (1.0f / DM) + EPS);
#pragma unroll
    for (int i = 0; i < 4; ++i) { const float4 gg = ((const float4*)g)[lane + 64 * i];
        float4 y; y.x = v[i].x * r * gg.x; y.y = v[i].y * r * gg.y; y.z = v[i].z * r * gg.z; y.w = v[i].w * r * gg.w; { uint4 yu; yu.x = __float_as_uint(y.x); yu.y = __float_as_uint(y.y); yu.z = __float_as_uint(y.z); yu.w = __float_as_uint(y.w); nt_st16((float4*)(out + (size_t)row * DM) + lane + 64 * i, yu); } }
}
typedef float f32x2 __attribute__((ext_vector_type(2)));
template <int CTRL> __device__ __forceinline__ float dpp_f(float v) { return __builtin_bit_cast(float, __builtin_amdgcn_update_dpp(0, __builtin_bit_cast(int, v), CTRL, 0xF, 0xF, false)); }
template <int CTRL> __device__ __forceinline__ unsigned dpp_u(unsigned v) { return (unsigned)__builtin_amdgcn_update_dpp(0, (int)v, CTRL, 0xF, 0xF, false); }
typedef unsigned u32x4nt __attribute__((ext_vector_type(4))); typedef int i32x4nt __attribute__((ext_vector_type(4)));
__device__ __forceinline__ uint4 nt_ld16(const void* p) { const u32x4nt v = __builtin_nontemporal_load((const u32x4nt*)p); uint4 r; r.x = v[0]; r.y = v[1]; r.z = v[2]; r.w = v[3]; return r; }
__device__ __forceinline__ int4 nt_ld16i(const void* p) { const i32x4nt v = __builtin_nontemporal_load((const i32x4nt*)p); int4 r; r.x = v[0]; r.y = v[1]; r.z = v[2]; r.w = v[3]; return r; }
__device__ __forceinline__ void table_row_to_i8(const float* __restrict__ row, const float* __restrict__ g, unsigned char* __restrict__ T8, float* __restrict__ isc, int e, int lane) {
    float v[16]; float mx = 0.f;
#pragma unroll
    for (int i = 0; i < 4; ++i) { const float4 a = ((const float4*)row)[lane * 4 + i]; const float4 gg = g ? ((const float4*)g)[lane * 4 + i] : make_float4(1.f, 1.f, 1.f, 1.f);
        v[4 * i] = a.x * gg.x; v[4 * i + 1] = a.y * gg.y; v[4 * i + 2] = a.z * gg.z; v[4 * i + 3] = a.w * gg.w;
        mx = fmaxf(mx, fmaxf(fmaxf(fabsf(v[4 * i]), fabsf(v[4 * i + 1])), fmaxf(fabsf(v[4 * i + 2]), fabsf(v[4 * i + 3])))); }
    mx = wave_max(mx);
    const float sc = mx > 0.f ? 127.0f / mx : 1.0f;
    unsigned w[4];
#pragma unroll
    for (int i = 0; i < 4; ++i) w[i] = ((unsigned)(int)rintf(v[4 * i] * sc) & 0xFFu) | (((unsigned)(int)rintf(v[4 * i + 1] * sc) & 0xFFu) << 8) | (((unsigned)(int)rintf(v[4 * i + 2] * sc) & 0xFFu) << 16) | (((unsigned)(int)rintf(v[4 * i + 3] * sc) & 0xFFu) << 24);
    uint4 o; o.x = w[0]; o.y = w[1]; o.z = w[2]; o.w = w[3];
    nt_st16(T8 + ((size_t)(lane >> 3) * NEXP + e) * 128 + (lane & 7) * 16, o);
    if (lane == 0) isc[e] = mx > 0.f ? mx * (1.0f / 127.0f) : 1.0f;
}
__device__ __forceinline__ void table_row_to_fp8(const float* __restrict__ row, const float* __restrict__ g, unsigned char* __restrict__ T8, float* __restrict__ isc, int e, int lane) {
    float v[16]; float mx = 0.f;
#pragma unroll
    for (int i = 0; i < 4; ++i) { const float4 a = ((const float4*)row)[lane * 4 + i]; float4 gg = make_float4(1.f, 1.f, 1.f, 1.f); if (g) gg = ((const float4*)g)[lane * 4 + i];
        v[4 * i] = a.x * gg.x; v[4 * i + 1] = a.y * gg.y; v[4 * i + 2] = a.z * gg.z; v[4 * i + 3] = a.w * gg.w;
        mx = fmaxf(mx, fmaxf(fmaxf(fabsf(v[4 * i]), fabsf(v[4 * i + 1])), fmaxf(fabsf(v[4 * i + 2]), fabsf(v[4 * i + 3])))); }
    mx = wave_max(mx);
    const float sc = mx > 0.f ? 224.0f / mx : 1.0f;
    uint4 o; unsigned w[4];
#pragma unroll
    for (int i = 0; i < 4; ++i) { int p = __builtin_amdgcn_cvt_pk_fp8_f32(v[4 * i] * sc, v[4 * i + 1] * sc, 0, false); p = __builtin_amdgcn_cvt_pk_fp8_f32(v[4 * i + 2] * sc, v[4 * i + 3] * sc, p, true); w[i] = (unsigned)p; }
    o.x = w[0]; o.y = w[1]; o.z = w[2]; o.w = w[3];
    nt_st16(T8 + ((size_t)(lane >> 3) * NEXP + e) * 128 + (lane & 7) * 16, o);
    if (lane == 0) isc[e] = mx > 0.f ? mx * (1.0f / 224.0f) : 1.0f;
}

#define PK_CE(a, b) { const unsigned t_ = (a) > (b) ? (a) : (b); b = (a) > (b) ? (b) : (a); a = t_; }
__device__ __forceinline__ void sort16_desc(unsigned (&v)[16]) {
    PK_CE(v[0], v[13]) PK_CE(v[1], v[12]) PK_CE(v[2], v[15]) PK_CE(v[3], v[14]) PK_CE(v[4], v[8]) PK_CE(v[5], v[6]) PK_CE(v[7], v[11]) PK_CE(v[9], v[10])
    PK_CE(v[0], v[5]) PK_CE(v[1], v[7]) PK_CE(v[2], v[9]) PK_CE(v[3], v[4]) PK_CE(v[6], v[13]) PK_CE(v[8], v[14]) PK_CE(v[10], v[15]) PK_CE(v[11], v[12])
    PK_CE(v[0], v[1]) PK_CE(v[2], v[3]) PK_CE(v[4], v[5]) PK_CE(v[6], v[8]) PK_CE(v[7], v[9]) PK_CE(v[10], v[11]) PK_CE(v[12], v[13]) PK_CE(v[14], v[15])
    PK_CE(v[0], v[2]) PK_CE(v[1], v[3]) PK_CE(v[4], v[10]) PK_CE(v[5], v[11]) PK_CE(v[6], v[7]) PK_CE(v[8], v[9]) PK_CE(v[12], v[14]) PK_CE(v[13], v[15])
    PK_CE(v[1], v[2]) PK_CE(v[3], v[12]) PK_CE(v[4], v[6]) PK_CE(v[5], v[7]) PK_CE(v[8], v[10]) PK_CE(v[9], v[11]) PK_CE(v[13], v[14])
    PK_CE(v[1], v[4]) PK_CE(v[2], v[6]) PK_CE(v[5], v[8]) PK_CE(v[7], v[10]) PK_CE(v[9], v[13]) PK_CE(v[11], v[14])
    PK_CE(v[2], v[4]) PK_CE(v[3], v[6]) PK_CE(v[9], v[12]) PK_CE(v[11], v[13])
    PK_CE(v[3], v[5]) PK_CE(v[6], v[8]) PK_CE(v[7], v[9]) PK_CE(v[10], v[12])
    PK_CE(v[3], v[4]) PK_CE(v[5], v[6]) PK_CE(v[7], v[8]) PK_CE(v[9], v[10]) PK_CE(v[11], v[12])
    PK_CE(v[6], v[7]) PK_CE(v[8], v[9])
}
__device__ __forceinline__ void merge16_desc(unsigned (&R)[16], const unsigned (&N)[16]) {
#pragma unroll
    for (int i = 0; i < 16; ++i) R[i] = R[i] > N[15 - i] ? R[i] : N[15 - i];
#pragma unroll
    for (int j = 8; j > 0; j >>= 1)
#pragma unroll
        for (int i = 0; i < 16; ++i) { const int l = i ^ j; if (l > i) PK_CE(R[i], R[l]) }
}
__device__ __forceinline__ void peer_topk_fast(const bf16_t* __restrict__ SC, int* __restrict__ IDX, float* __restrict__ GATE, int t, int hp) {
    const uint4* src = (const uint4*)(SC + (size_t)t * 2048 + hp * 128);
    unsigned R[16];
#pragma unroll
    for (int g = 0; g < 8; ++g) {
        const uint4 a = src[2 * g], b = src[2 * g + 1]; const unsigned dw[8] = {a.x, a.y, a.z, a.w, b.x, b.y, b.z, b.w};
        unsigned N[16];
#pragma unroll
        for (int k = 0; k < 8; ++k) { const unsigned w = dw[k]; const unsigned m = ((w >> 15) & 0x00010001u) * 0x7FFFu; const unsigned u = w ^ (m | 0x80008000u);
            N[2 * k] = (u << 16) | (unsigned)(127 - (g * 16 + 2 * k)); N[2 * k + 1] = (u & 0xFFFF0000u) | (unsigned)(127 - (g * 16 + 2 * k + 1)); }
        sort16_desc(N);
        if (g == 0) {
#pragma unroll
            for (int i = 0; i < 16; ++i) R[i] = N[i];
        } else merge16_desc(R, N);
    }
    const int p = hp & 1;
    unsigned F[16];
#pragma unroll
    for (int r = 0; r < 16; ++r) {
        const unsigned u = R[r] >> 16; const unsigned hb = (u & 0x8000u) ? (u & 0x7FFFu) : (~u & 0xFFFFu);
        const float s = h2f((unsigned short)hb); const int id = 127 - (int)(R[r] & 127u);
        int f = (int)rintf(s * 4096.0f); f = f < -65535 ? -65535 : (f > 65535 ? 65535 : f);
        F[r] = p ? (unsigned)(f * 16384 + id) : (((unsigned)(f + 131072) << 14) + ((unsigned)id << 7));
    }
    unsigned F0[16], F1[16];
#pragma unroll
    for (int r = 0; r < 16; ++r) { const unsigned o = dpp_u<0xB1>(F[r]); F0[r] = p ? o : F[r]; F1[r] = p ? F[r] : o; }
    unsigned A[16], B[16];
#pragma unroll
    for (int j = 0; j < 16; ++j) A[j] = F0[0] + F1[j];
#pragma unroll
    for (int j = 0; j < 8; ++j) B[j] = F0[1] + F1[j];
#pragma unroll
    for (int j = 0; j < 5; ++j) B[8 + j] = F0[2] + F1[j];
#pragma unroll
    for (int j = 0; j < 3; ++j) B[13 + j] = F0[4] + F1[j];
    sort16_desc(B); merge16_desc(A, B);
#pragma unroll
    for (int j = 0; j < 4; ++j) B[j] = F0[3] + F1[j];
#pragma unroll
    for (int i = 0; i < 3; ++i) { B[4 + 2 * i] = F0[5 + i] + F1[0]; B[5 + 2 * i] = F0[5 + i] + F1[1]; }
#pragma unroll
    for (int i = 0; i < 6; ++i) B[10 + i] = F0[8 + i] + F1[0];
    sort16_desc(B); merge16_desc(A, B);
#pragma unroll
    for (int i = 14; i < 16; ++i) { unsigned xk = F0[i] + F1[0];
#pragma unroll
        for (int k = 0; k < 16; ++k) PK_CE(A[k], xk) }
    float ex[16]; float sum = 0.f; const float s0 = (float)((int)(A[0] >> 14) - 131072);
#pragma unroll
    for (int r = 0; r < 16; ++r) { const float s = (float)((int)(A[r] >> 14) - 131072); ex[r] = __expf((s - s0) * (1.0f / 4096.0f)); sum += ex[r]; }
    const float inv = 1.0f / sum;
    int4 i0, i1; float4 g0, g1;
    i0.x = (int)((p ? A[8] : A[0]) & 0x3FFFu); i0.y = (int)((p ? A[9] : A[1]) & 0x3FFFu); i0.z = (int)((p ? A[10] : A[2]) & 0x3FFFu); i0.w = (int)((p ? A[11] : A[3]) & 0x3FFFu);
    i1.x = (int)((p ? A[12] : A[4]) & 0x3FFFu); i1.y = (int)((p ? A[13] : A[5]) & 0x3FFFu); i1.z = (int)((p ? A[14] : A[6]) & 0x3FFFu); i1.w = (int)((p ? A[15] : A[7]) & 0x3FFFu);
    g0.x = (p ? ex[8] : ex[0]) * inv; g0.y = (p ? ex[9] : ex[1]) * inv; g0.z = (p ? ex[10] : ex[2]) * inv; g0.w = (p ? ex[11] : ex[3]) * inv;
    g1.x = (p ? ex[12] : ex[4]) * inv; g1.y = (p ? ex[13] : ex[5]) * inv; g1.z = (p ? ex[14] : ex[6]) * inv; g1.w = (p ? ex[15] : ex[7]) * inv;
    const size_t o = (size_t)t * 128 + (hp >> 1) * 16 + p * 8;
    *(int4*)(IDX + o) = i0; *(int4*)(IDX + o + 4) = i1; *(float4*)(GATE + o) = g0; *(float4*)(GATE + o + 4) = g1;
}

struct PeerStep { int t, s; bool ok; };
__device__ __forceinline__ PeerStep peer_step(int k, int bid, int G, int wave) { PeerStep r; const int i = bid + (k >> 3) * G; r.ok = i < 8 * (T / 64);
#ifdef XTEST
    r.s = (i >> 3) & 7; r.t = ((((i >> 6) << 3) | (i & 7))) * 64 + wave * 8 + (k & 7);
#else
    r.s = i & 7; r.t = (i >> 3) * 64 + wave * 8 + (k & 7);
#endif
    return r; }
#define PEER_LD_IDX(ID, ST) do { const int* ip_ = IDX + (size_t)(ST).t * 128 + g * 16; const int4 a_ = *(const int4*)ip_, b_ = *(const int4*)(ip_ + 4), c_ = *(const int4*)(ip_ + 8), d_ = *(const int4*)(ip_ + 12); \
    ID[0] = a_.x; ID[1] = a_.y; ID[2] = a_.z; ID[3] = a_.w; ID[4] = b_.x; ID[5] = b_.y; ID[6] = b_.z; ID[7] = b_.w; ID[8] = c_.x; ID[9] = c_.y; ID[10] = c_.z; ID[11] = c_.w; ID[12] = d_.x; ID[13] = d_.y; ID[14] = d_.z; ID[15] = d_.w; } while (0)
#define PEER_LD_TAB(D, ID, TAB, ST) do { const unsigned char* tb_ = (TAB) + (size_t)(ST).s * NEXP * 128 + j * 16; _Pragma("unroll") for (int q_ = 0; q_ < 16; ++q_) D[q_] = *(const uint4*)(tb_ + (size_t)((ID[q_]) & 0x3FFF) * 128); } while (0)
__device__ __forceinline__ unsigned perm_b(unsigned hi, unsigned lo, unsigned sel) { return __builtin_amdgcn_perm(hi, lo, sel); }
__device__ __forceinline__ void peer_u_compute(const uint4 (&d)[16], const uint4& xa, const uint4& xb, bf16_t* __restrict__ Arow, int g, int j) {
    const unsigned xw[8] = {xa.x, xa.y, xa.z, xa.w, xb.x, xb.y, xb.z, xb.w};
    f32x2 xf[8]; float mx = 0.f;
#pragma unroll
    for (int k = 0; k < 8; ++k) { xf[k][0] = __uint_as_float(xw[k] << 16); xf[k][1] = __uint_as_float(xw[k] & 0xFFFF0000u); mx = fmaxf(mx, fmaxf(fabsf(xf[k][0]), fabsf(xf[k][1]))); }
    mx = fmaxf(mx, dpp_f<0xB1>(mx)); mx = fmaxf(mx, dpp_f<0x4E>(mx)); mx = fmaxf(mx, dpp_f<0x141>(mx));
    const float sx = mx > 0.f ? 127.0f / mx : 1.0f, inv = mx > 0.f ? mx * (1.0f / 127.0f) : 1.0f;
    const f32x2 sx2 = {sx, sx}, magic = {12582912.0f, 12582912.0f};
    unsigned yb[16];
#pragma unroll
    for (int k = 0; k < 8; ++k) { const f32x2 y = __builtin_elementwise_fma(xf[k], sx2, magic); yb[2 * k] = __float_as_uint(y[0]); yb[2 * k + 1] = __float_as_uint(y[1]); }
    int xq[4];
#pragma unroll
    for (int k = 0; k < 4; ++k) xq[k] = (int)perm_b(perm_b(yb[4 * k + 3], yb[4 * k + 2], 0x0c0c0400u), perm_b(yb[4 * k + 1], yb[4 * k], 0x0c0c0400u), 0x05040100u);
    unsigned sacc[16];
#pragma unroll
    for (int q = 0; q < 16; ++q) {
        int acc = __builtin_amdgcn_sdot4((int)d[q].x, xq[0], 0, false); acc = __builtin_amdgcn_sdot4((int)d[q].y, xq[1], acc, false); acc = __builtin_amdgcn_sdot4((int)d[q].z, xq[2], acc, false); acc = __builtin_amdgcn_sdot4((int)d[q].w, xq[3], acc, false);
        sacc[q] = (unsigned)acc;
    }
    const bool b2 = (j & 4) != 0, b0 = (j & 1) != 0, b1 = (j & 2) != 0;
    unsigned s8[8], s4[4], s2[2];
#pragma unroll
    for (int i = 0; i < 8; ++i) { const int q = (i & 3) + 8 * (i >> 2); s8[i] = (b2 ? sacc[q + 4] : sacc[q]) + dpp_u<0x141>(b2 ? sacc[q] : sacc[q + 4]); }
#pragma unroll
    for (int i = 0; i < 4; ++i) { const int p = 2 * (i & 1) + 4 * (i >> 1); s4[i] = (b0 ? s8[p + 1] : s8[p]) + dpp_u<0xB1>(b0 ? s8[p] : s8[p + 1]); }
#pragma unroll
    for (int i = 0; i < 2; ++i) { const int p = 2 * i; s2[i] = (b1 ? s4[p + 1] : s4[p]) + dpp_u<0x4E>(b1 ? s4[p] : s4[p + 1]); }
    Arow[g * 16 + j] = f2bf((float)(int)s2[0] * inv); Arow[g * 16 + 8 + j] = f2bf((float)(int)s2[1] * inv);
}
__device__ __forceinline__ void peer_u_phase(const bf16_t* __restrict__ XB, const int* __restrict__ IDX, const unsigned char* __restrict__ U8, bf16_t* __restrict__ APART, int bid, int G, int wave, int lane) {
    const int g = lane >> 3, j = lane & 7;
    const int nk = ((8 * (T / 64) - bid + G - 1) / G) * 8;
    if (nk <= 0) return;
    int idA[16], idB[16]; uint4 dA[16], dB[16]; uint4 xA0, xA1, xB0, xB1;
    PeerStep sA = peer_step(0, bid, G, wave), sB = peer_step(1, bid, G, wave);
    PEER_LD_IDX(idA, sA); { const bf16_t* xs = XB + (size_t)sA.t * DM + sA.s * 128 + 16 * j; xA0 = *(const uint4*)xs; xA1 = *(const uint4*)(xs + 8); }
    PEER_LD_TAB(dA, idA, U8, sA);
    PEER_LD_IDX(idB, sB); { const bf16_t* xs = XB + (size_t)sB.t * DM + sB.s * 128 + 16 * j; xB0 = *(const uint4*)xs; xB1 = *(const uint4*)(xs + 8); }
#pragma unroll 1
    for (int k = 0; k < nk; k += 2) {
        PEER_LD_TAB(dB, idB, U8, sB);
        const PeerStep nA = peer_step(k + 2 < nk ? k + 2 : k, bid, G, wave), nB = peer_step(k + 3 < nk ? k + 3 : k + 1, bid, G, wave);
        PEER_LD_IDX(idA, nA);
        peer_u_compute(dA, xA0, xA1, APART + ((size_t)sA.s * T + sA.t) * 128, g, j);
        { const bf16_t* xs = XB + (size_t)nA.t * DM + nA.s * 128 + 16 * j; xA0 = *(const uint4*)xs; xA1 = *(const uint4*)(xs + 8); }
        PEER_LD_TAB(dA, idA, U8, nA);
        PEER_LD_IDX(idB, nB);
        peer_u_compute(dB, xB0, xB1, APART + ((size_t)sB.s * T + sB.t) * 128, g, j);
        { const bf16_t* xs = XB + (size_t)nB.t * DM + nB.s * 128 + 16 * j; xB0 = *(const uint4*)xs; xB1 = *(const uint4*)(xs + 8); }
        sA = nA; sB = nB;
    }
}
struct CmbIn { float rstd; float4 a; int4 ev; float4 gv; };
__device__ __forceinline__ CmbIn peer_combine_load(const bf16_t* __restrict__ A, const int* IDX, const float* __restrict__ GATE, const float* __restrict__ SSQ, int i4) {
    const int i = i4 * 4, t = i >> 7, p = i & 127; CmbIn r;
    const float4* sp = (const float4*)(SSQ + (size_t)t * 16); const float4 s0 = sp[0], s1 = sp[1], s2 = sp[2], s3 = sp[3];
    float4 a = make_float4(0.f, 0.f, 0.f, 0.f);
#pragma unroll
    for (int s = 0; s < 8; ++s) { const uint2 v = *(const uint2*)(A + ((size_t)s * T + t) * 128 + p); a.x += __uint_as_float(v.x << 16); a.y += __uint_as_float(v.x & 0xFFFF0000u); a.z += __uint_as_float(v.y << 16); a.w += __uint_as_float(v.y & 0xFFFF0000u); }
    r.ev = *(const int4*)(IDX + i); r.gv = *(const float4*)(GATE + i); r.a = a;
    const float q = ((s0.x + s0.y) + (s0.z + s0.w)) + ((s1.x + s1.y) + (s1.z + s1.w)) + ((s2.x + s2.y) + (s2.z + s2.w)) + ((s3.x + s3.y) + (s3.z + s3.w));
    r.rstd = rsqrtf(q * (1.0f / DM) + EPS);
    return r;
}
__device__ __forceinline__ void peer_combine_finish(const CmbIn& in, const float4 su, const float4 sv, int* IDX, float* __restrict__ WSC, int i4) {
    const int i = i4 * 4, t = i >> 7, p = i & 127;
    const int e[4] = {in.ev.x & 0x3FFF, in.ev.y & 0x3FFF, in.ev.z & 0x3FFF, in.ev.w & 0x3FFF}; const float av[4] = {in.a.x, in.a.y, in.a.z, in.a.w}; const float gg[4] = {in.gv.x, in.gv.y, in.gv.z, in.gv.w};
    const float iu[4] = {su.x, su.y, su.z, su.w}, iv[4] = {sv.x, sv.y, sv.z, sv.w};
    float w[4]; float mx = 0.f;
#pragma unroll
    for (int k = 0; k < 4; ++k) { const float x = av[k] * in.rstd * iu[k]; w[k] = gg[k] * 0.5f * x * (1.f + erff(x * 0.7071067811865476f)) * iv[k]; mx = fmaxf(mx, fabsf(w[k])); }
    mx = fmaxf(mx, dpp_f<0xB1>(mx)); mx = fmaxf(mx, dpp_f<0x4E>(mx)); mx = fmaxf(mx, dpp_f<0x141>(mx)); mx = fmaxf(mx, dpp_f<0x140>(mx)); mx = xor16_max(mx);
    const float sw = mx > 0.f ? 127.0f / mx : 1.0f;
    int o[4];
#pragma unroll
    for (int k = 0; k < 4; ++k) o[k] = (int)((((unsigned)(int)rintf(w[k] * sw) & 0xFFu) << 16) | (unsigned)e[k]);
    int4 ov; ov.x = o[0]; ov.y = o[1]; ov.z = o[2]; ov.w = o[3];
    *(int4*)(IDX + i) = ov;
    if (p == 0) WSC[t] = mx > 0.f ? mx * (1.0f / 127.0f) : 1.0f;
}
__device__ __forceinline__ float4 cmb_gather(const float* __restrict__ isc, const int4 ev) { float4 r; r.x = isc[ev.x & 0x3FFF]; r.y = isc[ev.y & 0x3FFF]; r.z = isc[ev.z & 0x3FFF]; r.w = isc[ev.w & 0x3FFF]; return r; }
__device__ __forceinline__ void peer_combine_phase(const bf16_t* __restrict__ A, int* IDX, const float* __restrict__ GATE, const float* __restrict__ SSQ, const float* __restrict__ iscu, const float* __restrict__ iscv, float* __restrict__ WSC, int first, int stride) {
#pragma unroll 1
    for (int i4 = first; i4 < T * 32; i4 += 2 * stride) {
        const int j4 = i4 + stride < T * 32 ? i4 + stride : i4;
        const CmbIn c0 = peer_combine_load(A, IDX, GATE, SSQ, i4), c1 = peer_combine_load(A, IDX, GATE, SSQ, j4);
        const float4 u0 = cmb_gather(iscu, c0.ev), v0 = cmb_gather(iscv, c0.ev), u1 = cmb_gather(iscu, c1.ev), v1 = cmb_gather(iscv, c1.ev);
        peer_combine_finish(c0, u0, v0, IDX, WSC, i4); if (j4 != i4) peer_combine_finish(c1, u1, v1, IDX, WSC, j4);
    }
}
__device__ __forceinline__ void peer_v_compute(const uint4 (&d)[16], const int (&pw)[16], const float wsc, bf16_t* xb, float* ssq2, int g, int j, const bool do_store) {
    unsigned* xp = (unsigned*)(xb + 16 * j + 2 * g);
    const unsigned xw = *xp;
    int acc[16];
#pragma unroll
    for (int c = 0; c < 16; ++c) acc[c] = 0;
#pragma unroll
    for (int m = 0; m < 4; ++m) {
        const unsigned wlo = perm_b((unsigned)pw[4 * m + 1], (unsigned)pw[4 * m], 0x0c0c0602u), whi = perm_b((unsigned)pw[4 * m + 3], (unsigned)pw[4 * m + 2], 0x0c0c0602u);
        const int wb = (int)perm_b(whi, wlo, 0x05040100u);
        const unsigned r0[4] = {d[4 * m].x, d[4 * m].y, d[4 * m].z, d[4 * m].w}, r1[4] = {d[4 * m + 1].x, d[4 * m + 1].y, d[4 * m + 1].z, d[4 * m + 1].w};
        const unsigned r2[4] = {d[4 * m + 2].x, d[4 * m + 2].y, d[4 * m + 2].z, d[4 * m + 2].w}, r3[4] = {d[4 * m + 3].x, d[4 * m + 3].y, d[4 * m + 3].z, d[4 * m + 3].w};
#pragma unroll
        for (int k = 0; k < 4; ++k) {
            const unsigned t0 = perm_b(r1[k], r0[k], 0x05010400u), t1 = perm_b(r1[k], r0[k], 0x07030602u), t2 = perm_b(r3[k], r2[k], 0x05010400u), t3 = perm_b(r3[k], r2[k], 0x07030602u);
            const unsigned c0 = perm_b(t2, t0, 0x05040100u), c1 = perm_b(t2, t0, 0x07060302u), c2 = perm_b(t3, t1, 0x05040100u), c3 = perm_b(t3, t1, 0x07060302u);
            acc[4 * k] = __builtin_amdgcn_sdot4((int)c0, wb, acc[4 * k], false); acc[4 * k + 1] = __builtin_amdgcn_sdot4((int)c1, wb, acc[4 * k + 1], false);
            acc[4 * k + 2] = __builtin_amdgcn_sdot4((int)c2, wb, acc[4 * k + 2], false); acc[4 * k + 3] = __builtin_amdgcn_sdot4((int)c3, wb, acc[4 * k + 3], false);
        }
    }
    int r8[8], r4[4];
#pragma unroll
    for (int i = 0; i < 8; ++i) { auto rr = __builtin_amdgcn_permlane32_swap((unsigned)acc[i], (unsigned)acc[i + 8], false, false); r8[i] = (int)(rr[0] + rr[1]); }
#pragma unroll
    for (int i = 0; i < 4; ++i) { auto rr = __builtin_amdgcn_permlane16_swap((unsigned)r8[i], (unsigned)r8[i + 4], false, false); r4[i] = (int)(rr[0] + rr[1]); }
    const bool e = (g & 1) != 0;
    const int t0 = (e ? r4[2] : r4[0]) + (int)dpp_u<0x128>((unsigned)(e ? r4[0] : r4[2])), t1 = (e ? r4[3] : r4[1]) + (int)dpp_u<0x128>((unsigned)(e ? r4[1] : r4[3]));
    if (do_store) {
        const float lo = __uint_as_float(xw << 16) + (float)t0 * wsc, hi = __uint_as_float(xw & 0xFFFF0000u) + (float)t1 * wsc;
        const unsigned ow = pk2bf(lo, hi);
        *xp = ow;
        const float rl = __uint_as_float(ow << 16), rh = __uint_as_float(ow & 0xFFFF0000u);
        const float ss = wave_sum(rl * rl + rh * rh);
        if (g == 0 && j == 0) { ssq2[0] = ss; ssq2[1] = 0.f; }
    }
}
__device__ __forceinline__ void peer_v_phase(const int* __restrict__ IDX, const float* __restrict__ WSC, const unsigned char* __restrict__ V8, bf16_t* XB, float* SSQ, int bid, int G, int wave, int lane, const bool do_store = true) {
    const int g = lane >> 3, j = lane & 7;
    const int nk = ((8 * (T / 64) - bid + G - 1) / G) * 8;
    if (nk <= 0) return;
    int idA[16], idB[16], idN[16]; uint4 dA[16], dB[16];
    PeerStep sA = peer_step(0, bid, G, wave), sB = peer_step(1, bid, G, wave);
    PEER_LD_IDX(idA, sA); PEER_LD_TAB(dA, idA, V8, sA); PEER_LD_IDX(idB, sB);
#pragma unroll 1
    for (int k = 0; k < nk; k += 2) {
        PEER_LD_TAB(dB, idB, V8, sB);
        const PeerStep nA = peer_step(k + 2 < nk ? k + 2 : k, bid, G, wave), nB = peer_step(k + 3 < nk ? k + 3 : k + 1, bid, G, wave);
        PEER_LD_IDX(idN, nA);
        peer_v_compute(dA, idA, WSC[sA.t], XB + (size_t)sA.t * DM + sA.s * 128, SSQ + (size_t)sA.t * 16 + 2 * sA.s, g, j, do_store);
#pragma unroll
        for (int q = 0; q < 16; ++q) idA[q] = idN[q];
        PEER_LD_TAB(dA, idA, V8, nA);
        PEER_LD_IDX(idN, nB);
        peer_v_compute(dB, idB, WSC[sB.t], XB + (size_t)sB.t * DM + sB.s * 128, SSQ + (size_t)sB.t * 16 + 2 * sB.s, g, j, do_store);
#pragma unroll
        for (int q = 0; q < 16; ++q) idB[q] = idN[q];
        sA = nA; sB = nB;
    }
}
typedef short bf16x8_t __attribute__((ext_vector_type(8)));
typedef float f32x16_t __attribute__((ext_vector_type(16)));
__device__ __forceinline__ bf16x8_t mk_bf16x8(uint2 a, uint2 b) { uint4 v; v.x = a.x; v.y = a.y; v.z = b.x; v.w = b.y; return __builtin_bit_cast(bf16x8_t, v); }
__device__ __forceinline__ void xattn_unit(char* lds, const bf16_t* __restrict__ Q, const bf16_t* __restrict__ Kb, const bf16_t* __restrict__ VTb, bf16_t* __restrict__ O, int t0, int h, int tid_in, const bool do_store = true) {
    int tid = tid_in; asm volatile("" : "+v"(tid));
    const int lane = tid & 63, wave = __builtin_amdgcn_readfirstlane(tid >> 6), r = lane & 31, hh = lane >> 5, tq = wave & 3, dh = wave >> 2;
    char* Il = lds;
    uint4 kr0, kr1, kr2, kr3, kr4, kr5, kr6, kr7, kr8, kr9, kr10, kr11, kr12, kr13, kr14, kr15;
#define XA_LDK(i_) do { const int c = tid + 512 * (i_); kr##i_ = *(const uint4*)(Kb + (size_t)(c >> 5) * 2048 + (c & 31) * 8); } while (0)
    XA_LDK(0); XA_LDK(1); XA_LDK(2); XA_LDK(3); XA_LDK(4); XA_LDK(5); XA_LDK(6); XA_LDK(7); XA_LDK(8); XA_LDK(9); XA_LDK(10); XA_LDK(11); XA_LDK(12); XA_LDK(13); XA_LDK(14); XA_LDK(15);
#undef XA_LDK
#pragma unroll
    for (int i = 0; i < 8; ++i) { const int c = tid + 512 * i; *(uint4*)(Il + (c >> 5) * 528 + (c & 31) * 16) = *(const uint4*)(Q + (size_t)(t0 + (c >> 5)) * DM + h * 256 + (c & 31) * 8); }
    __syncthreads();
    bf16x8_t qf[16];
#pragma unroll
    for (int ks = 0; ks < 16; ++ks) qf[ks] = *(const bf16x8_t*)(Il + (tq * 32 + r) * 528 + (16 * ks + 8 * hh) * 2);
    __syncthreads();
#define XA_STK(i_) do { const int c = tid + 512 * (i_); *(uint4*)(Il + (c >> 5) * 528 + (c & 31) * 16) = kr##i_; } while (0)
    XA_STK(0); XA_STK(1); XA_STK(2); XA_STK(3); XA_STK(4); XA_STK(5); XA_STK(6); XA_STK(7); XA_STK(8); XA_STK(9); XA_STK(10); XA_STK(11); XA_STK(12); XA_STK(13); XA_STK(14); XA_STK(15);
#undef XA_STK
    __syncthreads();
    f32x16_t sc0, sc1, sc2, sc3, sc4, sc5, sc6, sc7;
#define XA_S(S_, mb_) do { _Pragma("unroll") for (int i = 0; i < 16; ++i) S_[i] = 0.f; \
        _Pragma("unroll") for (int ks = 0; ks < 16; ++ks) { const bf16x8_t kf = *(const bf16x8_t*)(Il + ((mb_) * 32 + r) * 528 + (16 * ks + 8 * hh) * 2); S_ = __builtin_amdgcn_mfma_f32_32x32x16_bf16(kf, qf[ks], S_, 0, 0, 0); } } while (0)
    XA_S(sc0, 0); XA_S(sc1, 1); XA_S(sc2, 2); XA_S(sc3, 3); XA_S(sc4, 4); XA_S(sc5, 5); XA_S(sc6, 6); XA_S(sc7, 7);
#undef XA_S
    uint4 vr0, vr1, vr2, vr3, vr4, vr5, vr6, vr7, vr8, vr9, vr10, vr11, vr12, vr13, vr14, vr15;
    int tv = tid; asm volatile("" : "+v"(tv));
#define XA_LDV(i_) do { const int c = tv + 512 * (i_); vr##i_ = *(const uint4*)(VTb + (size_t)(c >> 5) * 256 + (c & 31) * 8); } while (0)
    XA_LDV(0); XA_LDV(1); XA_LDV(2); XA_LDV(3); XA_LDV(4); XA_LDV(5); XA_LDV(6); XA_LDV(7);
    float mx = sc0[0];
#define XA_MAX(S_) do { _Pragma("unroll") for (int i = 0; i < 16; ++i) mx = fmaxf(mx, S_[i]); } while (0)
    XA_MAX(sc0); XA_MAX(sc1); XA_MAX(sc2); XA_MAX(sc3); XA_MAX(sc4); XA_MAX(sc5); XA_MAX(sc6); XA_MAX(sc7);
#undef XA_MAX
    mx = xor32_max(mx);
    float ps = 0.f;
    bf16x8_t pf00, pf01, pf10, pf11, pf20, pf21, pf30, pf31, pf40, pf41, pf50, pf51, pf60, pf61, pf70, pf71;
#define XA_P(S_, P0_, P1_) do { _Pragma("unroll") for (int i = 0; i < 16; ++i) { S_[i] = __builtin_amdgcn_exp2f(S_[i] - mx); ps += S_[i]; } \
        { uint4 w; w.x = pk2bf(S_[0], S_[1]); w.y = pk2bf(S_[2], S_[3]); w.z = pk2bf(S_[4], S_[5]); w.w = pk2bf(S_[6], S_[7]); P0_ = __builtin_bit_cast(bf16x8_t, w); } \
        { uint4 w; w.x = pk2bf(S_[8], S_[9]); w.y = pk2bf(S_[10], S_[11]); w.z = pk2bf(S_[12], S_[13]); w.w = pk2bf(S_[14], S_[15]); P1_ = __builtin_bit_cast(bf16x8_t, w); } } while (0)
    XA_P(sc0, pf00, pf01); XA_P(sc1, pf10, pf11); XA_P(sc2, pf20, pf21); XA_P(sc3, pf30, pf31); XA_P(sc4, pf40, pf41); XA_P(sc5, pf50, pf51); XA_P(sc6, pf60, pf61); XA_P(sc7, pf70, pf71);
#undef XA_P
    ps = xor32_sum(ps);
    const float inv = 1.0f / ps;
    XA_LDV(8); XA_LDV(9); XA_LDV(10); XA_LDV(11); XA_LDV(12); XA_LDV(13); XA_LDV(14); XA_LDV(15);
#undef XA_LDV
    __syncthreads();
#define XA_STV(i_) do { const int c = tv + 512 * (i_); *(uint4*)(Il + (c >> 5) * 528 + (c & 31) * 16) = vr##i_; } while (0)
    XA_STV(0); XA_STV(1); XA_STV(2); XA_STV(3); XA_STV(4); XA_STV(5); XA_STV(6); XA_STV(7); XA_STV(8); XA_STV(9); XA_STV(10); XA_STV(11); XA_STV(12); XA_STV(13); XA_STV(14); XA_STV(15);
#undef XA_STV
    __syncthreads();
    f32x16_t o[4];
#define XA_PV(db_, mb_, P0_, P1_) do { const char* vp = Il + (dh * 128 + (db_) * 32 + r) * 528 + ((mb_) * 32 + 4 * hh) * 2; \
        o[db_] = __builtin_amdgcn_mfma_f32_32x32x16_bf16(mk_bf16x8(*(const uint2*)vp, *(const uint2*)(vp + 16)), P0_, o[db_], 0, 0, 0); \
        o[db_] = __builtin_amdgcn_mfma_f32_32x32x16_bf16(mk_bf16x8(*(const uint2*)(vp + 32), *(const uint2*)(vp + 48)), P1_, o[db_], 0, 0, 0); } while (0)
#pragma unroll
    for (int db = 0; db < 4; ++db) {
#pragma unroll
        for (int i = 0; i < 16; ++i) o[db][i] = 0.f;
        XA_PV(db, 0, pf00, pf01); XA_PV(db, 1, pf10, pf11); XA_PV(db, 2, pf20, pf21); XA_PV(db, 3, pf30, pf31); XA_PV(db, 4, pf40, pf41); XA_PV(db, 5, pf50, pf51); XA_PV(db, 6, pf60, pf61); XA_PV(db, 7, pf70, pf71);
    }
#undef XA_PV
    __syncthreads();
    char* Ost = Il + wave * 8704;
#pragma unroll
    for (int db = 0; db < 4; ++db)
#pragma unroll
        for (int g = 0; g < 4; ++g) { uint2 w; w.x = pk2bf(o[db][4 * g] * inv, o[db][4 * g + 1] * inv); w.y = pk2bf(o[db][4 * g + 2] * inv, o[db][4 * g + 3] * inv); *(uint2*)(Ost + r * 272 + (db * 32 + 8 * g + 4 * hh) * 2) = w; }
    bf16_t* obase = O + (size_t)(t0 + tq * 32) * DM + h * 256 + dh * 128;
#pragma unroll
    for (int i = 0; i < 8; ++i) { const int c = lane + 64 * i, row = c >> 4, ch = c & 15; const uint4 v = *(const uint4*)(Ost + row * 272 + ch * 16); if (do_store) nt_st16(obase + (size_t)row * DM + ch * 8, v); }
    __syncthreads();
}
__device__ __forceinline__ void sb_wave(char* ldsw, bf16_t* MIXQ, const bf16_t* __restrict__ PROJ2, const bf16_t* __restrict__ SVT, const float* __restrict__ sbn, int b, int h, int t0, int lane, const bool do_store = true) {
    const int r = lane & 31, hh = lane >> 5;
    char* Kw = ldsw; char* Vw = ldsw + 4608;
    bf16_t* qrow = MIXQ + ((size_t)b * SEQ + t0 + r) * DM + h * 64;
    bf16x8_t qf[4];
#pragma unroll
    for (int ks = 0; ks < 4; ++ks) qf[ks] = *(const bf16x8_t*)(qrow + 16 * ks + 8 * hh);
    const bf16_t* Kg = PROJ2 + ((size_t)b * SEQ + (lane >> 3)) * 1536 + h * 64 + (lane & 7) * 8;
    const bf16_t* Vg = SVT + ((size_t)(b * 8 + h) * 64 + (lane >> 2)) * SEQ + (lane & 3) * 8;
    char* Kst = Kw + (lane >> 3) * 144 + (lane & 7) * 16; char* Vst = Vw + (lane >> 2) * 72 + (lane & 3) * 16;
    const char* Kfr = Kw + r * 144 + 16 * hh; const char* Vfr = Vw + r * 72 + 8 * hh;
    f32x16_t o0, o1;
#pragma unroll
    for (int i = 0; i < 16; ++i) { o0[i] = 0.f; o1[i] = 0.f; }
    float carry = 0.f;
    uint4 gk0, gk1, gk2, gk3, gv0, gv1, gv2, gv3;
#define SB_GLOAD(k0_) do { const bf16_t* kp_ = Kg + (size_t)(k0_) * 1536; gk0 = *(const uint4*)kp_; gk1 = *(const uint4*)(kp_ + 8 * 1536); gk2 = *(const uint4*)(kp_ + 16 * 1536); gk3 = *(const uint4*)(kp_ + 24 * 1536); \
        const bf16_t* vp_ = Vg + (k0_); gv0 = *(const uint4*)vp_; gv1 = *(const uint4*)(vp_ + 16 * SEQ); gv2 = *(const uint4*)(vp_ + 32 * SEQ); gv3 = *(const uint4*)(vp_ + 48 * SEQ); } while (0)
#define SB_VST(p_, v_) do { uint2 lo_, hi_; lo_.x = (v_).x; lo_.y = (v_).y; hi_.x = (v_).z; hi_.y = (v_).w; *(uint2*)(p_) = lo_; *(uint2*)((p_) + 8) = hi_; } while (0)
    SB_GLOAD(t0);
#pragma unroll 1
    for (int k0 = t0; k0 >= 0; k0 -= 32) {
        *(uint4*)Kst = gk0; *(uint4*)(Kst + 8 * 144) = gk1; *(uint4*)(Kst + 16 * 144) = gk2; *(uint4*)(Kst + 24 * 144) = gk3;
        SB_VST(Vst, gv0); SB_VST(Vst + 16 * 72, gv1); SB_VST(Vst + 32 * 72, gv2); SB_VST(Vst + 48 * 72, gv3);
        if (k0 >= 32) SB_GLOAD(k0 - 32);
        bf16x8_t kf[4], vf[4];
#pragma unroll
        for (int ks = 0; ks < 4; ++ks) kf[ks] = *(const bf16x8_t*)(Kfr + 32 * ks);
#pragma unroll
        for (int db = 0; db < 2; ++db)
#pragma unroll
            for (int s2 = 0; s2 < 2; ++s2) { const char* vp = Vfr + db * 32 * 72 + 32 * s2; vf[db * 2 + s2] = mk_bf16x8(*(const uint2*)vp, *(const uint2*)(vp + 16)); }
        f32x16_t s;
#pragma unroll
        for (int i = 0; i < 16; ++i) s[i] = 0.f;
#pragma unroll
        for (int ks = 0; ks < 4; ++ks) s = __builtin_amdgcn_mfma_f32_32x32x16_bf16(kf[ks], qf[ks], s, 0, 0, 0);
        const bool diag = (k0 == t0);
        float lb[16];
#pragma unroll
        for (int i = 0; i < 16; ++i) {
            const float z = s[i]; const float e = __builtin_amdgcn_exp2f(-fabsf(z));
            float v = -(fmaxf(z, 0.f) + __builtin_amdgcn_logf(1.0f + e));
            if (diag && ((i & 3) + 8 * (i >> 2) + 4 * hh >= r)) v = 0.f;
            lb[i] = v;
        }
        float gs[4], pg[4], off[4];
#pragma unroll
        for (int g = 0; g < 4; ++g) { lb[4 * g + 2] += lb[4 * g + 3]; lb[4 * g + 1] += lb[4 * g + 2]; lb[4 * g] += lb[4 * g + 1]; gs[g] = lb[4 * g]; }
#pragma unroll
        for (int g = 0; g < 4; ++g) pg[g] = xor32_get(gs[g], hh);
        float run = 0.f;
#pragma unroll
        for (int g = 3; g >= 0; --g) { off[g] = run + (hh == 0 ? pg[g] : 0.f); run += gs[g] + pg[g]; }
#pragma unroll
        for (int i = 0; i < 16; ++i) {
            float p = __builtin_amdgcn_exp2f(s[i] + lb[i] + off[i >> 2] + carry);
            if (diag && ((i & 3) + 8 * (i >> 2) + 4 * hh >= r)) p = 0.f;
            s[i] = p;
        }
        carry += run;
        bf16x8_t pf[2];
#pragma unroll
        for (int s2 = 0; s2 < 2; ++s2) { uint4 w; w.x = pk2bf(s[8 * s2], s[8 * s2 + 1]); w.y = pk2bf(s[8 * s2 + 2], s[8 * s2 + 3]); w.z = pk2bf(s[8 * s2 + 4], s[8 * s2 + 5]); w.w = pk2bf(s[8 * s2 + 6], s[8 * s2 + 7]); pf[s2] = __builtin_bit_cast(bf16x8_t, w); }
#pragma unroll
        for (int s2 = 0; s2 < 2; ++s2) { o0 = __builtin_amdgcn_mfma_f32_32x32x16_bf16(vf[s2], pf[s2], o0, 0, 0, 0); o1 = __builtin_amdgcn_mfma_f32_32x32x16_bf16(vf[2 + s2], pf[s2], o1, 0, 0, 0); }
        if (__all(carry < -64.f)) break;
    }
#undef SB_GLOAD
#undef SB_VST
    float ss = 0.f;
#pragma unroll
    for (int i = 0; i < 16; ++i) ss += o0[i] * o0[i] + o1[i] * o1[i];
    ss = xor32_sum(ss);
    const float rstd = rsqrtf(ss * (1.0f / 64.0f) + EPS);
#pragma unroll
    for (int g = 0; g < 4; ++g) {
        const int d = 8 * g + 4 * hh;
        const float4 g0 = *(const float4*)(sbn + h * 64 + d), g1 = *(const float4*)(sbn + h * 64 + 32 + d);
        uint2 w0, w1;
        w0.x = pk2bf(o0[4 * g] * rstd * g0.x, o0[4 * g + 1] * rstd * g0.y); w0.y = pk2bf(o0[4 * g + 2] * rstd * g0.z, o0[4 * g + 3] * rstd * g0.w);
        w1.x = pk2bf(o1[4 * g] * rstd * g1.x, o1[4 * g + 1] * rstd * g1.y); w1.y = pk2bf(o1[4 * g + 2] * rstd * g1.z, o1[4 * g + 3] * rstd * g1.w);
        *(uint2*)(Kw + r * 144 + d * 2) = w0; *(uint2*)(Kw + r * 144 + (32 + d) * 2) = w1;
    }
    { bf16_t* ob = MIXQ + ((size_t)b * SEQ + t0) * DM + h * 64;
#pragma unroll
      for (int i = 0; i < 4; ++i) { const int p = lane + 64 * i, row = p >> 3, ch = p & 7; const uint4 v = *(const uint4*)(Kw + row * 144 + ch * 16); if (do_store) *(uint4*)(ob + (size_t)row * DM + ch * 8) = v; } }
}

__device__ __forceinline__ void ret_unit(char* lds, bf16_t* MIXQ, const bf16_t* __restrict__ PROJ2, const bf16_t* __restrict__ RKT, const bf16_t* __restrict__ RVT, const float* __restrict__ rn, int b, int h, int j, int tid, const bool do_store = true) {
    const int lane = tid & 63, wave = __builtin_amdgcn_readfirstlane(tid >> 6), r = lane & 31, hh = lane >> 5;
    const int eh = wave >> 2, cq = eh ? 3 - (wave & 3) : (wave & 3);
    const int eb4 = wave & 3, dp = wave >> 2;
    char* Kl = lds; char* KzT = lds + 34816; char* VTl = lds + 69632; char* stT = lds + 104448; float* xch = (float*)(lds + 139264);
    const float lg2 = log2f(1.0f - exp2f(-5.0f - (float)h));
    const float g128 = exp2f(128.0f * lg2);
    float Ei[16];
#pragma unroll
    for (int i = 0; i < 16; ++i) Ei[i] = __builtin_amdgcn_exp2f(-(float)((i & 3) + 8 * (i >> 2)) * lg2);
    f32x16_t st0, st1;
#pragma unroll
    for (int i = 0; i < 16; ++i) { st0[i] = 0.f; st1[i] = 0.f; }
    const size_t bh = (size_t)b * 4 + h;
    if (j > 0) {
        uint4 az0, az1, az2, az3, av0, av1, av2, av3;
#define RET_LOAD(P_, i_, n_) do { int t_ = tid; asm volatile("" : "+v"(t_)); const int c_ = t_ + 512 * (i_), rw_ = c_ >> 4, ch_ = c_ & 15; \
        P_##z##i_ = *(const uint4*)(RKT + (bh * 128 + rw_) * SEQ + (n_) * 128 + ch_ * 8); P_##v##i_ = *(const uint4*)(RVT + (bh * 128 + rw_) * SEQ + (n_) * 128 + ch_ * 8); } while (0)
#define RET_STAGE(P_, i_) do { int t_ = tid; asm volatile("" : "+v"(t_)); const int c_ = t_ + 512 * (i_), rw_ = c_ >> 4, ch_ = c_ & 15; *(uint4*)(KzT + rw_ * 272 + ch_ * 16) = P_##z##i_; *(uint4*)(VTl + rw_ * 272 + ch_ * 16) = P_##v##i_; } while (0)
#define RET_STATE() do { _Pragma("unroll") for (int i = 0; i < 16; ++i) { st0[i] *= g128; st1[i] *= g128; } \
        _Pragma("unroll") for (int ks = 0; ks < 8; ++ks) { const bf16x8_t bv_ = *(const bf16x8_t*)(VTl + (eb4 * 32 + r) * 272 + (16 * ks + 8 * hh) * 2); \
            const bf16x8_t a0_ = *(const bf16x8_t*)(KzT + ((2 * dp) * 32 + r) * 272 + (16 * ks + 8 * hh) * 2), a1_ = *(const bf16x8_t*)(KzT + ((2 * dp + 1) * 32 + r) * 272 + (16 * ks + 8 * hh) * 2); \
            st0 = __builtin_amdgcn_mfma_f32_32x32x16_bf16(a0_, bv_, st0, 0, 0, 0); st1 = __builtin_amdgcn_mfma_f32_32x32x16_bf16(a1_, bv_, st1, 0, 0, 0); } } while (0)
        RET_LOAD(a, 0, 0); RET_LOAD(a, 1, 0); RET_LOAD(a, 2, 0); RET_LOAD(a, 3, 0);
#pragma unroll 1
        for (int n = 0; n < 4 * j; ++n) {
            __syncthreads();
            RET_STAGE(a, 0); RET_STAGE(a, 1); RET_STAGE(a, 2); RET_STAGE(a, 3);
            __syncthreads();
            if (n + 1 < 4 * j) { RET_LOAD(a, 0, n + 1); RET_LOAD(a, 1, n + 1); RET_LOAD(a, 2, n + 1); RET_LOAD(a, 3, n + 1); }
            RET_STATE();
        }
#undef RET_LOAD
#undef RET_STAGE
#undef RET_STATE
    }
    uint4 fz0, fz1, fz2, fz3, fv0, fv1, fv2, fv3, fk0, fk1, fk2, fk3;
#define FL_LOAD(i_, n_) do { int t_ = tid; asm volatile("" : "+v"(t_)); const int c_ = t_ + 512 * (i_), rw_ = c_ >> 4, ch_ = c_ & 15; \
        fz##i_ = *(const uint4*)(RKT + (bh * 128 + rw_) * SEQ + (n_) * 128 + ch_ * 8); fv##i_ = *(const uint4*)(RVT + (bh * 128 + rw_) * SEQ + (n_) * 128 + ch_ * 8); } while (0)
#define FL_STAGE(i_) do { int t_ = tid; asm volatile("" : "+v"(t_)); const int c_ = t_ + 512 * (i_), rw_ = c_ >> 4, ch_ = c_ & 15; \
        *(uint4*)(KzT + rw_ * 272 + ch_ * 16) = fz##i_; *(uint4*)(VTl + rw_ * 272 + ch_ * 16) = fv##i_; \
        *(uint4*)(Kl + rw_ * 272 + ch_ * 16) = fk##i_; } while (0)
#define FK_LOAD(i_) do { int t_ = tid; asm volatile("" : "+v"(t_)); const int c_ = t_ + 512 * (i_), rw_ = c_ >> 4, ch_ = c_ & 15; \
        fk##i_ = *(const uint4*)(PROJ2 + (row0 + rw_) * 1536 + 512 + h * 128 + ch_ * 8); } while (0)
    FL_LOAD(0, 4 * j); FL_LOAD(1, 4 * j); FL_LOAD(2, 4 * j); FL_LOAD(3, 4 * j);
#pragma unroll 1
    for (int n = 4 * j; n < 4 * j + 4; ++n) {
        const bool full = true;
        int rl = r; asm volatile("" : "+v"(rl));
        const size_t row0 = (size_t)b * SEQ + n * 128;
        FK_LOAD(0); FK_LOAD(1); FK_LOAD(2); FK_LOAD(3);
        bf16x8_t qf[8]; uint2 gA0, gA1, gA2, gA3, gB0, gB1, gB2, gB3;
        if (full) {
            const bf16_t* qrow = MIXQ + (row0 + cq * 32 + rl) * DM + 512 + h * 128 + 8 * hh;
#pragma unroll
            for (int ks = 0; ks < 8; ++ks) qf[ks] = *(const bf16x8_t*)(qrow + 16 * ks);
        }
        __syncthreads();
        FL_STAGE(0); FL_STAGE(1); FL_STAGE(2); FL_STAGE(3);
        if (full) {
#pragma unroll
            for (int g = 0; g < 4; ++g) { uint2 w0, w1; w0.x = pk2bf(st0[4 * g], st0[4 * g + 1]); w0.y = pk2bf(st0[4 * g + 2], st0[4 * g + 3]); w1.x = pk2bf(st1[4 * g], st1[4 * g + 1]); w1.y = pk2bf(st1[4 * g + 2], st1[4 * g + 3]);
                *(uint2*)(stT + (eb4 * 32 + r) * 272 + ((2 * dp) * 32 + 8 * g + 4 * hh) * 2) = w0; *(uint2*)(stT + (eb4 * 32 + r) * 272 + ((2 * dp + 1) * 32 + 8 * g + 4 * hh) * 2) = w1; }
        }
        __syncthreads();
        f32x16_t ot0, ot1;
        if (full) {
            {
                int rg = r; asm volatile("" : "+v"(rg));
                const bf16_t* grow = PROJ2 + (row0 + cq * 32 + rg) * 1536 + 1024 + h * 128 + eh * 64 + 4 * hh;
                gA0 = *(const uint2*)(grow); gA1 = *(const uint2*)(grow + 8); gA2 = *(const uint2*)(grow + 16); gA3 = *(const uint2*)(grow + 24);
                gB0 = *(const uint2*)(grow + 32); gB1 = *(const uint2*)(grow + 40); gB2 = *(const uint2*)(grow + 48); gB3 = *(const uint2*)(grow + 56);
            }
#pragma unroll
            for (int i = 0; i < 16; ++i) { ot0[i] = 0.f; ot1[i] = 0.f; }
#pragma unroll
            for (int ks = 0; ks < 8; ++ks) {
                const bf16x8_t a0 = *(const bf16x8_t*)(stT + (eh * 64 + r) * 272 + (16 * ks + 8 * hh) * 2), a1 = *(const bf16x8_t*)(stT + (eh * 64 + 32 + r) * 272 + (16 * ks + 8 * hh) * 2);
                ot0 = __builtin_amdgcn_mfma_f32_32x32x16_bf16(a0, qf[ks], ot0, 0, 0, 0); ot1 = __builtin_amdgcn_mfma_f32_32x32x16_bf16(a1, qf[ks], ot1, 0, 0, 0); }
            const float xi = __builtin_amdgcn_exp2f((float)(cq * 32 + r + 1) * lg2);
#pragma unroll
            for (int i = 0; i < 16; ++i) { ot0[i] *= xi; ot1[i] *= xi; }
#pragma unroll 1
            for (int mb = 0; mb <= cq; ++mb) {
                f32x16_t s;
#pragma unroll
                for (int i = 0; i < 16; ++i) s[i] = 0.f;
#pragma unroll
                for (int ks = 0; ks < 8; ++ks) { const bf16x8_t a = *(const bf16x8_t*)(Kl + (mb * 32 + r) * 272 + (16 * ks + 8 * hh) * 2); s = __builtin_amdgcn_mfma_f32_32x32x16_bf16(a, qf[ks], s, 0, 0, 0); }
                const int cm = (cq - mb) * 32 + r - 4 * hh;
                const float base = __builtin_amdgcn_exp2f((float)cm * lg2);
                if (mb == cq) {
#pragma unroll
                    for (int i = 0; i < 16; ++i) { const int dl = cm - ((i & 3) + 8 * (i >> 2)); s[i] = dl >= 0 ? s[i] * (base * Ei[i]) : 0.f; }
                } else {
#pragma unroll
                    for (int i = 0; i < 16; ++i) s[i] *= base * Ei[i];
                }
                bf16x8_t pf[2];
#pragma unroll
                for (int s2 = 0; s2 < 2; ++s2) { uint4 w; w.x = pk2bf(s[8 * s2], s[8 * s2 + 1]); w.y = pk2bf(s[8 * s2 + 2], s[8 * s2 + 3]); w.z = pk2bf(s[8 * s2 + 4], s[8 * s2 + 5]); w.w = pk2bf(s[8 * s2 + 6], s[8 * s2 + 7]); pf[s2] = __builtin_bit_cast(bf16x8_t, w); }
#pragma unroll
                for (int s2 = 0; s2 < 2; ++s2) {
                    const char* vp0 = VTl + (eh * 64 + r) * 272 + (mb * 32 + 16 * s2 + 4 * hh) * 2; const char* vp1 = vp0 + 32 * 272;
                    ot0 = __builtin_amdgcn_mfma_f32_32x32x16_bf16(mk_bf16x8(*(const uint2*)vp0, *(const uint2*)(vp0 + 16)), pf[s2], ot0, 0, 0, 0);
                    ot1 = __builtin_amdgcn_mfma_f32_32x32x16_bf16(mk_bf16x8(*(const uint2*)vp1, *(const uint2*)(vp1 + 16)), pf[s2], ot1, 0, 0, 0); }
            }
            float s1 = 0.f, s2v = 0.f;
#pragma unroll
            for (int i = 0; i < 16; ++i) { s1 += ot0[i] + ot1[i]; s2v += ot0[i] * ot0[i] + ot1[i] * ot1[i]; }
            s1 = xor32_sum(s1); s2v = xor32_sum(s2v);
            if (hh == 0) { xch[(eh * 128 + cq * 32 + r) * 2] = s1; xch[(eh * 128 + cq * 32 + r) * 2 + 1] = s2v; }
        }
#pragma unroll
        for (int i = 0; i < 16; ++i) { st0[i] *= g128; st1[i] *= g128; }
#pragma unroll
        for (int ks = 0; ks < 8; ++ks) {
            const bf16x8_t bv = *(const bf16x8_t*)(VTl + (eb4 * 32 + r) * 272 + (16 * ks + 8 * hh) * 2);
            const bf16x8_t a0 = *(const bf16x8_t*)(KzT + ((2 * dp) * 32 + r) * 272 + (16 * ks + 8 * hh) * 2), a1 = *(const bf16x8_t*)(KzT + ((2 * dp + 1) * 32 + r) * 272 + (16 * ks + 8 * hh) * 2);
            st0 = __builtin_amdgcn_mfma_f32_32x32x16_bf16(a0, bv, st0, 0, 0, 0); st1 = __builtin_amdgcn_mfma_f32_32x32x16_bf16(a1, bv, st1, 0, 0, 0); }
        if (full) {
            const float* gn = rn + h * 128 + eh * 64 + 4 * hh;
            const float4 nA0 = *(const float4*)(gn), nA1 = *(const float4*)(gn + 8), nA2 = *(const float4*)(gn + 16), nA3 = *(const float4*)(gn + 24);
            const float4 nB0 = *(const float4*)(gn + 32), nB1 = *(const float4*)(gn + 40), nB2 = *(const float4*)(gn + 48), nB3 = *(const float4*)(gn + 56);
            __syncthreads();
            if (n + 1 < 4 * j + 4) { FL_LOAD(0, n + 1); FL_LOAD(1, n + 1); FL_LOAD(2, n + 1); FL_LOAD(3, n + 1); }
            const int c = cq * 32 + rl;
            const float t1 = xch[c * 2] + xch[(128 + c) * 2], t2 = xch[c * 2 + 1] + xch[(128 + c) * 2 + 1];
            const float mu = t1 * (1.0f / 128.0f); const float var = fmaxf(t2 * (1.0f / 128.0f) - mu * mu, 0.f); const float rstd = rsqrtf(var + EPS);
            char* Ow = lds + wave * 4608;
#pragma unroll
            for (int g = 0; g < 4; ++g) {
                const uint2 ga = g == 0 ? gA0 : (g == 1 ? gA1 : (g == 2 ? gA2 : gA3)), gb = g == 0 ? gB0 : (g == 1 ? gB1 : (g == 2 ? gB2 : gB3));
                const float4 na = g == 0 ? nA0 : (g == 1 ? nA1 : (g == 2 ? nA2 : nA3)), nb = g == 0 ? nB0 : (g == 1 ? nB1 : (g == 2 ? nB2 : nB3));
                const float gav[4] = {__uint_as_float(ga.x << 16), __uint_as_float(ga.x & 0xFFFF0000u), __uint_as_float(ga.y << 16), __uint_as_float(ga.y & 0xFFFF0000u)};
                const float gbv[4] = {__uint_as_float(gb.x << 16), __uint_as_float(gb.x & 0xFFFF0000u), __uint_as_float(gb.y << 16), __uint_as_float(gb.y & 0xFFFF0000u)};
                const float nav[4] = {na.x, na.y, na.z, na.w}, nbv[4] = {nb.x, nb.y, nb.z, nb.w};
                float ya[4], yb[4];
#pragma unroll
                for (int k = 0; k < 4; ++k) { ya[k] = (ot0[4 * g + k] - mu) * rstd * nav[k] * (gav[k] * __builtin_amdgcn_rcpf(1.0f + __builtin_amdgcn_exp2f(-1.4426950408889634f * gav[k]))); yb[k] = (ot1[4 * g + k] - mu) * rstd * nbv[k] * (gbv[k] * __builtin_amdgcn_rcpf(1.0f + __builtin_amdgcn_exp2f(-1.4426950408889634f * gbv[k]))); }
                uint2 w0, w1; w0.x = pk2bf(ya[0], ya[1]); w0.y = pk2bf(ya[2], ya[3]); w1.x = pk2bf(yb[0], yb[1]); w1.y = pk2bf(yb[2], yb[3]);
                *(uint2*)(Ow + rl * 144 + (8 * g + 4 * hh) * 2) = w0; *(uint2*)(Ow + rl * 144 + (32 + 8 * g + 4 * hh) * 2) = w1;
            }
            { int ll = lane; asm volatile("" : "+v"(ll));
              bf16_t* ob = MIXQ + (row0 + cq * 32) * DM + 512 + h * 128 + eh * 64;
#pragma unroll
              for (int i = 0; i < 4; ++i) { const int p = ll + 64 * i, row = p >> 3, ch = p & 7; const uint4 v = *(const uint4*)(Ow + row * 144 + ch * 16); if (do_store) *(uint4*)(ob + (size_t)row * DM + ch * 8) = v; } }
        }
    }
#undef FL_LOAD
#undef FL_STAGE
#undef FK_LOAD
    __syncthreads();
}
#define XB_TMO      128
#define XB_XCNT(j)  (256  + 64 * (j))
#define XB_XSUB(j)  (1280 + 64 * (j))
#define XB_XGEN(j)  (2304 + 64 * (j))
#define XB_TOP      3328
#define XB_TOPGEN   3392
#define XB_SPIN_CAP (1u << 20)
typedef __attribute__((address_space(3))) unsigned lds_u32;
__device__ __forceinline__ unsigned xb_ld(unsigned* p)              { return __hip_atomic_load(p, __ATOMIC_RELAXED, __HIP_MEMORY_SCOPE_AGENT); }
__device__ __forceinline__ unsigned xb_add(unsigned* p, unsigned v) { return __hip_atomic_fetch_add(p, v, __ATOMIC_RELAXED, __HIP_MEMORY_SCOPE_AGENT); }
__device__ __forceinline__ unsigned xb_xcc_id() { return (unsigned)__builtin_amdgcn_s_getreg((3 << 11) | 20) & 0xFu; }
#define XB_SPIN(cond, bar) do { unsigned _sp = 0; while (cond) { __builtin_amdgcn_s_sleep(1); \
    if ((++_sp & 255u) == 0u) { if (xb_ld(&(bar)[XB_TMO])) break; if (_sp > XB_SPIN_CAP) { atomicAdd(&(bar)[XB_TMO], 1u); break; } } } } while (0)
__device__ __forceinline__ void xcd_barrier_post(unsigned* bar) { if (threadIdx.x == 0) (void)xb_add(&bar[XB_XCNT(xb_xcc_id())], 1u); }
__device__ __forceinline__ void xcd_barrier_complete(unsigned* bar, unsigned x, unsigned& nloc, unsigned& nx) {
    const unsigned G = gridDim.x * gridDim.y * gridDim.z;
    unsigned sum, cnt, mine, sp = 0u;
    for (;;) {
        sum = 0u; cnt = 0u; mine = 0u;
#pragma unroll
        for (unsigned j = 0; j < 16; ++j) { const unsigned c = xb_ld(&bar[XB_XCNT(j)]); sum += c; cnt += (c > 0u) ? 1u : 0u; mine = (j == x) ? c : mine; }
        if (sum == G) break;
        __builtin_amdgcn_s_sleep(1);
        if ((++sp & 255u) == 0u) { if (xb_ld(&bar[XB_TMO])) break; if (sp > XB_SPIN_CAP) { atomicAdd(&bar[XB_TMO], 1u); break; } }
    }
    nloc = mine > 0u ? mine : 1u; nx = cnt > 0u ? cnt : 1u;
}
__device__ __forceinline__ void xcd_barrier(unsigned* bar, volatile lds_u32* st, const bool thread0) {
    asm volatile("s_waitcnt vmcnt(0)" ::: "memory");
    __syncthreads();
    if (thread0) {
        __builtin_amdgcn_s_waitcnt(0);
        const unsigned x = xb_xcc_id();
        unsigned nloc = st[0], nx = st[1];
        if (nloc == 0u) { xcd_barrier_complete(bar, x, nloc, nx); st[0] = nloc; st[1] = nx; }
        const unsigned old = xb_add(&bar[XB_XSUB(x)], 1u);
        const unsigned gen = old / nloc;
        if (old + 1u == (gen + 1u) * nloc) {
            __builtin_amdgcn_fence(__ATOMIC_RELEASE, "agent");
            asm volatile("s_waitcnt vmcnt(0)" ::: "memory");
            const unsigned og = xb_add(&bar[XB_TOP], 1u);
            const unsigned tg = og / nx;
            if (og + 1u == (tg + 1u) * nx) xb_add(&bar[XB_TOPGEN], 1u);
            else XB_SPIN(xb_ld(&bar[XB_TOPGEN]) == tg, bar);
            __builtin_amdgcn_fence(__ATOMIC_ACQUIRE, "agent");
        } else {
            XB_SPIN(xb_ld(&bar[XB_TOPGEN]) == gen, bar);
            __builtin_amdgcn_fence(__ATOMIC_ACQUIRE, "agent");
            asm volatile("s_waitcnt vmcnt(0)" ::: "memory");
        }
    }
    __syncthreads();
}
__device__ __forceinline__ int lane_id_volatile() { int l; asm volatile("v_mbcnt_lo_u32_b32 %0, -1, 0\n\tv_mbcnt_hi_u32_b32 %0, -1, %0" : "=v"(l)); return l; }
struct Params { const float* in[18]; float* out; char* ws; };
constexpr int LDS_BYTES = 147456, BARW_OFF = 147392;
#define GRID_BAR() do { const __attribute__((address_space(4))) Params* kpb = (const __attribute__((address_space(4))) Params*)__builtin_amdgcn_kernarg_segment_ptr(); asm volatile("" : "+s"(kpb)); xcd_barrier((unsigned*)kpb->ws + 4096, (volatile lds_u32*)(lds_all + BARW_OFF), wave_s == 0 && lane_id_volatile() == 0); } while (0)
constexpr size_t MiB = 1u << 20;
constexpr size_t WS_ROT = 1, WS_SSQ = 2, WS_MEMSSQ = 4, WS_MEMB = 8, WS_KV = 16, WS_WIN = 48, WS_WOUT = 62, WS_WQ = 66, WS_WKV = 70, WS_WO = 78, WS_WP = 82,
                 WS_XB = 96, WS_MIXQ = 160, WS_PROJ2 = 224, WS_SVT = 320, WS_RVT = 352, WS_RKT = 384, WS_Q = 224, WS_O = 288, WS_SCORES = 224, WS_IDX = 384, WS_GATE = 400, WS_T8 = 416, WS_ISC = 5, WS_A = 224, WS_VT = 480, WS_END = 496;
#ifndef PHMASK
#define PHMASK 0xFFFFF
#endif
#define PH(k) if constexpr ((PHMASK >> (k)) & 1)
#ifndef REP0
#define REP0 1
#endif
#ifndef REP1
#define REP1 1
#endif
#ifndef REP12
#define REP12 1
#endif
#ifndef REP9B
#define REP9B 1
#endif
#ifndef REP9C
#define REP9C 1
#endif
#ifndef REP4
#define REP4 1
#endif
#ifndef REPR
#define REPR 1
#endif
#ifndef REPS
#define REPS 1
#endif
#ifndef REP5ST
#define REP5ST 1
#endif
#ifndef REP5
#define REP5 1
#endif
#ifndef REP8
#define REP8 1
#endif
#ifndef REP89
#define REP89 1
#endif
#ifdef PROBE_T
#define STAMP(i) do { if (blockIdx.x == 0 && wave_s == 0 && lane_id_volatile() == 0) ((volatile unsigned long long*)(lds_all + 146432))[i] = __builtin_amdgcn_s_memrealtime(); } while (0)
#else
#define STAMP(i) do {} while (0)
#endif
#define VB_LOOP(nvb) for (int vb = bid * 2 + (tid >> 8); vb < (nvb); vb += G * 2)

#define PHASE_VARS \
    const __attribute__((address_space(4))) Params* kp = (const __attribute__((address_space(4))) Params*)__builtin_amdgcn_kernarg_segment_ptr(); asm volatile("" : "+s"(kp)); \
    int tid; asm volatile("v_mbcnt_lo_u32_b32 %0, -1, 0\n\tv_mbcnt_hi_u32_b32 %0, -1, %0" : "=v"(tid)); tid += wave_s * 64; \
    const int lane = tid & 63, wave = __builtin_amdgcn_readfirstlane(tid >> 6), vtid = tid & 255; char* lds = lds_all + (tid >> 8) * 32768; \
    PG8_LAS unsigned char* glds = (PG8_LAS unsigned char*)lds_all; PG8_LAS float* rbuf = (PG8_LAS float*)(glds + 132096); \
    const int G = gridDim.x, bid = blockIdx.x; \
    const float* x = kp->in[0]; const float* mem = kp->in[1]; const float* mix_norm = kp->in[2]; const float* w_in = kp->in[3]; const float* sb_norm = kp->in[4]; const float* ret_norm = kp->in[5]; \
    const float* w_out = kp->in[6]; const float* xa_norm = kp->in[7]; const float* mem_norm = kp->in[8]; const float* xa_wq = kp->in[9]; const float* xa_wkv = kp->in[10]; const float* xa_wo = kp->in[11]; \
    const float* peer_norm = kp->in[12]; const float* peer_wq = kp->in[13]; const float* peer_keys = kp->in[14]; const float* peer_u = kp->in[15]; const float* peer_v = kp->in[16]; const float* final_norm = kp->in[17]; \
    float* XR = kp->out; char* ws = kp->ws; \
    float* SSQ = (float*)(ws + WS_SSQ * MiB); float* MEMSSQ = (float*)(ws + WS_MEMSSQ * MiB); \
    bf16_t* MEMB = (bf16_t*)(ws + WS_MEMB * MiB); bf16_t* KV = (bf16_t*)(ws + WS_KV * MiB); \
    bf16_t* WIN_T = (bf16_t*)(ws + WS_WIN * MiB); bf16_t* WOUT_T = (bf16_t*)(ws + WS_WOUT * MiB); bf16_t* WQ_T = (bf16_t*)(ws + WS_WQ * MiB); \
    bf16_t* WKV_T = (bf16_t*)(ws + WS_WKV * MiB); bf16_t* WO_T = (bf16_t*)(ws + WS_WO * MiB); bf16_t* WP_T = (bf16_t*)(ws + WS_WP * MiB); \
    bf16_t* XB = (bf16_t*)(ws + WS_XB * MiB); bf16_t* MIXQ = (bf16_t*)(ws + WS_MIXQ * MiB); bf16_t* PROJ2 = (bf16_t*)(ws + WS_PROJ2 * MiB); \
    bf16_t* Q = (bf16_t*)(ws + WS_Q * MiB); bf16_t* O = (bf16_t*)(ws + WS_O * MiB); bf16_t* SCORES = (bf16_t*)(ws + WS_SCORES * MiB); \
    int* IDX = (int*)(ws + WS_IDX * MiB); float* GATE = (float*)(ws + WS_GATE * MiB); unsigned char* T8 = (unsigned char*)(ws + WS_T8 * MiB); float* ISC = (float*)(ws + WS_ISC * MiB); float* WSC = (float*)(ws + WS_ISC * MiB + 524288); float* WMAX = (float*)(ws + 65536); unsigned char* WINQ = (unsigned char*)(ws + WS_WIN * MiB); unsigned char* XQ = (unsigned char*)XR; float* XS = (float*)((char*)XR + 64 * MiB); bf16_t* APART = (bf16_t*)(ws + WS_A * MiB); bf16_t* VT = (bf16_t*)(ws + WS_VT * MiB); bf16_t* SVT = (bf16_t*)(ws + WS_SVT * MiB); bf16_t* RVT = (bf16_t*)(ws + WS_RVT * MiB); bf16_t* RKT = (bf16_t*)(ws + WS_RKT * MiB); \
    (void)lane; (void)wave; (void)vtid; (void)lds; (void)glds; (void)rbuf; (void)G; (void)bid; (void)x; (void)mem; (void)mix_norm; (void)w_in; (void)sb_norm; (void)ret_norm; (void)w_out; (void)xa_norm; (void)mem_norm; \
    (void)xa_wq; (void)xa_wkv; (void)xa_wo; (void)peer_norm; (void)peer_wq; (void)peer_keys; (void)peer_u; (void)peer_v; (void)final_norm; (void)XR; (void)SSQ; (void)MEMSSQ; (void)MEMB; (void)KV; (void)WIN_T; \
    (void)WOUT_T; (void)WQ_T; (void)WKV_T; (void)WO_T; (void)WP_T; (void)XB; (void)MIXQ; (void)PROJ2; (void)Q; (void)O; (void)SCORES; (void)IDX; (void)GATE; (void)T8; (void)ISC; (void)WSC; (void)WMAX; (void)WINQ; (void)XQ; (void)XS; (void)APART; (void)VT; (void)SVT; (void)RVT; (void)RKT;

__global__ void __launch_bounds__(512, 2) mega(Params p_unused) {
    extern __shared__ __attribute__((aligned(16))) char lds_all[];
    cg::grid_group grid = cg::this_grid();
    const int wave_s = __builtin_amdgcn_readfirstlane((int)(threadIdx.x >> 6));
    if (threadIdx.x < 2) ((volatile lds_u32*)(lds_all + BARW_OFF))[threadIdx.x] = 0u;
    __syncthreads();
    { const __attribute__((address_space(4))) Params* kp0 = (const __attribute__((address_space(4))) Params*)__builtin_amdgcn_kernarg_segment_ptr(); xcd_barrier_post((unsigned*)kp0->ws + 4096); }
    STAMP(0);
    for (int rep0 = 0; rep0 < REP0; ++rep0)
    PH(0) { PHASE_VARS
        const int gw = bid * 8 + wave, NGW = G * 8;
        for (int it = gw; it < NL * 896; it += NGW) { const int l = it / 896; wmax_item(w_in + (size_t)l * DM * INC, DM, INC, mix_norm + l * DM, WMAX + l * INC, it % 896, lane); }
    }
    GRID_BAR();
    PH(0) { PHASE_VARS
        const int gw = bid * 8 + wave, NGW = G * 8;
        float* scr = (float*)(lds_all + wave * 8448);
        for (int it = gw; it < 2 * 4352; it += NGW) {
            const int l = it / 4352; int r = it % 4352;
            if (r < 1792) { tr_item_i8(w_in + (size_t)l * DM * INC, DM, INC, mix_norm + l * DM, WINQ + (size_t)l * INC * DM, WMAX + l * INC, WMAX + 8192 + l * INC, scr, r, lane); continue; } r -= 1792;
            if (r < 512) { tr_item(w_out + (size_t)l * DM * DM, DM, DM, nullptr, false, WOUT_T + (size_t)l * DM * DM, scr, r, lane); continue; } r -= 512;
            if (r < 512) { tr_item(xa_wq + (size_t)l * DM * DM, DM, DM, xa_norm + l * DM, false, WQ_T + (size_t)l * DM * DM, scr, r, lane); continue; } r -= 512;
            if (r < 1024) { tr_item(xa_wkv + (size_t)l * DM * 2048, DM, 2048, mem_norm + l * DM, false, WKV_T + (size_t)l * 2048 * DM, scr, r, lane); continue; } r -= 1024;
            tr_item(xa_wo + (size_t)l * DM * DM, DM, DM, nullptr, false, WO_T + (size_t)l * DM * DM, scr, r, lane);
        }
        for (int m = gw; m < T; m += NGW) row_to_i8_ssq(x + (size_t)m * DM, XQ + (size_t)m * DM, XS + m, SSQ + (size_t)m * 16, lane);
        for (int m = gw; m < MROWS; m += NGW) row_to_bf16_ssq(mem + (size_t)m * DM, MEMB + (size_t)m * DM, MEMSSQ + (size_t)m * 16, lane);
        __syncthreads();
        for (int it = bid; it < NL * 256; it += G) { const int l = it >> 8;
            peer_fold_item(peer_wq + (size_t)l * DM * 2048, peer_keys + (size_t)l * 8 * 2 * 128 * 128, peer_norm + l * DM, WP_T + (size_t)l * 2048 * DM, (float*)lds_all, it & 255, tid); }
    }
    grid.sync();
    STAMP(1);
    for (int l = 0; l < NL; ++l) {
        int stamp_i = 2 + l * 11; (void)stamp_i;
        if (l > 0) {
            PH(1) { PHASE_VARS const int gw = bid * 8 + wave, NGW = G * 8; xb_rows_run(XB, XQ, XS, gw, NGW, lane); }
            GRID_BAR();
        }
        for (int rep12 = 0; rep12 < REP12; ++rep12) {
        for (int rep1 = 0; rep1 < REP1; ++rep1) {
        PH(1) { PHASE_VARS  pg8::Gemm g{(const bf16_t*)XQ, (const bf16_t*)(WINQ + (size_t)l * INC * DM), T, INC, DM / 2}; pg8::StaticOrder S; S.init(T, INC, G, bid, tid, SSQ, rbuf, XS, WMAX + 8192 + l * INC);
            pg8::EpiProj E{MIXQ, PROJ2, SVT, RKT, RVT, rbuf, WMAX + 8192 + l * INC, glds + 136192};
            pg8::gemm_phase<pg8::EpiProj, pg8::StaticOrder, true, true, true>(glds, g, S, E, tid); }
        PH(2) if (l == 0) { PHASE_VARS
#pragma unroll 1
            for (int ll = 0; ll < NL; ++ll) {
                const int tk = wave_s * 64 + lane_id_volatile();
                pg8::Gemm g{MEMB, WKV_T + (size_t)ll * 2048 * DM, MROWS, 2048, DM}; pg8::StaticOrder S; S.init(MROWS, 2048, G, (bid + ll * (G / 2)) % G, tk, MEMSSQ, rbuf);
                pg8::EpiKV E{KV + (size_t)ll * MROWS * 2048, VT + (size_t)ll * NB * 4 * 256 * 256, rbuf};
                pg8::gemm_phase<pg8::EpiKV, pg8::StaticOrder, true, true>(glds, g, S, E, tk); }
        }
        GRID_BAR(); STAMP(stamp_i); ++stamp_i;
        }
        for (int repr = 0; repr < REPR; ++repr)
        PH(3) { PHASE_VARS
            for (int u = bid; u < NB * 4 * 4; u += G) { const bool co = (G == NB * 16); const int p = co ? (u & 7) + 8 * (u >> 5) : (u >> 2), q = co ? (u >> 3) & 3 : (u & 3);
                ret_unit(lds_all, MIXQ, PROJ2, RKT, RVT, ret_norm + l * 512, p >> 2, p & 3, 3 - q, tid, repr == REPR - 1); } }
        for (int reps = 0; reps < REPS; ++reps)
        PH(4) { PHASE_VARS
            if (G == NB * 16) {
                const int grp = bid & 7;
                unsigned* qctr = (unsigned*)ws + 8192 + ((l * 64 + grp) * 2) * 16;
                volatile unsigned* slot = (volatile unsigned*)(lds_all + 143360);
                if (tid == 0) slot[0] = atomicAdd(qctr, 1u);
                __syncthreads();
                unsigned cur = slot[0];
                for (int it = 1; cur < 256u; ++it) {
                    unsigned nxt = 0u; if (tid == 0) nxt = atomicAdd(qctr, 1u);
                    if (cur < 128u) { const int wu = (grp * 128 + (int)cur) * 8 + wave;
                        sb_wave(lds_all + wave * 9216, MIXQ, PROJ2, SVT, sb_norm + l * 512, wu >> 9, (wu >> 6) & 7, (63 - (wu & 63)) * 32, lane, reps == REPS - 1); }
                    else table_rows_run(peer_u, peer_v, peer_norm, T8, ISC, l, (grp * 128 + (int)cur - 128) * 32 + wave * 4, 4, lane);
                    if (tid == 0) slot[it & 1] = nxt;
                    __syncthreads();
                    cur = slot[it & 1];
                }
            } else {
                for (int wu = bid * 8 + wave; wu < NB * 8 * 64; wu += G * 8) sb_wave(lds_all + wave * 9216, MIXQ, PROJ2, SVT, sb_norm + l * 512, wu >> 9, (wu >> 6) & 7, (63 - (wu & 63)) * 32, lane, reps == REPS - 1);
                for (int r = bid * 8 + wave; r < 2 * NEXP; r += G * 8) { const int tab = r >> 14, e = r & (NEXP - 1), lt = l * 2 + tab;
                    table_row_to_i8((tab ? peer_v : peer_u) + ((size_t)l * NEXP + e) * DM, tab ? nullptr : peer_norm + l * DM, T8 + (size_t)lt * 8 * NEXP * 128, ISC + (size_t)lt * NEXP, e, lane); }
            } }
        GRID_BAR(); STAMP(stamp_i); ++stamp_i;
        }
        PH(5) { PHASE_VARS  pg8::Gemm g{MIXQ, WOUT_T + (size_t)l * DM * DM, T, DM, DM};
            if (l == 0) { const int t3 = wave_s * 64 + lane_id_volatile(); pg8::StaticOrder S; S.init(T, DM, G, bid, t3); pg8::EpiResid<true> E{x, XB, SSQ}; pg8::gemm_phase<pg8::EpiResid<true>, pg8::StaticOrder, true, true>(glds, g, S, E, t3); }
            else { const int t3 = wave_s * 64 + lane_id_volatile(); pg8::StaticOrder S; S.init(T, DM, G, bid, t3); pg8::EpiResid<false> E{nullptr, XB, SSQ}; pg8::gemm_phase<pg8::EpiResid<false>, pg8::StaticOrder, true, true>(glds, g, S, E, t3); } }
        GRID_BAR(); STAMP(stamp_i); ++stamp_i;
        PH(6) { PHASE_VARS  pg8::Gemm g{XB, WQ_T + (size_t)l * DM * DM, T, DM, DM}; pg8::StaticOrder S; S.init(T, DM, G, bid, tid, SSQ, rbuf);
            pg8::EpiScale<false> E{Q, 1024, rbuf, 0.0625f * 1.4426950408889634f};
            pg8::gemm_phase<pg8::EpiScale<false>, pg8::StaticOrder, true, true>(glds, g, S, E, tid);
            asm volatile("s_waitcnt vmcnt(0)" ::: "memory"); __syncthreads(); __builtin_amdgcn_fence(__ATOMIC_ACQUIRE, "agent"); asm volatile("s_waitcnt vmcnt(0)" ::: "memory"); __syncthreads();
            pg8::Unit u;
            for (int rep5 = 0; rep5 < REP5; ++rep5)
            for (int i = 0; S.next(i, u); ++i) { const int b = u.pm >> 3, h = u.pn;
#pragma unroll 1
                for (int hf = 0; hf < 2; ++hf)
                    xattn_unit(lds_all, Q, KV + (size_t)l * MROWS * 2048 + (size_t)b * NMEM * 2048 + h * 256, VT + ((size_t)l * NB * 4 + b * 4 + h) * 65536, O, u.pm * 256 + hf * 128, h, wave_s * 64 + lane_id_volatile(), REP5ST || rep5 == REP5 - 1); } }
        GRID_BAR(); STAMP(stamp_i); ++stamp_i;
        PH(8) { PHASE_VARS  pg8::Gemm g{O, WO_T + (size_t)l * DM * DM, T, DM, DM}; pg8::StaticOrder S; S.init(T, DM, G, bid, tid);
            pg8::EpiResid<false> E{nullptr, XB, SSQ};
            pg8::gemm_phase<pg8::EpiResid<false>, pg8::StaticOrder, true, true>(glds, g, S, E, tid); }
        GRID_BAR(); STAMP(stamp_i); ++stamp_i;
#ifdef GPROBE
        {   PHASE_VARS  pg8::Gemm g{XB, WQ_T + (size_t)l * DM * DM, T, DM, DM}; pg8::StaticOrder S;
            if (GPROBE == 1) { S.init(T, DM, G, bid, tid, SSQ, rbuf); pg8::EpiScale<false> E{(bf16_t*)XR, 1024, rbuf, 1.0f}; pg8::gemm_phase<pg8::EpiScale<false>, pg8::StaticOrder, true, true>(glds, g, S, E, tid); }
            if (GPROBE == 2) { S.init(T, DM, G, bid, tid); pg8::EpiScale<false> E{(bf16_t*)XR, 1024, rbuf, 1.0f}; pg8::gemm_phase<pg8::EpiScale<false>, pg8::StaticOrder, true, true>(glds, g, S, E, tid); }
            if (GPROBE == 3) { S.init(T, DM, G, bid, tid); pg8::EpiMin E{(bf16_t*)XR}; pg8::gemm_phase<pg8::EpiMin, pg8::StaticOrder, true, true>(glds, g, S, E, tid); }
        }
        GRID_BAR();
#endif
        PH(9) { PHASE_VARS  pg8::Gemm g{XB, WP_T + (size_t)l * 2048 * DM, T, 2048, DM}; pg8::StaticOrder S; S.init(T, 2048, G, bid, tid, SSQ, rbuf);
            pg8::EpiScale<true> E{SCORES, 2048, rbuf, 1.0f};
            pg8::gemm_phase<pg8::EpiScale<true>, pg8::StaticOrder, true, true>(glds, g, S, E, tid);
            asm volatile("s_waitcnt vmcnt(0)" ::: "memory"); __syncthreads(); __builtin_amdgcn_fence(__ATOMIC_ACQUIRE, "agent"); asm volatile("s_waitcnt vmcnt(0)" ::: "memory"); __syncthreads();
            pg8::Unit u;
            for (int i = 0; S.next(i, u); ++i) { const int t2 = wave_s * 64 + lane_id_volatile(); peer_topk_fast(SCORES, IDX, GATE, u.pm * 256 + (t2 >> 1), u.pn * 2 + (t2 & 1)); } }
        GRID_BAR(); STAMP(stamp_i); ++stamp_i;
#ifndef REP9A
#define REP9A 1
#endif
        for (int rep9a = 0; rep9a < REP9A; ++rep9a)
        PH(11) { PHASE_VARS peer_u_phase(XB, IDX, T8 + (size_t)(l * 2 + 0) * 8 * NEXP * 128, APART, bid, G, wave, lane); }
        GRID_BAR(); STAMP(stamp_i); ++stamp_i;
        for (int rep9b = 0; rep9b < REP9B; ++rep9b)
        PH(11) { PHASE_VARS peer_combine_phase(APART, IDX, GATE, SSQ, ISC + (size_t)(l * 2 + 0) * NEXP, ISC + (size_t)(l * 2 + 1) * NEXP, WSC, bid * 512 + tid, G * 512); }
        GRID_BAR(); STAMP(stamp_i); ++stamp_i;
        for (int rep9c = 0; rep9c < REP9C; ++rep9c)
        PH(11) { PHASE_VARS peer_v_phase(IDX, WSC, T8 + (size_t)(l * 2 + 1) * 8 * NEXP * 128, XB, SSQ, bid, G, wave, lane, rep9c == REP9C - 1); }
        GRID_BAR(); STAMP(stamp_i); ++stamp_i;
    }
    PH(12) { PHASE_VARS VB_LOOP(T / 4) d_rmsnorm_final(vb, vtid, XB, XR, final_norm); }
#ifdef PROBE_T
    STAMP(24);
    GRID_BAR();
    if (blockIdx.x == 0) {
        volatile unsigned long long* ts = (volatile unsigned long long*)(lds_all + 146432);
        const __attribute__((address_space(4))) Params* kpp = (const __attribute__((address_space(4))) Params*)__builtin_amdgcn_kernarg_segment_ptr();
        float* outp = kpp->out;
        unsigned long long d = 0;
#pragma unroll
        for (int j = 0; j < 11; ++j) if ((PROBE_MASK >> j) & 1) d += (ts[2 + j] - ts[1 + j]) + (ts[13 + j] - ts[12 + j]);
        if ((PROBE_MASK >> 11) & 1) d += ts[1] - ts[0];
        if ((PROBE_MASK >> 12) & 1) d += ts[24] - ts[0];
        if ((PROBE_MASK >> 13) & 1) d += ts[24] - ts[23];
        const float w = (float)d * 0.01f * (float)(PROBE_S);
        for (int i = wave_s * 64 + lane_id_volatile(); i < 16384; i += 512) outp[1024 + i] = w;
    }
#endif

}

extern "C" void kernel_launch(void* const* d_in, const int* in_sizes, int n_in, void* d_out, int out_size, void* d_ws, size_t ws_size, hipStream_t stream) {
    static int grid_blocks = 0;
    if (grid_blocks == 0) {
        int dev = 0, cus = 0, per_cu = 0;
        (void)hipGetDevice(&dev);
        (void)hipDeviceGetAttribute(&cus, hipDeviceAttributeMultiprocessorCount, dev);
        (void)hipFuncSetAttribute((const void*)mega, hipFuncAttributeMaxDynamicSharedMemorySize, LDS_BYTES);
        (void)hipOccupancyMaxActiveBlocksPerMultiprocessor(&per_cu, (const void*)mega, 512, LDS_BYTES);
        if (per_cu < 1) { fprintf(stderr, "occupancy query says %d blocks/CU\n", per_cu); per_cu = 1; }
        grid_blocks = cus * per_cu;
        if (ws_size < WS_END * MiB || n_in != 18) { fprintf(stderr, "bad ws_size %zu / n_in %d\n", ws_size, n_in); grid_blocks = -1; }
    }
    if (grid_blocks < 0) return;
    (void)hipMemsetAsync(d_ws, 0, 131072, stream);
    Params p{};
    for (int i = 0; i < 18; ++i) p.in[i] = (const float*)d_in[i];
    p.out = (float*)d_out; p.ws = (char*)d_ws;
    void* args[] = {&p};
    hipError_t e = hipLaunchCooperativeKernel((const void*)mega, dim3(grid_blocks), dim3(512), args, LDS_BYTES, stream);
    if (e != hipSuccess) fprintf(stderr, "cooperative launch failed: %s (grid %d)\n", hipGetErrorString(e), grid_blocks);
}
```
